# Optimizing an MI355X kernel written in HIP

```python
import jax, jax.numpy as jnp
from jax import lax
import numpy as np

D_MODEL = 1024
BATCH = 8
SEQ = 8192
DEPTH = 2

GRID_W = 64
CTX_LEN = 256
N_HEADS = 8
N_KV_HEADS = 2
GROUP = N_HEADS // N_KV_HEADS
HEAD_DIM = 64
ROPE_AXIS_DIM = HEAD_DIM // 2
ROPE_THETA = 10000.0
WINDOW = 128
ATTN_BLOCK = 128
D_CONV = D_MODEL // 2
CONV_K = 31
D_POOL = D_MODEL // 2
POOL_WINDOWS = (2, 4, 8, 16)
POOL_GROUP = D_POOL // len(POOL_WINDOWS)
N_BRANCH = 3
D_Q = N_HEADS * HEAD_DIM
D_KV = N_KV_HEADS * HEAD_DIM
IN_SPLITS = (D_CONV, D_CONV, D_Q, D_KV, D_KV, D_POOL, N_BRANCH * D_MODEL)
IN_OFFSETS = tuple(sum(IN_SPLITS[: i + 1]) for i in range(len(IN_SPLITS) - 1))
D_IN = sum(IN_SPLITS)
N_EXPERTS = 32
TOP_K = 4
D_EXPERT = D_MODEL
SWIGLU_LIMIT = 7.0
SWIGLU_ALPHA = 1.702
MOE_BLOCK = 128
EPS = 1e-6
MASK_VALUE = -1e30

kernel_name = "hybrid_gated_conv_swa_pool_moe_dit"


def rmsnorm(x, g):
    xf = x.astype(jnp.float32)
    y = xf * lax.rsqrt(jnp.mean(jnp.square(xf), axis=-1, keepdims=True) + EPS)
    return y.astype(x.dtype) * g


def layernorm(x, g, b):
    xf = x.astype(jnp.float32)
    mu = jnp.mean(xf, axis=-1, keepdims=True)
    var = jnp.mean(jnp.square(xf - mu), axis=-1, keepdims=True)
    return ((xf - mu) * lax.rsqrt(var + EPS)).astype(x.dtype) * g + b


def modulate(h, shift, scale):
    return h * (1 + scale) + shift


def axial_rope_tables(rows):
    row = jnp.repeat(jnp.arange(rows), GRID_W).astype(jnp.float32)
    col = jnp.tile(jnp.arange(GRID_W), rows).astype(jnp.float32)
    inv = ROPE_THETA ** (-jnp.arange(0, ROPE_AXIS_DIM, 2, dtype=jnp.float32) / ROPE_AXIS_DIM)
    ang = jnp.concatenate([row[:, None] * inv, col[:, None] * inv], axis=-1)
    return jnp.cos(ang), jnp.sin(ang)


def apply_rope(x, cos, sin):
    half = HEAD_DIM // 2
    x1, x2 = x[..., :half], x[..., half:]
    c = cos[None, :, None, :].astype(x.dtype)
    s = sin[None, :, None, :].astype(x.dtype)
    return jnp.concatenate([x1 * c - x2 * s, x2 * c + x1 * s], axis=-1)


def sink_softmax(logits, sink):
    s = jnp.broadcast_to(sink.reshape(N_KV_HEADS, GROUP, 1, 1).astype(jnp.float32), logits.shape[:-1] + (1,))
    p = jax.nn.softmax(jnp.concatenate([logits, s], axis=-1), axis=-1)
    return p[..., :-1]


def latent_attention(q, k, v, kz, vz, sink):
    B, S = q.shape[0], q.shape[1]
    nb = S // ATTN_BLOCK
    scale = HEAD_DIM ** -0.5
    qb = q.reshape(B, nb, ATTN_BLOCK, N_KV_HEADS, GROUP, HEAD_DIM)
    pad = ((0, 0), (ATTN_BLOCK, ATTN_BLOCK), (0, 0), (0, 0))
    kp = jnp.pad(k, pad).reshape(B, nb + 2, ATTN_BLOCK, N_KV_HEADS, HEAD_DIM)
    vp = jnp.pad(v, pad).reshape(B, nb + 2, ATTN_BLOCK, N_KV_HEADS, HEAD_DIM)
    kw = jnp.concatenate([kp[:, :-2], kp[:, 1:-1], kp[:, 2:]], axis=2)
    vw = jnp.concatenate([vp[:, :-2], vp[:, 1:-1], vp[:, 2:]], axis=2)
    s_loc = jnp.einsum('bnqkgd,bnjkd->bnkgqj', qb, kw).astype(jnp.float32) * scale
    qi = jnp.arange(ATTN_BLOCK)[:, None]
    kj = jnp.arange(3 * ATTN_BLOCK)[None, :]
    in_window = jnp.abs(kj - ATTN_BLOCK - qi) <= WINDOW
    kpos = jnp.arange(nb)[:, None] * ATTN_BLOCK - ATTN_BLOCK + kj
    in_range = (kpos >= 0) & (kpos < S)
    valid = in_window[None] & in_range[:, None, :]
    s_loc = jnp.where(valid[None, :, None, None], s_loc, MASK_VALUE)
    s_ctx = jnp.einsum('bnqkgd,bckd->bnkgqc', qb, kz).astype(jnp.float32) * scale
    p = sink_softmax(jnp.concatenate([s_loc, s_ctx], axis=-1), sink)
    n_loc = 3 * ATTN_BLOCK
    p_loc = p[..., :n_loc].astype(v.dtype)
    p_ctx = p[..., n_loc:].astype(v.dtype)
    out = jnp.einsum('bnkgqj,bnjkd->bnqkgd', p_loc, vw) + jnp.einsum('bnkgqc,bckd->bnqkgd', p_ctx, vz)
    return out.reshape(B, S, D_Q)


def context_attention(qz, kz, vz, sink):
    B, C = qz.shape[0], qz.shape[1]
    qg = qz.reshape(B, C, N_KV_HEADS, GROUP, HEAD_DIM)
    s = jnp.einsum('bqkgd,bckd->bkgqc', qg, kz).astype(jnp.float32) * (HEAD_DIM ** -0.5)
    p = sink_softmax(s, sink).astype(vz.dtype)
    return jnp.einsum('bkgqc,bckd->bqkgd', p, vz).reshape(B, C, D_Q)


def conv_mix(a_val, a_gate, w_dw, b_dw, ln_g, ln_b, w_conv_out):
    a = a_val * jax.nn.sigmoid(a_gate)
    a = lax.conv_general_dilated(
        a, w_dw[:, None, :], window_strides=(1,), padding=((CONV_K // 2, CONV_K // 2),),
        dimension_numbers=('NWC', 'WIO', 'NWC'), feature_group_count=D_CONV) + b_dw
    a = jax.nn.silu(layernorm(a, ln_g, ln_b))
    return a @ w_conv_out


def pool_mix(u, w_pool, pool_scale, w_pool_out):
    B, L, _ = u.shape
    cs = jnp.pad(jnp.cumsum(u.astype(jnp.float32), axis=1), ((0, 0), (1, 0), (0, 0)))
    t = jnp.arange(L)
    outs = []
    for gi, w in enumerate(POOL_WINDOWS):
        lo = jnp.clip(t - w // 2, 0, L)
        hi = jnp.clip(t + w - w // 2, 0, L)
        sl = slice(gi * POOL_GROUP, (gi + 1) * POOL_GROUP)
        cnt = (hi - lo).astype(jnp.float32)[None, :, None]
        outs.append((cs[:, hi, sl] - cs[:, lo, sl]) / cnt)
    pooled = jnp.concatenate(outs, axis=-1).astype(u.dtype) - u
    pooled = pooled.reshape(B, L, len(POOL_WINDOWS), POOL_GROUP)
    mixed = jnp.einsum('blgc,gcd->blgd', pooled, w_pool).reshape(B, L, D_POOL) * pool_scale
    return mixed @ w_pool_out


def merge_branches(y_conv, y_attn, y_pool, gate_logits, b_gate, w_out):
    g_conv, g_attn, g_pool = jnp.split(jax.nn.sigmoid(gate_logits + b_gate), N_BRANCH, axis=-1)
    return (g_conv * y_conv + g_attn * y_attn + g_pool * y_pool) @ w_out


def routed_ffn(h, router_w, router_b, w_gu, b_gu, w_down, b_down):
    T, D = h.shape
    logits = (h @ router_w + router_b).astype(jnp.float32)
    top_v, top_i = lax.top_k(logits, TOP_K)
    gates = jax.nn.softmax(top_v, axis=-1).astype(h.dtype)
    A = T * TOP_K
    flat_e = top_i.reshape(-1)
    flat_tok = jnp.repeat(jnp.arange(T), TOP_K)
    order = jnp.argsort(flat_e)
    sorted_e = flat_e[order]
    sorted_tok = flat_tok[order]
    sorted_gate = gates.reshape(-1)[order]
    counts = jnp.bincount(flat_e, length=N_EXPERTS)
    padded = (counts + MOE_BLOCK - 1) // MOE_BLOCK * MOE_BLOCK
    start = jnp.cumsum(counts) - counts
    padded_end = jnp.cumsum(padded)
    padded_start = padded_end - padded
    dest = padded_start[sorted_e] + (jnp.arange(A) - start[sorted_e])
    n_blk = -(-A // MOE_BLOCK) + N_EXPERTS
    P = n_blk * MOE_BLOCK
    x_pad = jnp.zeros((P, D), h.dtype).at[dest].set(h[sorted_tok])
    block_e = jnp.minimum(jnp.searchsorted(padded_end, jnp.arange(n_blk) * MOE_BLOCK, side='right'), N_EXPERTS - 1)

    def expert_block(args):
        xb, e = args
        gu = xb @ w_gu[e] + b_gu[e]
        g, up = gu[:, :D_EXPERT], gu[:, D_EXPERT:]
        g = jnp.minimum(g, SWIGLU_LIMIT)
        up = jnp.clip(up, -SWIGLU_LIMIT, SWIGLU_LIMIT)
        act = (up + 1) * (g * jax.nn.sigmoid(SWIGLU_ALPHA * g))
        return act @ w_down[e] + b_down[e]

    y = lax.map(expert_block, (x_pad.reshape(n_blk, MOE_BLOCK, D), block_e)).reshape(P, D)
    return jnp.zeros((T, D), h.dtype).at[sorted_tok].add(y[dest] * sorted_gate[:, None])


def trunk_layer(x, z, c, c_ctx, cos, sin, w_mod, b_mod, norm1_g, w_in, b_gate, w_dw, b_dw, conv_ln_g, conv_ln_b,
                w_conv_out, attn_sink, w_attn_out, w_pool, pool_scale, w_pool_out, w_out, norm2_g,
                router_w, router_b, w_gu, b_gu, w_down, b_down, last):
    B, S, D = x.shape
    C = z.shape[1]
    sh1, sc1, g1, sh2, sc2, g2 = jnp.split((jax.nn.silu(c) @ w_mod + b_mod)[:, None, :], 6, axis=-1)
    zsh1, zsc1, zg1, zsh2, zsc2, zg2 = jnp.split(jax.nn.silu(c_ctx) @ w_mod + b_mod, 6, axis=-1)

    h = modulate(rmsnorm(x, norm1_g), sh1, sc1)
    hz = modulate(rmsnorm(z, norm1_g), zsh1, zsc1)
    a_val, a_gate, q, k, v, u, gate_logits = jnp.split(h @ w_in, IN_OFFSETS, axis=-1)
    if last:
        zk, zv = jnp.split(hz @ w_in[:, IN_OFFSETS[2]:IN_OFFSETS[4]], 2, axis=-1)
    else:
        za_val, za_gate, zq, zk, zv, zu, zgate_logits = jnp.split(hz @ w_in, IN_OFFSETS, axis=-1)
    zk = zk.reshape(B, C, N_KV_HEADS, HEAD_DIM)
    zv = zv.reshape(B, C, N_KV_HEADS, HEAD_DIM)
    q = apply_rope(q.reshape(B, S, N_HEADS, HEAD_DIM), cos, sin)
    k = apply_rope(k.reshape(B, S, N_KV_HEADS, HEAD_DIM), cos, sin)
    v = v.reshape(B, S, N_KV_HEADS, HEAD_DIM)

    y_conv = conv_mix(a_val, a_gate, w_dw, b_dw, conv_ln_g, conv_ln_b, w_conv_out)
    y_attn = latent_attention(q, k, v, zk, zv, attn_sink) @ w_attn_out
    y_pool = pool_mix(u, w_pool, pool_scale, w_pool_out)
    x = x + g1 * merge_branches(y_conv, y_attn, y_pool, gate_logits, b_gate, w_out)

    if not last:
        zy_conv = conv_mix(za_val, za_gate, w_dw, b_dw, conv_ln_g, conv_ln_b, w_conv_out)
        zy_attn = context_attention(zq.reshape(B, C, N_HEADS, HEAD_DIM), zk, zv, attn_sink) @ w_attn_out
        zy_pool = pool_mix(zu, w_pool, pool_scale, w_pool_out)
        z = z + zg1 * merge_branches(zy_conv, zy_attn, zy_pool, zgate_logits, b_gate, w_out)

    h2 = modulate(rmsnorm(x, norm2_g), sh2, sc2)
    if last:
        f = routed_ffn(h2.reshape(B * S, D), router_w, router_b, w_gu, b_gu, w_down, b_down)
        x = x + g2 * f.reshape(B, S, D)
    else:
        h2z = modulate(rmsnorm(z, norm2_g), zsh2, zsc2)
        f = routed_ffn(jnp.concatenate([h2.reshape(B * S, D), h2z.reshape(B * C, D)], axis=0),
                       router_w, router_b, w_gu, b_gu, w_down, b_down)
        x = x + g2 * f[: B * S].reshape(B, S, D)
        z = z + zg2 * f[B * S:].reshape(B, C, D)
    return x, z


def setup_inputs(seed: int = 0) -> dict:
    key = jax.random.key(seed)
    ks = iter(jax.random.split(key, 40))
    L, D, E, F = DEPTH, D_MODEL, N_EXPERTS, D_EXPERT

    def nrm(shape, scale):
        return jax.random.normal(next(ks), shape, jnp.float32) * scale

    return {
        "x": nrm((BATCH, SEQ, D), 1.0),
        "c": nrm((BATCH, D), 1.0),
        "ctx": nrm((BATCH, CTX_LEN, D), 1.0),
        "c_ctx": nrm((D,), 1.0),
        "w_mod": nrm((L, D, 6 * D), 0.5 * D ** -0.5),
        "b_mod": nrm((L, 6 * D), 0.02),
        "norm1_g": 1.0 + nrm((L, D), 0.02),
        "w_in": nrm((L, D, D_IN), D ** -0.5),
        "b_gate": nrm((L, N_BRANCH * D), 0.02),
        "w_dw": nrm((L, CONV_K, D_CONV), CONV_K ** -0.5),
        "b_dw": nrm((L, D_CONV), 0.02),
        "conv_ln_g": 1.0 + nrm((L, D_CONV), 0.02),
        "conv_ln_b": nrm((L, D_CONV), 0.02),
        "w_conv_out": nrm((L, D_CONV, D), D_CONV ** -0.5),
        "attn_sink": nrm((L, N_HEADS), 0.5),
        "w_attn_out": nrm((L, D_Q, D), D_Q ** -0.5),
        "w_pool": nrm((L, len(POOL_WINDOWS), POOL_GROUP, POOL_GROUP), POOL_GROUP ** -0.5),
        "pool_scale": 1.0 + nrm((L, D_POOL), 0.1),
        "w_pool_out": nrm((L, D_POOL, D), D_POOL ** -0.5),
        "w_out": nrm((L, D, D), D ** -0.5),
        "norm2_g": 1.0 + nrm((L, D), 0.02),
        "router_w": nrm((L, D, E), D ** -0.5),
        "router_b": nrm((L, E), 0.01),
        "w_gu": nrm((L, E, D, 2 * F), D ** -0.5),
        "b_gu": nrm((L, E, 2 * F), 0.02),
        "w_down": nrm((L, E, F, D), F ** -0.5),
        "b_down": nrm((L, E, D), 0.02),
        "final_g": 1.0 + nrm((D,), 0.02),
    }


def reference(x, c, ctx, c_ctx, w_mod, b_mod, norm1_g, w_in, b_gate, w_dw, b_dw, conv_ln_g, conv_ln_b,
              w_conv_out, attn_sink, w_attn_out, w_pool, pool_scale, w_pool_out, w_out, norm2_g,
              router_w, router_b, w_gu, b_gu, w_down, b_down, final_g):
    rows = x.shape[1] // GRID_W
    cos, sin = axial_rope_tables(rows)
    z = ctx
    for l in range(DEPTH):
        x, z = trunk_layer(
            x, z, c, c_ctx, cos, sin, w_mod[l], b_mod[l], norm1_g[l], w_in[l], b_gate[l], w_dw[l], b_dw[l],
            conv_ln_g[l], conv_ln_b[l], w_conv_out[l], attn_sink[l], w_attn_out[l], w_pool[l], pool_scale[l],
            w_pool_out[l], w_out[l], norm2_g[l], router_w[l], router_b[l], w_gu[l], b_gu[l], w_down[l], b_down[l],
            last=(l == DEPTH - 1))
    return rmsnorm(x, final_g)
```

```cpp
#include <hip/hip_runtime.h>
#include <cstdio>
#include <cstdint>

#ifndef MK_PER_PHASE
#define MK_PER_PHASE 1
#endif

#define GAS __attribute__((address_space(1)))
#define LAS __attribute__((address_space(3)))
typedef unsigned short bf16_t;
typedef short bf16x8 __attribute__((ext_vector_type(8)));
typedef float f32x2 __attribute__((ext_vector_type(2)));
typedef float f32x4 __attribute__((ext_vector_type(4)));
typedef float f32x16 __attribute__((ext_vector_type(16)));
typedef unsigned u32x2 __attribute__((ext_vector_type(2)));
typedef unsigned u32x4 __attribute__((ext_vector_type(4)));
typedef __bf16 bf16x2_t __attribute__((ext_vector_type(2)));

constexpr int D = 1024, NB = 8, SEQ = 8192, CTXL = 256;
constexpr int TX = NB * SEQ, TZ = NB * CTXL, TA = TX + TZ;
constexpr int NTX = TX / 256, NTZ = TZ / 256, NTA = TA / 256;
constexpr int DIN = 5376, NE = 32;
constexpr int NPH = 18;
constexpr float EPS = 1e-6f;
constexpr float LOG2E = 1.4426950408889634f;

constexpr size_t al256(size_t x) { return (x + 255) & ~(size_t)255; }
constexpr size_t WS_CTL = 0, CTL_BYTES = 1u << 20;
constexpr size_t WS_MOD = WS_CTL + CTL_BYTES, MOD_BYTES = al256((size_t)2 * 9 * 6144 * 4);
constexpr size_t WS_ROPE = WS_MOD + MOD_BYTES, ROPE_BYTES = (size_t)2 * 8192 * 32 * 4;
constexpr size_t WS_W = WS_ROPE + ROPE_BYTES;
constexpr size_t W_IN = 0, W_IN_B = (size_t)DIN * 1024 * 2;
constexpr size_t W_CO = W_IN + W_IN_B, W_P_B = (size_t)1024 * 512 * 2;
constexpr size_t W_AO = W_CO + W_P_B;
constexpr size_t W_PE = W_AO + W_P_B;
constexpr size_t W_OUT = W_PE + W_P_B, W_OUT_B = (size_t)1024 * 1024 * 2;
constexpr size_t W_GU = W_OUT + W_OUT_B, W_GU_E = (size_t)2048 * 1024 * 2, W_GU_B = 32 * W_GU_E;
constexpr size_t W_DN = W_GU + W_GU_B, W_DN_E = (size_t)1024 * 1024 * 2, W_DN_B = 32 * W_DN_E;
constexpr size_t W_LAYER = W_DN + W_DN_B;
constexpr size_t WS_H = WS_W + 2 * W_LAYER;
constexpr size_t H_BYTES = (size_t)TA * 1024 * 2;
constexpr size_t WS_R1 = WS_H + H_BYTES;
constexpr size_t R1_AGLU = 0, R1_Q = R1_AGLU + (size_t)TA * 512 * 2, R1_K = R1_Q + (size_t)TA * 512 * 2, R1_VT = R1_K + (size_t)TA * 128 * 2,
                 R1_U = R1_VT + (size_t)TA * 128 * 2, R1_G = R1_U + (size_t)TA * 512 * 2, R1_BYTES = R1_G + (size_t)TA * 3072 * 2;
constexpr int PMAX = TA * 4 + 32 * 256;
constexpr size_t ACT_BYTES = (size_t)PMAX * 1024 * 2;
static_assert(ACT_BYTES <= R1_BYTES, "ACT must fit R1");
constexpr size_t WS_R2 = WS_R1 + R1_BYTES;
constexpr size_t R2_AC = 0, R2_AT = (size_t)TA * 512 * 2, R2_PL = 2 * R2_AT, R2_MG = 3 * R2_AT, R2_BYTES = ACT_BYTES;
static_assert(R2_MG + (size_t)TA * 1024 * 2 <= R2_BYTES, "R2");
constexpr size_t WS_X = WS_R2 + R2_BYTES;
constexpr size_t X_BYTES = (size_t)TA * 1024 * 4;
constexpr size_t WS_TI = WS_X + X_BYTES;
constexpr size_t WS_TG = WS_TI + (size_t)TA * 16;
constexpr size_t WS_LIST = WS_TG + (size_t)TA * 16;
constexpr size_t WS_END = WS_LIST + (size_t)32 * TA * 4;
constexpr int CW_TMO = 0, CW_BAR = 4096, CW_CNT = 16384;

constexpr int LDS_BYTES = 163840;
constexpr int LDS_MISC = 163840 - 256;
constexpr int LDS_TAB = 131072;

__device__ __forceinline__ unsigned f2bf(float f) { unsigned u = __builtin_bit_cast(unsigned, f); return (u + 0x7fffu + ((u >> 16) & 1u)) >> 16; }
__device__ __forceinline__ unsigned pk2(float lo, float hi) { f32x2 v = {lo, hi}; bf16x2_t b = __builtin_convertvector(v, bf16x2_t); return __builtin_bit_cast(unsigned, b); }
__device__ __forceinline__ float bflo(unsigned u) { return __builtin_bit_cast(float, u << 16); }
__device__ __forceinline__ float bfhi(unsigned u) { return __builtin_bit_cast(float, u & 0xffff0000u); }
__device__ __forceinline__ float wave_sum(float v) {
#pragma unroll
    for (int o = 1; o < 64; o <<= 1) v += __shfl_xor(v, o);
    return v;
}
__device__ __forceinline__ float sigmoidf_(float x) { return __builtin_amdgcn_rcpf(1.0f + __builtin_amdgcn_exp2f(-x * LOG2E)); }
__device__ __forceinline__ u32x4 pack8(const f32x4& a, const f32x4& b) { u32x4 w; w.x = pk2(a[0], a[1]); w.y = pk2(a[2], a[3]); w.z = pk2(b[0], b[1]); w.w = pk2(b[2], b[3]); return w; }
__device__ __forceinline__ void unpack8(const u32x4& w, f32x4& a, f32x4& b) { a = (f32x4){bflo(w.x), bfhi(w.x), bflo(w.y), bfhi(w.y)}; b = (f32x4){bflo(w.z), bfhi(w.z), bflo(w.w), bfhi(w.w)}; }
__device__ __forceinline__ int perm16(int s) { return (s & ~12) | ((s & 4) << 1) | ((s & 8) >> 1); }

#define XB_TMO      128
#define XB_XCNT(j)  (256  + 64 * (j))
#define XB_XSUB(j)  (1280 + 64 * (j))
#define XB_XGEN(j)  (2304 + 64 * (j))
#define XB_TOP      3328
#define XB_TOPGEN   3392
#define XCD_BAR_WORDS 3456
#define XB_SPIN_CAP (1u << 18)
__device__ __forceinline__ unsigned xb_ld(unsigned* p)              { return __hip_atomic_load(p, __ATOMIC_RELAXED, __HIP_MEMORY_SCOPE_AGENT); }
__device__ __forceinline__ unsigned xb_add(unsigned* p, unsigned v) { return __hip_atomic_fetch_add(p, v, __ATOMIC_RELAXED, __HIP_MEMORY_SCOPE_AGENT); }
__device__ __forceinline__ unsigned xb_xcc_id() { return (unsigned)__builtin_amdgcn_s_getreg((3 << 11) | 20) & 0xFu; }
#define XB_SPIN(cond, bar) do { unsigned _sp = 0; while (cond) { __builtin_amdgcn_s_sleep(1); \
    if ((++_sp & 255u) == 0u) { if (xb_ld(&(bar)[XB_TMO])) break; if (_sp > XB_SPIN_CAP) { atomicAdd(&(bar)[XB_TMO], 1u); break; } } } } while (0)
struct XcdBarrier { unsigned* bar; unsigned x; volatile LAS unsigned* st; };
__device__ __forceinline__ XcdBarrier xcd_barrier_post(unsigned* bar, volatile LAS unsigned* st) {
    XcdBarrier b; b.bar = bar; b.x = xb_xcc_id(); b.st = st;
    if (threadIdx.x == 0) (void)xb_add(&bar[XB_XCNT(b.x)], 1u);
    return b;
}
__device__ __forceinline__ void xcd_barrier_complete(unsigned* bar, unsigned x, unsigned& nloc, unsigned& nx) {
    const unsigned G = gridDim.x * gridDim.y * gridDim.z;
    unsigned sum, cnt, mine, sp = 0u;
    for (;;) {
        sum = 0u; cnt = 0u; mine = 0u;
#pragma unroll
        for (unsigned j = 0; j < 16; ++j) { const unsigned c = xb_ld(&bar[XB_XCNT(j)]); sum += c; cnt += (c > 0u) ? 1u : 0u; mine = (j == x) ? c : mine; }
        if (sum == G) break;
        __builtin_amdgcn_s_sleep(1);
        if ((++sp & 255u) == 0u) { if (xb_ld(&bar[XB_TMO])) break; if (sp > XB_SPIN_CAP) { atomicAdd(&bar[XB_TMO], 1u); break; } }
    }
    nloc = mine > 0u ? mine : 1u; nx = cnt > 0u ? cnt : 1u;
}
__device__ __forceinline__ void xcd_barrier(const XcdBarrier& b) {
    asm volatile("s_waitcnt vmcnt(0)" ::: "memory");
    __syncthreads();
    if (threadIdx.x == 0) {
        unsigned* bar = b.bar;
        __builtin_amdgcn_s_waitcnt(0);
        unsigned nloc = b.st[0], nx = b.st[1];
        if (nloc == 0u) { xcd_barrier_complete(bar, b.x, nloc, nx); b.st[0] = nloc; b.st[1] = nx; }
        const unsigned old = xb_add(&bar[XB_XSUB(b.x)], 1u);
        const unsigned gen = old / nloc;
        if (old + 1u == (gen + 1u) * nloc) {
            __builtin_amdgcn_fence(__ATOMIC_RELEASE, "agent");
            asm volatile("s_waitcnt vmcnt(0)" ::: "memory");
            const unsigned og = xb_add(&bar[XB_TOP], 1u);
            const unsigned tg = og / nx;
            if (og + 1u == (tg + 1u) * nx) xb_add(&bar[XB_TOPGEN], 1u);
            else XB_SPIN(xb_ld(&bar[XB_TOPGEN]) == tg, bar);
            __builtin_amdgcn_fence(__ATOMIC_ACQUIRE, "agent");
            xb_add(&bar[XB_XGEN(b.x)], 1u);
            asm volatile("s_waitcnt vmcnt(0)" ::: "memory");
        } else {
            XB_SPIN(xb_ld(&bar[XB_XGEN(b.x)]) == gen, bar);
            __builtin_amdgcn_fence(__ATOMIC_ACQUIRE, "agent");
            asm volatile("s_waitcnt vmcnt(0)" ::: "memory");
        }
    }
    __syncthreads();
}

namespace g8 {
constexpr int BM = 256, BK = 64, HALF = 128, HTB = HALF * BK * 2, STAGE_BYTES = 8 * HTB, NXCD = 8, WGM = 8;
__device__ __forceinline__ int lds_byte(int r, int c) { const int st = (r >> 4) * 2 + (c >> 5), rr = r & 15, cc = c & 31, ob = rr * 64 + cc * 2; return st * 1024 + (ob ^ (((ob >> 9) & 1) << 5)); }
__device__ __forceinline__ void stage_rc(int b, int& R, int& C) { const int st = b / 1024, sb = b % 1024, swz = sb ^ (((sb >> 9) & 1) << 5); R = (st >> 1) * 16 + swz / 64; C = (st & 1) * 32 + (swz % 64) / 2; }
__device__ __forceinline__ int perm32(int rho) { const int n = rho >> 4, i = rho & 15; return 8 * (i >> 2) + 4 * n + (i & 3); }

struct GUnit { const char* A; const char* B; int pm, pn, aux; };

__device__ __forceinline__ bool tile_map(int L, int nM, int nN, int& pm, int& pn) {
    const int nwg = nM * nN; if (L >= nwg) return false;
    int wgid = L; { const int q = nwg / NXCD, r = nwg % NXCD, xcd = wgid % NXCD, off = wgid / NXCD; wgid = (xcd < r ? xcd * (q + 1) : r * (q + 1) + (xcd - r) * q) + off; }
    const int nig = WGM * nN, gid = wgid / nig, fm = gid * WGM, gsz = (nM - fm) < WGM ? (nM - fm) : WGM;
    pm = fm + ((wgid % nig) % gsz); pn = (wgid % nig) / gsz; return true;
}

template <int K, class Epi, class Sched>
__device__ __forceinline__ void gemm_phase(LAS unsigned char* lds, const Sched& S, const Epi& E, const int tid) {
    const int wid = __builtin_amdgcn_readfirstlane(tid >> 6), lane = tid & 63, wr = wid >> 2, wc = wid & 3, fr = lane & 15, fq = lane >> 4;
    constexpr int nt = K / BK;
    unsigned voffB[2]; int sR[2], sC[2];
#pragma unroll
    for (int i = 0; i < 2; ++i) { int R, C; stage_rc(tid * 16 + i * 8192, R, C); const int Rb = Epi::PERM ? ((R & ~31) + perm32(R & 31)) : R;
        voffB[i] = (unsigned)(Rb * K + C) * 2u; sR[i] = R; sC[i] = C; }
    constexpr size_t kstep = (size_t)(BK * 2);
    constexpr size_t hstep = (size_t)HALF * K * 2;
    const unsigned ldsw = (unsigned)wid * 1024u;
    const int aoff = lds_byte(wr * 64 + fr, fq * 8), boff = lds_byte(wc * 32 + fr, fq * 8);
#define PG8_SA(b, h) (((b) * 2 + (h)) * HTB)
#define PG8_SB(b, h) ((4 + (b) * 2 + (h)) * HTB)
#define PG8_STAGE(bufoff, gbase, voff) do { _Pragma("unroll") for (int _i = 0; _i < 2; ++_i) \
        __builtin_amdgcn_global_load_lds((const unsigned*)((const char*)(gbase) + (voff)[_i]), (LAS unsigned*)(lds + (bufoff) + ldsw + _i * 8192), 16, 0, 0); } while (0)
#define PG8_LDA(dst, b, h) do { _Pragma("unroll") for (int m = 0; m < 4; ++m) _Pragma("unroll") for (int k = 0; k < 2; ++k) dst[m][k] = *(const LAS bf16x8*)(lds + PG8_SA(b, h) + aoff + m * 2048 + k * 1024); } while (0)
#define PG8_LDB(dst, b, h) do { _Pragma("unroll") for (int n = 0; n < 2; ++n) _Pragma("unroll") for (int k = 0; k < 2; ++k) dst[n][k] = *(const LAS bf16x8*)(lds + PG8_SB(b, h) + boff + n * 2048 + k * 1024); } while (0)
#define PG8_MMA(ai, bj, At, Bt) do { __builtin_amdgcn_s_setprio(1); _Pragma("unroll") for (int m = 0; m < 4; ++m) _Pragma("unroll") for (int n = 0; n < 2; ++n) _Pragma("unroll") for (int k = 0; k < 2; ++k) \
        acc[ai][bj][m][n] = __builtin_amdgcn_mfma_f32_16x16x32_bf16(Bt[n][k], At[m][k], acc[ai][bj][m][n], 0, 0, 0); __builtin_amdgcn_s_setprio(0); } while (0)
#define PG8_WAIT_V(n) asm volatile("s_waitcnt vmcnt(" #n ")" ::: "memory")
#define PG8_WAIT_L(n) asm volatile("s_waitcnt lgkmcnt(" #n ")" ::: "memory")
#define PG8_BAR __builtin_amdgcn_s_barrier()
#define PG8_SCHED __builtin_amdgcn_sched_barrier(0)
    GUnit cur, nxt; int ui = 0;
    if (!S.next(0, cur)) return;
    f32x4 acc[2][2][4][2];
#pragma unroll
    for (int a = 0; a < 2; ++a)
#pragma unroll
        for (int b = 0; b < 2; ++b)
#pragma unroll
            for (int m = 0; m < 4; ++m)
#pragma unroll
                for (int n = 0; n < 2; ++n) acc[a][b][m][n] = (f32x4){0.f, 0.f, 0.f, 0.f};
    bf16x8 At[4][2], B0[2][2], B1[2][2];
    unsigned ca0[2], ca1[2], na0[2], na1[2];
    S.aoff(cur, sR, sC, ca0, ca1);
    const char* cA = cur.A; const char* cB = cur.B;
    PG8_STAGE(PG8_SB(0, 0), cB, voffB); PG8_STAGE(PG8_SB(0, 1), cB + hstep, voffB); PG8_STAGE(PG8_SA(0, 0), cA, ca0); PG8_STAGE(PG8_SA(0, 1), cA, ca1);
    if (wr == 1) PG8_BAR;
    PG8_WAIT_V(2); PG8_BAR;
    PG8_STAGE(PG8_SB(1, 0), cB + kstep, voffB); PG8_STAGE(PG8_SA(1, 0), cA + kstep, ca0); PG8_STAGE(PG8_SB(1, 1), cB + hstep + kstep, voffB);
    PG8_WAIT_V(6); PG8_BAR;
    for (;;) {
        const bool has_next = S.next(ui + 1, nxt);
        if (has_next) S.aoff(nxt, sR, sC, na0, na1); else { na0[0] = ca0[0]; na0[1] = ca0[1]; na1[0] = ca1[0]; na1[1] = ca1[1]; }
        const char* nA = has_next ? nxt.A : cA; const char* nB = has_next ? nxt.B : cB;
        for (int t = 0; t < nt; t += 2) {
            const bool last = (t == nt - 2);
            const char* a1 = cA + (size_t)(t + 1) * kstep;
            const char* a2 = last ? nA : cA + (size_t)(t + 2) * kstep; const char* b2 = last ? nB : cB + (size_t)(t + 2) * kstep;
            const char* a3 = a2 + kstep; const char* b3 = b2 + kstep;
            unsigned xa0[2], xa1[2];
            xa0[0] = last ? na0[0] : ca0[0]; xa0[1] = last ? na0[1] : ca0[1]; xa1[0] = last ? na1[0] : ca1[0]; xa1[1] = last ? na1[1] : ca1[1];
            PG8_LDB(B0, 0, 0); PG8_LDB(B1, 0, 1); PG8_SCHED; PG8_LDA(At, 0, 0); PG8_STAGE(PG8_SA(1, 1), a1, ca1);
            PG8_WAIT_V(8); PG8_WAIT_L(0); PG8_BAR; PG8_MMA(0, 0, At, B0); PG8_MMA(0, 1, At, B1); PG8_BAR; PG8_SCHED;
            PG8_LDA(At, 0, 1); PG8_STAGE(PG8_SB(0, 0), b2, voffB); PG8_STAGE(PG8_SB(0, 1), b2 + hstep, voffB); PG8_STAGE(PG8_SA(0, 0), a2, xa0);
            PG8_WAIT_V(8); PG8_WAIT_L(0); PG8_BAR; PG8_MMA(1, 0, At, B0); PG8_MMA(1, 1, At, B1); PG8_BAR; PG8_SCHED;
            PG8_LDB(B0, 1, 0); PG8_LDB(B1, 1, 1); PG8_SCHED; PG8_LDA(At, 1, 0); PG8_STAGE(PG8_SA(0, 1), a2, xa1);
            PG8_WAIT_V(8); PG8_WAIT_L(0); PG8_BAR; PG8_MMA(0, 0, At, B0); PG8_MMA(0, 1, At, B1); PG8_BAR; PG8_SCHED;
            PG8_LDA(At, 1, 1); PG8_STAGE(PG8_SB(1, 0), b3, voffB); PG8_STAGE(PG8_SB(1, 1), b3 + hstep, voffB); PG8_STAGE(PG8_SA(1, 0), a3, xa0);
            PG8_WAIT_V(8); PG8_WAIT_L(0); PG8_BAR; PG8_MMA(1, 0, At, B0); PG8_MMA(1, 1, At, B1); PG8_BAR; PG8_SCHED;
        }
        if (wr == 0) PG8_BAR;
        E(acc, cur, wr, wc, fr, fq);
        if (!has_next) break;
#pragma unroll
        for (int a = 0; a < 2; ++a)
#pragma unroll
            for (int b = 0; b < 2; ++b)
#pragma unroll
                for (int m = 0; m < 4; ++m)
#pragma unroll
                    for (int n = 0; n < 2; ++n) acc[a][b][m][n] = (f32x4){0.f, 0.f, 0.f, 0.f};
        cur = nxt; cA = nA; cB = nB; ca0[0] = na0[0]; ca0[1] = na0[1]; ca1[0] = na1[0]; ca1[1] = na1[1]; ++ui;
        if (wr == 1) PG8_BAR;
    }
    PG8_WAIT_V(0);
    PG8_BAR;
#undef PG8_SA
#undef PG8_SB
#undef PG8_STAGE
#undef PG8_LDA
#undef PG8_LDB
#undef PG8_MMA
#undef PG8_WAIT_V
#undef PG8_WAIT_L
#undef PG8_BAR
#undef PG8_SCHED
}

template <int K> struct SchedDense {
    const char* A; const char* B; int nM, nN, G, c, extra, xpn;
    __device__ __forceinline__ bool next(int i, GUnit& u) const {
        const int L = i * G + c; int pm, pn;
        if (!tile_map(L, nM, nN, pm, pn)) { const int j = L - nM * nN; if (j >= extra) return false; pm = nM + j; pn = xpn; }
        u.pm = pm; u.pn = pn; u.aux = 0; u.A = A + (size_t)pm * 256 * K * 2; u.B = B + (size_t)pn * 256 * K * 2; return true;
    }
    __device__ __forceinline__ void aoff(const GUnit&, const int (&sR)[2], const int (&sC)[2], unsigned (&o0)[2], unsigned (&o1)[2]) const {
#pragma unroll
        for (int i = 0; i < 2; ++i) { o0[i] = (unsigned)(sR[i] * K + sC[i]) * 2u; o1[i] = (unsigned)((128 + sR[i]) * K + sC[i]) * 2u; }
    }
};
struct SchedBranch {
    const char* A0; const char* B0; size_t sa, sb; int nM, G, c;
    __device__ __forceinline__ bool next(int i, GUnit& u) const {
        const int ti = i / 3, br = i - 3 * ti; const int L = ti * G + c; int pm, pn;
        if (!tile_map(L, nM, 4, pm, pn)) return false;
        u.pm = pm; u.pn = pn; u.aux = br;
        u.A = A0 + (size_t)br * sa + (size_t)pm * 256 * 1024; u.B = B0 + (size_t)br * sb + (size_t)pn * 256 * 1024; return true;
    }
    __device__ __forceinline__ void aoff(const GUnit&, const int (&sR)[2], const int (&sC)[2], unsigned (&o0)[2], unsigned (&o1)[2]) const {
#pragma unroll
        for (int i = 0; i < 2; ++i) { o0[i] = (unsigned)(sR[i] * 512 + sC[i]) * 2u; o1[i] = (unsigned)((128 + sR[i]) * 512 + sC[i]) * 2u; }
    }
};
template <bool GATHER> struct SchedMoE {
    const char* A; const char* W; size_t wexp; const unsigned* list; const LAS unsigned* tab; int nN, G, c;
    __device__ __forceinline__ bool next(int i, GUnit& u) const {
        const int L = i * G + c; int pm, pn; const int nM = (int)tab[64];
        if (!tile_map(L, nM, nN, pm, pn)) return false;
        const int e = __builtin_amdgcn_readfirstlane((int)tab[96 + pm]);
        u.pm = pm; u.pn = pn; u.aux = e; u.B = W + (size_t)e * wexp + (size_t)pn * 256 * 2048;
        u.A = GATHER ? A : A + (size_t)pm * 256 * 2048; return true;
    }
    __device__ __forceinline__ void aoff(const GUnit& u, const int (&sR)[2], const int (&sC)[2], unsigned (&o0)[2], unsigned (&o1)[2]) const {
        if (GATHER) {
            const int e = u.aux; const int n_e = (int)tab[e]; const int idx0 = (u.pm - (int)tab[32 + e]) * 256;
            const unsigned* le = list + (size_t)e * TA;
#pragma unroll
            for (int i = 0; i < 2; ++i) {
                const int i0 = idx0 + sR[i], i1 = i0 + 128;
                const unsigned t0 = i0 < n_e ? le[i0] : 0u, t1 = i1 < n_e ? le[i1] : 0u;
                o0[i] = (t0 * 1024u + (unsigned)sC[i]) * 2u; o1[i] = (t1 * 1024u + (unsigned)sC[i]) * 2u; }
        } else {
#pragma unroll
            for (int i = 0; i < 2; ++i) { o0[i] = (unsigned)(sR[i] * 1024 + sC[i]) * 2u; o1[i] = (unsigned)((128 + sR[i]) * 1024 + sC[i]) * 2u; }
        }
    }
};

struct EpiInProj {
    static constexpr bool PERM = true;
    bf16_t* aglu; bf16_t* q; bf16_t* k; bf16_t* vt; bf16_t* u; bf16_t* g; const float* bgate; const float* rope;
    __device__ __forceinline__ void operator()(const f32x4 (&acc)[2][2][4][2], const GUnit& un, int wr, int wc, int fr, int fq) const {
        const int pn = un.pn; const int row0 = un.pm * 256 + wr * 64 + fr; const bool isx = un.pm < NTX;
        if (pn < 4) {
#pragma unroll
            for (int ai = 0; ai < 2; ++ai)
#pragma unroll
                for (int m = 0; m < 4; ++m) { const int row = row0 + ai * 128 + m * 16; f32x4 o0, o1;
#pragma unroll
                    for (int j = 0; j < 4; ++j) { o0[j] = acc[ai][0][m][0][j] * sigmoidf_(acc[ai][1][m][0][j]); o1[j] = acc[ai][0][m][1][j] * sigmoidf_(acc[ai][1][m][1][j]); }
                    *(u32x4*)(aglu + (size_t)row * 512 + pn * 128 + wc * 32 + fq * 8) = pack8(o0, o1); }
        } else if (pn < 6 || (pn == 6 && wc < 2)) {
            bf16_t* dst; int ld, c0;
            if (pn < 6) { dst = q; ld = 512; c0 = ((pn - 4) * 4 + wc) * 64 + fq * 8; } else { dst = k; ld = 128; c0 = wc * 64 + fq * 8; }
#pragma unroll
            for (int ai = 0; ai < 2; ++ai)
#pragma unroll
                for (int m = 0; m < 4; ++m) { const int row = row0 + ai * 128 + m * 16;
                    f32x4 x1a = acc[ai][0][m][0], x1b = acc[ai][0][m][1], x2a = acc[ai][1][m][0], x2b = acc[ai][1][m][1];
                    if (isx) { const int s = row & (SEQ - 1); const float* cp = rope + (size_t)s * 32 + fq * 8; const float* sp = cp + 8192 * 32;
                        const f32x4 ca = *(const f32x4*)cp, cb = *(const f32x4*)(cp + 4), sa = *(const f32x4*)sp, sb = *(const f32x4*)(sp + 4);
                        const f32x4 o1a = x1a * ca - x2a * sa, o1b = x1b * cb - x2b * sb, o2a = x2a * ca + x1a * sa, o2b = x2b * cb + x1b * sb;
                        x1a = o1a; x1b = o1b; x2a = o2a; x2b = o2b; }
                    *(u32x4*)(dst + (size_t)row * ld + c0) = pack8(x1a, x1b);
                    *(u32x4*)(dst + (size_t)row * ld + c0 + 32) = pack8(x2a, x2b); }
        } else if (pn == 6) {
            const int d0 = (wc - 2) * 32 + fq * 8;
#pragma unroll
            for (int ai = 0; ai < 2; ++ai)
#pragma unroll
                for (int m = 0; m < 4; ++m) { const int row = row0 + ai * 128 + m * 16;
#pragma unroll
                    for (int bj = 0; bj < 2; ++bj) {
                        bf16_t* base; size_t st;
                        if (isx) { const int b = row >> 13, s = row & (SEQ - 1); base = vt + ((size_t)((b * 2 + bj) * 64 + d0)) * SEQ + perm16(s); st = SEQ; }
                        else { const int zz = row - TX, b = zz >> 8, cp = zz & 255; base = vt + (size_t)TX * 128 + ((size_t)((b * 2 + bj) * 64 + d0)) * CTXL + perm16(cp); st = CTXL; }
#pragma unroll
                        for (int j = 0; j < 4; ++j) { base[(size_t)j * st] = (bf16_t)f2bf(acc[ai][bj][m][0][j]); base[(size_t)(4 + j) * st] = (bf16_t)f2bf(acc[ai][bj][m][1][j]); } } }
        } else if (pn < 9) {
#pragma unroll
            for (int ai = 0; ai < 2; ++ai)
#pragma unroll
                for (int m = 0; m < 4; ++m) { const int row = row0 + ai * 128 + m * 16;
#pragma unroll
                    for (int bj = 0; bj < 2; ++bj) *(u32x4*)(u + (size_t)row * 512 + (pn - 7) * 256 + bj * 128 + wc * 32 + fq * 8) = pack8(acc[ai][bj][m][0], acc[ai][bj][m][1]); }
        } else {
            const int gc0 = (pn - 9) * 256 + wc * 32 + fq * 8;
            f32x4 bv[2][2];
#pragma unroll
            for (int bj = 0; bj < 2; ++bj)
#pragma unroll
                for (int n = 0; n < 2; ++n) bv[bj][n] = *(const f32x4*)(bgate + gc0 + bj * 128 + 4 * n);
#pragma unroll
            for (int ai = 0; ai < 2; ++ai)
#pragma unroll
                for (int m = 0; m < 4; ++m) { const int row = row0 + ai * 128 + m * 16;
#pragma unroll
                    for (int bj = 0; bj < 2; ++bj) { f32x4 o0, o1;
#pragma unroll
                        for (int j = 0; j < 4; ++j) { o0[j] = sigmoidf_(acc[ai][bj][m][0][j] + bv[bj][0][j]); o1[j] = sigmoidf_(acc[ai][bj][m][1][j] + bv[bj][1][j]); }
                        *(u32x4*)(g + (size_t)row * 3072 + gc0 + bj * 128) = pack8(o0, o1); } }
        }
    }
};
struct EpiBranch {
    static constexpr bool PERM = true;
    const bf16_t* g; bf16_t* mg;
    __device__ __forceinline__ void operator()(const f32x4 (&acc)[2][2][4][2], const GUnit& un, int wr, int wc, int fr, int fq) const {
        const int br = un.aux; const int row0 = un.pm * 256 + wr * 64 + fr; const int c0 = un.pn * 256 + wc * 32 + fq * 8;
#pragma unroll
        for (int ai = 0; ai < 2; ++ai)
#pragma unroll
            for (int m = 0; m < 4; ++m) { const int row = row0 + ai * 128 + m * 16;
#pragma unroll
                for (int bj = 0; bj < 2; ++bj) {
                    const u32x4 gw = *(const u32x4*)(g + (size_t)row * 3072 + br * 1024 + c0 + bj * 128);
                    f32x4 ga, gb; unpack8(gw, ga, gb);
                    f32x4 o0 = ga * acc[ai][bj][m][0], o1 = gb * acc[ai][bj][m][1];
                    bf16_t* mp = mg + (size_t)row * 1024 + c0 + bj * 128;
                    if (br != 0) { const u32x4 pw = *(const u32x4*)mp; f32x4 pa, pb; unpack8(pw, pa, pb); o0 += pa; o1 += pb; }
                    *(u32x4*)mp = pack8(o0, o1); }
                asm volatile("" ::: "memory"); }
    }
};
struct EpiWout {
    static constexpr bool PERM = false;
    const float* resx; const float* resz; float* X; const float* modl; int first;
    __device__ __forceinline__ void operator()(const f32x4 (&acc)[2][2][4][2], const GUnit& un, int wr, int wc, int fr, int fq) const {
        const int row0 = un.pm * 256 + wr * 64 + fr; const int c0 = un.pn * 256 + wc * 32 + fq * 4; const bool isx = un.pm < NTX;
        const int ms = isx ? (un.pm >> 5) : 8;
        const float* gp = modl + (size_t)ms * 6144 + 2 * 1024 + c0;
        f32x4 gv[2][2];
#pragma unroll
        for (int bj = 0; bj < 2; ++bj)
#pragma unroll
            for (int n = 0; n < 2; ++n) gv[bj][n] = *(const f32x4*)(gp + bj * 128 + n * 16);
#pragma unroll
        for (int ai = 0; ai < 2; ++ai)
#pragma unroll
            for (int m = 0; m < 4; ++m) { const int row = row0 + ai * 128 + m * 16;
                const float* rp = first ? (isx ? resx + (size_t)row * 1024 : resz + (size_t)(row - TX) * 1024) : X + (size_t)row * 1024;
#pragma unroll
                for (int bj = 0; bj < 2; ++bj)
#pragma unroll
                    for (int n = 0; n < 2; ++n) { const f32x4 r = *(const f32x4*)(rp + c0 + bj * 128 + n * 16);
                        *(f32x4*)(X + (size_t)row * 1024 + c0 + bj * 128 + n * 16) = r + gv[bj][n] * acc[ai][bj][m][n]; }
                asm volatile("" ::: "memory"); }
    }
};
struct EpiGU {
    static constexpr bool PERM = true;
    bf16_t* act; const float* bgu;
    __device__ __forceinline__ void operator()(const f32x4 (&acc)[2][2][4][2], const GUnit& un, int wr, int wc, int fr, int fq) const {
        const int e = un.aux; const int row0 = un.pm * 256 + wr * 64 + fr; const int c0 = un.pn * 128 + wc * 32 + fq * 8;
        const float* bp = bgu + (size_t)e * 2048 + c0;
        const f32x4 bg0 = *(const f32x4*)bp, bg1 = *(const f32x4*)(bp + 4), bu0 = *(const f32x4*)(bp + 1024), bu1 = *(const f32x4*)(bp + 1028);
#pragma unroll
        for (int ai = 0; ai < 2; ++ai)
#pragma unroll
            for (int m = 0; m < 4; ++m) { const int row = row0 + ai * 128 + m * 16; f32x4 o0, o1;
#pragma unroll
                for (int j = 0; j < 4; ++j) {
                    float g0 = fminf(acc[ai][0][m][0][j] + bg0[j], 7.0f), u0 = fminf(fmaxf(acc[ai][1][m][0][j] + bu0[j], -7.0f), 7.0f);
                    float g1 = fminf(acc[ai][0][m][1][j] + bg1[j], 7.0f), u1 = fminf(fmaxf(acc[ai][1][m][1][j] + bu1[j], -7.0f), 7.0f);
                    o0[j] = (u0 + 1.0f) * (g0 * sigmoidf_(1.702f * g0)); o1[j] = (u1 + 1.0f) * (g1 * sigmoidf_(1.702f * g1)); }
                *(u32x4*)(act + (size_t)row * 1024 + c0) = pack8(o0, o1); }
    }
};
struct EpiDown {
    static constexpr bool PERM = true;
    bf16_t* y; const float* bdn;
    __device__ __forceinline__ void operator()(const f32x4 (&acc)[2][2][4][2], const GUnit& un, int wr, int wc, int fr, int fq) const {
        const int e = un.aux; const int row0 = un.pm * 256 + wr * 64 + fr; const int c0 = un.pn * 256 + wc * 32 + fq * 8;
        const float* bp = bdn + (size_t)e * 1024 + c0;
        f32x4 bv[2][2];
#pragma unroll
        for (int bj = 0; bj < 2; ++bj)
#pragma unroll
            for (int n = 0; n < 2; ++n) bv[bj][n] = *(const f32x4*)(bp + bj * 128 + 4 * n);
#pragma unroll
        for (int ai = 0; ai < 2; ++ai)
#pragma unroll
            for (int m = 0; m < 4; ++m) { const int row = row0 + ai * 128 + m * 16;
#pragma unroll
                for (int bj = 0; bj < 2; ++bj) *(u32x4*)(y + (size_t)row * 1024 + c0 + bj * 128) = pack8(acc[ai][bj][m][0] + bv[bj][0], acc[ai][bj][m][1] + bv[bj][1]); }
    }
};
}

struct Args { const float* in[28]; float* out; unsigned char* ws; int ph_lo, ph_hi; };
struct Frame {
    LAS unsigned char* lds; unsigned char* ws; unsigned* ctl;
    int tid, lane, wave, vcu, G;
};

__device__ __forceinline__ int colmap_in(int n) {
    const int pn = n >> 8, lc = n & 255, bj = lc >> 7, c = lc & 127;
    if (pn < 4) return bj * 512 + pn * 128 + c;
    if (pn < 6) return 1024 + ((pn - 4) * 4 + (c >> 5)) * 64 + bj * 32 + (c & 31);
    if (pn == 6) return c < 64 ? 1536 + (c >> 5) * 64 + bj * 32 + (c & 31) : 1664 + bj * 64 + (c - 64);
    if (pn < 9) return 1792 + (pn - 7) * 256 + lc;
    return 2304 + (pn - 9) * 256 + lc;
}
__device__ __forceinline__ void transpose_item(const float* src, int ld, int k0, int c0, bf16_t* dst, int r0, int Kd, LAS float* scr, int lane) {
#pragma unroll 8
    for (int i = 0; i < 32; ++i) { const int kk = 2 * i + (lane >> 5); scr[kk * 33 + (lane & 31)] = src[(size_t)(k0 + kk) * ld + c0 + (lane & 31)]; }
    asm volatile("s_waitcnt lgkmcnt(0)" ::: "memory");
    const int c = lane & 7;
#pragma unroll
    for (int j = 0; j < 4; ++j) { const int n = (lane >> 3) + 8 * j; const LAS float* s = scr + (8 * c) * 33 + n;
        u32x4 o; o.x = pk2(s[0 * 33], s[1 * 33]); o.y = pk2(s[2 * 33], s[3 * 33]); o.z = pk2(s[4 * 33], s[5 * 33]); o.w = pk2(s[6 * 33], s[7 * 33]);
        *(u32x4*)(dst + (size_t)(r0 + n) * Kd + k0 + 8 * c) = o; }
    asm volatile("s_waitcnt lgkmcnt(0)" ::: "memory");
}
__device__ __forceinline__ void p_prologue(Frame& F, const Args& a) {
    float* mod = (float*)(F.ws + WS_MOD);
    if (blockIdx.x < 192) {
        const int l = blockIdx.x / 96, n0 = (blockIdx.x % 96) * 64;
        LAS float* sc = (LAS float*)F.lds; LAS float* part = (LAS float*)(F.lds + 36864);
        for (int i = F.tid; i < 9 * 1024; i += 512) { const float v = i < 8192 ? a.in[1][i] : a.in[3][i - 8192]; sc[i] = v * sigmoidf_(v); }
        __syncthreads();
        const int ks = F.tid >> 6, col = F.tid & 63;
        float accv[9];
#pragma unroll
        for (int s = 0; s < 9; ++s) accv[s] = 0.f;
        const float* wp = a.in[4] + (size_t)l * 1024 * 6144 + n0 + col;
        for (int k = ks * 128; k < ks * 128 + 128; ++k) { const float w = wp[(size_t)k * 6144];
#pragma unroll
            for (int s = 0; s < 9; ++s) accv[s] += sc[s * 1024 + k] * w; }
#pragma unroll
        for (int s = 0; s < 9; ++s) part[(ks * 9 + s) * 64 + col] = accv[s];
        __syncthreads();
        for (int i = F.tid; i < 576; i += 512) { const int s = i >> 6, cc = i & 63; float v = a.in[5][l * 6144 + n0 + cc];
#pragma unroll
            for (int k2 = 0; k2 < 8; ++k2) v += part[(k2 * 9 + s) * 64 + cc];
            mod[(size_t)(l * 9 + s) * 6144 + n0 + cc] = v; }
        __syncthreads();
    }
    {
        const double inv[16] = {1.0, 0.5623413251903491, 0.31622776601683794, 0.1778279410038923, 0.1, 0.05623413251903491, 0.03162277660168379, 0.01778279410038923,
                                0.01, 0.005623413251903491, 0.0031622776601683794, 0.0017782794100389228, 0.001, 0.0005623413251903491, 0.00031622776601683794, 0.00017782794100389227};
        float* rope = (float*)(F.ws + WS_ROPE);
        for (int idx = F.vcu * 512 + F.tid; idx < 8192 * 32; idx += F.G * 512) {
            const int s = idx >> 5, dd = idx & 31; const int pos = dd < 16 ? (s >> 6) : (s & 63); const int i = dd & 15;
            double iv = inv[0];
#pragma unroll
            for (int q = 1; q < 16; ++q) iv = (i == q) ? inv[q] : iv;
            const double ang = (double)((float)pos * (float)iv);
            double rev = ang * 0.15915494309189535; rev -= __builtin_rint(rev); const double r = rev * 6.283185307179586, r2 = r * r;
            double sn = -1.0 / 51090942171709440000.0;
            sn = sn * r2 + 1.0 / 121645100408832000.0; sn = sn * r2 - 1.0 / 355687428096000.0; sn = sn * r2 + 1.0 / 1307674368000.0; sn = sn * r2 - 1.0 / 6227020800.0;
            sn = sn * r2 + 1.0 / 39916800.0; sn = sn * r2 - 1.0 / 362880.0; sn = sn * r2 + 1.0 / 5040.0; sn = sn * r2 - 1.0 / 120.0; sn = sn * r2 + 1.0 / 6.0; sn = sn * r2 - 1.0; sn = -sn * r;
            double cs = 1.0 / 1124000727777607680000.0;
            cs = cs * r2 - 1.0 / 2432902008176640000.0; cs = cs * r2 + 1.0 / 6402373705728000.0; cs = cs * r2 - 1.0 / 20922789888000.0; cs = cs * r2 + 1.0 / 87178291200.0;
            cs = cs * r2 - 1.0 / 479001600.0; cs = cs * r2 + 1.0 / 3628800.0; cs = cs * r2 - 1.0 / 40320.0; cs = cs * r2 + 1.0 / 720.0; cs = cs * r2 - 1.0 / 24.0; cs = cs * r2 + 0.5; cs = 1.0 - cs * r2;
            rope[idx] = (float)cs; rope[8192 * 32 + idx] = (float)sn;
        }
    }
    const int gw = F.vcu * 8 + F.wave, NGW = F.G * 8;
    for (int it = gw; it < 2048; it += NGW) {
        const int l = it >> 10, r = it & 1023, g = r >> 8, c0 = ((r & 255) >> 4) * 8, n = (r & 15) * 64 + F.lane;
        const float* wp = a.in[16] + ((size_t)(l * 4 + g) * 128 + c0) * 128; const float* ps = a.in[17] + l * 512 + g * 128; const float* wo = a.in[18] + ((size_t)l * 512 + g * 128) * 1024 + n;
        float accv[8];
#pragma unroll
        for (int i = 0; i < 8; ++i) accv[i] = 0.f;
        for (int d = 0; d < 128; ++d) { const float wv = wo[(size_t)d * 1024] * ps[d];
#pragma unroll
            for (int i = 0; i < 8; ++i) accv[i] += wp[i * 128 + d] * wv; }
        bf16_t* dst = (bf16_t*)(F.ws + WS_W + (size_t)l * W_LAYER + W_PE) + (size_t)n * 512 + g * 128 + c0;
        u32x4 o; o.x = pk2(accv[0], accv[1]); o.y = pk2(accv[2], accv[3]); o.z = pk2(accv[4], accv[5]); o.w = pk2(accv[6], accv[7]);
        *(u32x4*)dst = o;
    }
    LAS float* scr = (LAS float*)(F.lds + F.wave * 16384);
    constexpr int I_IN = 16 * 168, I_P = 8 * 32, I_O = 16 * 32, I_GU = 32 * 1024, I_DN = 32 * 512, I_L = I_IN + 2 * I_P + I_O + I_GU + I_DN;
    for (int it = gw; it < 2 * I_L; it += NGW) {
        const int l = it / I_L; int r = it - l * I_L; unsigned char* wl = F.ws + WS_W + (size_t)l * W_LAYER;
        if (r < I_IN) { const int kb = r / 168, nb = r % 168; transpose_item(a.in[7] + (size_t)l * 1024 * DIN, DIN, kb * 64, colmap_in(nb * 32), (bf16_t*)(wl + W_IN), nb * 32, 1024, scr, F.lane); continue; } r -= I_IN;
        if (r < I_P) { const int kb = r / 32, nb = r % 32; transpose_item(a.in[13] + (size_t)l * 512 * 1024, 1024, kb * 64, nb * 32, (bf16_t*)(wl + W_CO), nb * 32, 512, scr, F.lane); continue; } r -= I_P;
        if (r < I_P) { const int kb = r / 32, nb = r % 32; transpose_item(a.in[15] + (size_t)l * 512 * 1024, 1024, kb * 64, nb * 32, (bf16_t*)(wl + W_AO), nb * 32, 512, scr, F.lane); continue; } r -= I_P;
        if (r < I_O) { const int kb = r / 32, nb = r % 32; transpose_item(a.in[19] + (size_t)l * 1024 * 1024, 1024, kb * 64, nb * 32, (bf16_t*)(wl + W_OUT), nb * 32, 1024, scr, F.lane); continue; } r -= I_O;
        if (r < I_GU) { const int e = r >> 10, rr = r & 1023, kb = rr >> 6, nb = rr & 63, n0 = nb * 32; const int pn = n0 >> 8, lc = n0 & 255, c0 = (lc >> 7) * 1024 + pn * 128 + (lc & 127);
            transpose_item(a.in[23] + (size_t)(l * 32 + e) * 1024 * 2048, 2048, kb * 64, c0, (bf16_t*)(wl + W_GU + (size_t)e * W_GU_E), n0, 1024, scr, F.lane); continue; } r -= I_GU;
        { const int e = r >> 9, rr = r & 511, kb = rr >> 5, nb = rr & 31;
            transpose_item(a.in[25] + (size_t)(l * 32 + e) * 1024 * 1024, 1024, kb * 64, nb * 32, (bf16_t*)(wl + W_DN + (size_t)e * W_DN_E), nb * 32, 1024, scr, F.lane); }
    }
}

__device__ __forceinline__ void p_norm0(Frame& F, const Args& a) {
    const float* mod = (const float*)(F.ws + WS_MOD); bf16_t* H = (bf16_t*)(F.ws + WS_H);
    const int gw = F.vcu * 8 + F.wave, NGW = F.G * 8;
    for (int row = gw; row < TA; row += NGW) {
        const bool isx = row < TX; const float* src = isx ? a.in[0] + (size_t)row * 1024 : a.in[2] + (size_t)(row - TX) * 1024; const int ms = isx ? (row >> 13) : 8;
        f32x4 v[4]; float ss = 0.f;
#pragma unroll
        for (int j = 0; j < 4; ++j) { v[j] = *(const f32x4*)(src + F.lane * 4 + 256 * j); ss += (v[j][0] * v[j][0] + v[j][1] * v[j][1]) + (v[j][2] * v[j][2] + v[j][3] * v[j][3]); }
        const float rstd = 1.0f / sqrtf(wave_sum(ss) * (1.0f / 1024.0f) + EPS);
        const float* mp = mod + (size_t)ms * 6144;
#pragma unroll
        for (int j = 0; j < 4; ++j) { const int c = F.lane * 4 + 256 * j;
            const f32x4 g = *(const f32x4*)(a.in[6] + c), sh = *(const f32x4*)(mp + c), sc = *(const f32x4*)(mp + 1024 + c);
            const f32x4 h = (v[j] * rstd * g) * (sc + 1.0f) + sh;
            u32x2 o; o.x = pk2(h[0], h[1]); o.y = pk2(h[2], h[3]); *(u32x2*)(H + (size_t)row * 1024 + c) = o; }
    }
}

constexpr int AT_ROWB = 144;
constexpr int AT_TILEB = 64 * AT_ROWB;
__device__ __forceinline__ int crow(int r, int hi) { return (r & 3) + 8 * (r >> 2) + 4 * hi; }
__device__ __forceinline__ void attn_unit(Frame& F, const bf16_t* Q, const bf16_t* Kb, const bf16_t* VT, bf16_t* AT, const float* sink, bool isz, int b, int n, int kvh, int gh) {
    const int tid = F.tid, lane = F.lane, wave = F.wave, r32 = lane & 31, hi = lane >> 5;
    const int qq = wave & 3, head = kvh * 4 + gh * 2 + (wave >> 2);
    const int qrow = (isz ? TX + b * CTXL : b * SEQ) + n * 128 + qq * 32;
    bf16x8 qf[4];
#pragma unroll
    for (int ks = 0; ks < 4; ++ks) qf[ks] = *(const bf16x8*)(Q + (size_t)(qrow + r32) * 512 + head * 64 + ks * 16 + hi * 8);
    const float c2 = 0.125f * LOG2E;
    float mrun = sink[head] * LOG2E, lrun = (hi == 0) ? 1.0f : 0.0f;
    f32x16 o0, o1;
#pragma unroll
    for (int r = 0; r < 16; ++r) { o0[r] = 0.f; o1[r] = 0.f; }
    const int ntile = isz ? 4 : 10 - (n == 0 ? 2 : 0) - (n == SEQ / 128 - 1 ? 2 : 0);
    const int srow = tid >> 3, chunk = tid & 7;
    LAS unsigned char* KS = F.lds; LAS unsigned char* VS = F.lds + 2 * AT_TILEB;
#define AT_DESC(ti, cc, ksrc, vsrc) do { int c_ = (ti); if (isz) c_ += 6; else { if (n == 0) c_ += 2; if (n == SEQ / 128 - 1 && c_ >= 4) c_ += 2; } cc = c_; \
        if (c_ < 6) { const int blk = n - 1 + (c_ >> 1), j0_ = (c_ & 1) * 64; ksrc = Kb + (size_t)(b * SEQ + blk * 128 + j0_ + srow) * 128 + kvh * 64 + chunk * 8; \
                      vsrc = VT + ((size_t)((b * 2 + kvh) * 64 + srow)) * SEQ + blk * 128 + j0_ + chunk * 8; } \
        else { const int j0_ = (c_ - 6) * 64; ksrc = Kb + (size_t)(TX + b * CTXL + j0_ + srow) * 128 + kvh * 64 + chunk * 8; \
               vsrc = VT + (size_t)TX * 128 + ((size_t)((b * 2 + kvh) * 64 + srow)) * CTXL + j0_ + chunk * 8; } } while (0)
    int ccur; const bf16_t* ksrc; const bf16_t* vsrc;
    AT_DESC(0, ccur, ksrc, vsrc);
    u32x4 kreg = *(const u32x4*)ksrc, vreg = *(const u32x4*)vsrc;
    *(LAS u32x4*)(KS + srow * AT_ROWB + chunk * 16) = kreg; *(LAS u32x4*)(VS + srow * AT_ROWB + chunk * 16) = vreg;
    __syncthreads();
    const int qi = qq * 32 + r32;
    for (int ti = 0; ti < ntile; ++ti) {
        const int buf = ti & 1; int cnext = 0;
        if (ti + 1 < ntile) { AT_DESC(ti + 1, cnext, ksrc, vsrc); kreg = *(const u32x4*)ksrc; vreg = *(const u32x4*)vsrc; }
        const int type = ccur < 2 ? 0 : (ccur < 4 ? 1 : (ccur < 6 ? 2 : 3));
        const int j0 = (ccur & 1) * 64;
        const bool skip = (type == 0 && j0 == 0 && qq >= 2) || (type == 2 && j0 == 64 && qq < 2);
        if (!skip) {
            const LAS unsigned char* kb_ = KS + buf * AT_TILEB + r32 * AT_ROWB + hi * 16;
            const LAS unsigned char* vb_ = VS + buf * AT_TILEB + r32 * AT_ROWB + hi * 16;
            f32x16 s0, s1;
#pragma unroll
            for (int r = 0; r < 16; ++r) { s0[r] = 0.f; s1[r] = 0.f; }
#pragma unroll
            for (int ks = 0; ks < 4; ++ks) {
                const bf16x8 k0 = *(const LAS bf16x8*)(kb_ + ks * 32), k1 = *(const LAS bf16x8*)(kb_ + 32 * AT_ROWB + ks * 32);
                s0 = __builtin_amdgcn_mfma_f32_32x32x16_bf16(k0, qf[ks], s0, 0, 0, 0);
                s1 = __builtin_amdgcn_mfma_f32_32x32x16_bf16(k1, qf[ks], s1, 0, 0, 0);
            }
            if (type == 0) {
#pragma unroll
                for (int r = 0; r < 16; ++r) { const int jj = j0 + crow(r, hi); if (jj < qi) s0[r] = -1e30f; if (jj + 32 < qi) s1[r] = -1e30f; }
            } else if (type == 2) {
#pragma unroll
                for (int r = 0; r < 16; ++r) { const int jj = j0 + crow(r, hi); if (jj > qi) s0[r] = -1e30f; if (jj + 32 > qi) s1[r] = -1e30f; }
            }
            float tm = fmaxf(s0[0], s1[0]);
#pragma unroll
            for (int r = 1; r < 16; ++r) tm = fmaxf(tm, fmaxf(s0[r], s1[r]));
            tm = fmaxf(tm, __shfl_xor(tm, 32));
            const float mn = fmaxf(mrun, tm * c2);
            const float alpha = __builtin_amdgcn_exp2f(mrun - mn);
            mrun = mn;
            float ls = 0.f;
#pragma unroll
            for (int r = 0; r < 16; ++r) { s0[r] = __builtin_amdgcn_exp2f(s0[r] * c2 - mn); s1[r] = __builtin_amdgcn_exp2f(s1[r] * c2 - mn); ls += s0[r] + s1[r]; }
            lrun = lrun * alpha + ls;
#pragma unroll
            for (int r = 0; r < 16; ++r) { o0[r] *= alpha; o1[r] *= alpha; }
            u32x4 pw[4];
            pw[0] = (u32x4){pk2(s0[0], s0[1]), pk2(s0[2], s0[3]), pk2(s0[4], s0[5]), pk2(s0[6], s0[7])};
            pw[1] = (u32x4){pk2(s0[8], s0[9]), pk2(s0[10], s0[11]), pk2(s0[12], s0[13]), pk2(s0[14], s0[15])};
            pw[2] = (u32x4){pk2(s1[0], s1[1]), pk2(s1[2], s1[3]), pk2(s1[4], s1[5]), pk2(s1[6], s1[7])};
            pw[3] = (u32x4){pk2(s1[8], s1[9]), pk2(s1[10], s1[11]), pk2(s1[12], s1[13]), pk2(s1[14], s1[15])};
#pragma unroll
            for (int kk = 0; kk < 4; ++kk) {
                const bf16x8 v0 = *(const LAS bf16x8*)(vb_ + kk * 32), v1 = *(const LAS bf16x8*)(vb_ + 32 * AT_ROWB + kk * 32);
                o0 = __builtin_amdgcn_mfma_f32_32x32x16_bf16(v0, __builtin_bit_cast(bf16x8, pw[kk]), o0, 0, 0, 0);
                o1 = __builtin_amdgcn_mfma_f32_32x32x16_bf16(v1, __builtin_bit_cast(bf16x8, pw[kk]), o1, 0, 0, 0);
            }
        }
        if (ti + 1 < ntile) {
            *(LAS u32x4*)(KS + (buf ^ 1) * AT_TILEB + srow * AT_ROWB + chunk * 16) = kreg; *(LAS u32x4*)(VS + (buf ^ 1) * AT_TILEB + srow * AT_ROWB + chunk * 16) = vreg;
        }
        ccur = cnext;
        __syncthreads();
    }
#undef AT_DESC
    {
        const float lt = lrun + __shfl_xor(lrun, 32); const float inv = 1.0f / lt;
        bf16_t* op = AT + (size_t)(qrow + r32) * 512 + head * 64 + 4 * hi;
#pragma unroll
        for (int gi = 0; gi < 4; ++gi) { u32x2 w; w.x = pk2(o0[4 * gi] * inv, o0[4 * gi + 1] * inv); w.y = pk2(o0[4 * gi + 2] * inv, o0[4 * gi + 3] * inv); *(u32x2*)(op + 8 * gi) = w;
            u32x2 w2; w2.x = pk2(o1[4 * gi] * inv, o1[4 * gi + 1] * inv); w2.y = pk2(o1[4 * gi + 2] * inv, o1[4 * gi + 3] * inv); *(u32x2*)(op + 32 + 8 * gi) = w2; }
    }
}

__device__ __forceinline__ void conv_task(Frame& F, int tk, const bf16_t* AG, bf16_t* AC, const LAS float* wl, const float* bdw, const float* lng, const float* lnb) {
    const int t0 = tk * 8; int s0, s1;
    if (t0 < TX) { s0 = t0 & ~(SEQ - 1); s1 = s0 + SEQ; } else { s0 = TX + ((t0 - TX) & ~(CTXL - 1)); s1 = s0 + CTXL; }
    const int cA = 4 * F.lane;
    float acc[8][8];
#pragma unroll
    for (int o = 0; o < 8; ++o)
#pragma unroll
        for (int i = 0; i < 8; ++i) acc[o][i] = 0.f;
#pragma unroll 1
    for (int r = -15; r <= 22; ++r) {
        const int row = t0 + r; const bool inr = row >= s0 && row < s1; const int rr = inr ? row : t0;
        const u32x2 wa = *(const u32x2*)(AG + (size_t)rr * 512 + cA), wb = *(const u32x2*)(AG + (size_t)rr * 512 + 256 + cA);
        float x[8];
        x[0] = inr ? bflo(wa.x) : 0.f; x[1] = inr ? bfhi(wa.x) : 0.f; x[2] = inr ? bflo(wa.y) : 0.f; x[3] = inr ? bfhi(wa.y) : 0.f;
        x[4] = inr ? bflo(wb.x) : 0.f; x[5] = inr ? bfhi(wb.x) : 0.f; x[6] = inr ? bflo(wb.y) : 0.f; x[7] = inr ? bfhi(wb.y) : 0.f;
#pragma unroll
        for (int o = 0; o < 8; ++o) { const int j = r - o + 15;
            if ((unsigned)j <= 30u) { const f32x4 w0 = *(const LAS f32x4*)(wl + j * 512 + cA), w1 = *(const LAS f32x4*)(wl + j * 512 + 256 + cA);
#pragma unroll
                for (int i = 0; i < 4; ++i) { acc[o][i] += w0[i] * x[i]; acc[o][4 + i] += w1[i] * x[4 + i]; } } }
    }
    const f32x4 b0 = *(const f32x4*)(bdw + cA), b1 = *(const f32x4*)(bdw + 256 + cA), g0 = *(const f32x4*)(lng + cA), g1 = *(const f32x4*)(lng + 256 + cA),
                e0 = *(const f32x4*)(lnb + cA), e1 = *(const f32x4*)(lnb + 256 + cA);
#pragma unroll
    for (int o = 0; o < 8; ++o) {
        float v[8]; float s = 0.f;
#pragma unroll
        for (int i = 0; i < 4; ++i) { v[i] = acc[o][i] + b0[i]; v[4 + i] = acc[o][4 + i] + b1[i]; s += v[i] + v[4 + i]; }
        const float mu = wave_sum(s) * (1.0f / 512.0f); float q = 0.f;
#pragma unroll
        for (int i = 0; i < 8; ++i) { v[i] -= mu; q += v[i] * v[i]; }
        const float rstd = 1.0f / sqrtf(wave_sum(q) * (1.0f / 512.0f) + EPS);
        float y[8];
#pragma unroll
        for (int i = 0; i < 4; ++i) { const float ya = v[i] * rstd * g0[i] + e0[i], yb = v[4 + i] * rstd * g1[i] + e1[i]; y[i] = ya * sigmoidf_(ya); y[4 + i] = yb * sigmoidf_(yb); }
        u32x2 oa, ob; oa.x = pk2(y[0], y[1]); oa.y = pk2(y[2], y[3]); ob.x = pk2(y[4], y[5]); ob.y = pk2(y[6], y[7]);
        *(u32x2*)(AC + (size_t)(t0 + o) * 512 + cA) = oa; *(u32x2*)(AC + (size_t)(t0 + o) * 512 + 256 + cA) = ob;
    }
}
__device__ __forceinline__ void pool_task(Frame& F, int tk, const bf16_t* U, bf16_t* PL) {
    const int t0 = tk * 8; int s0, s1;
    if (t0 < TX) { s0 = t0 & ~(SEQ - 1); s1 = s0 + SEQ; } else { s0 = TX + ((t0 - TX) & ~(CTXL - 1)); s1 = s0 + CTXL; }
    const int c0 = 8 * F.lane; const int hw = 1 << (F.lane >> 4);
    float acc[8][8], cnt[8];
#pragma unroll
    for (int o = 0; o < 8; ++o) { cnt[o] = 0.f;
#pragma unroll
        for (int i = 0; i < 8; ++i) acc[o][i] = 0.f; }
#pragma unroll 1
    for (int r = -8; r <= 14; ++r) {
        const int row = t0 + r; const bool inr = row >= s0 && row < s1; const int rr = inr ? row : t0;
        const u32x4 w = *(const u32x4*)(U + (size_t)rr * 512 + c0);
        f32x4 xa, xb; unpack8(w, xa, xb);
#pragma unroll
        for (int o = 0; o < 8; ++o) { const int rel = r - o;
            const float mm = (inr && rel >= -hw && rel < hw) ? 1.0f : 0.0f; cnt[o] += mm;
#pragma unroll
            for (int i = 0; i < 4; ++i) { acc[o][i] += mm * xa[i]; acc[o][4 + i] += mm * xb[i]; } }
    }
#pragma unroll
    for (int o = 0; o < 8; ++o) {
        const u32x4 w = *(const u32x4*)(U + (size_t)(t0 + o) * 512 + c0); f32x4 xa, xb; unpack8(w, xa, xb);
        const float ic = 1.0f / cnt[o]; f32x4 pa, pb;
#pragma unroll
        for (int i = 0; i < 4; ++i) { pa[i] = acc[o][i] * ic - xa[i]; pb[i] = acc[o][4 + i] * ic - xb[i]; }
        *(u32x4*)(PL + (size_t)(t0 + o) * 512 + c0) = pack8(pa, pb);
    }
}

__device__ __forceinline__ void moe_tables(Frame& F, int l) {
    LAS unsigned* tab = (LAS unsigned*)(F.lds + LDS_TAB);
    __syncthreads();
    if (F.tid < 32) { const unsigned n = __hip_atomic_load(F.ctl + CW_CNT + (l * 32 + F.tid) * 64, __ATOMIC_RELAXED, __HIP_MEMORY_SCOPE_AGENT); tab[F.tid] = n; tab[1400 + F.tid] = (n + 255u) >> 8; }
    __syncthreads();
    if (F.tid < 32) { unsigned tb = 0; for (int e = 0; e < F.tid; ++e) tb += tab[1400 + e]; const unsigned nte = tab[1400 + F.tid]; tab[32 + F.tid] = tb; if (F.tid == 31) tab[64] = tb + nte;
        for (unsigned i = 0; i < nte; ++i) tab[96 + tb + i] = (unsigned)F.tid; }
    __syncthreads();
}

__device__ __forceinline__ void p_route(Frame& F, const Args& a, int l) {
    const float* mod = (const float*)(F.ws + WS_MOD) + (size_t)l * 9 * 6144; const float* X = (const float*)(F.ws + WS_X); bf16_t* H = (bf16_t*)(F.ws + WS_H);
    unsigned* TI = (unsigned*)(F.ws + WS_TI); float* TG = (float*)(F.ws + WS_TG); unsigned* LIST = (unsigned*)(F.ws + WS_LIST);
    const float* rw = a.in[21] + (size_t)l * 1024 * 32; const float* rb = a.in[22] + l * 32; const float* n2g = a.in[20] + l * 1024;
    LAS unsigned char* WH = F.lds; LAS unsigned char* WL = F.lds + 65536; LAS float* LG = (LAS float*)(F.lds + 131072) + F.wave * 512;
    LAS unsigned* hist = (LAS unsigned*)(F.lds + 131072 + 16384); LAS unsigned* basel = hist + 32;
    const int tid = F.tid, lane = F.lane;
    for (int idx = tid; idx < 32768; idx += 512) { const int c = idx >> 5, e = idx & 31; const float w = rw[idx]; const unsigned h = f2bf(w); const float wh = __builtin_bit_cast(float, h << 16); const unsigned lo = f2bf(w - wh);
        const int ad = e * 2048 + (((c >> 3) ^ (e & 15)) * 16) + (c & 7) * 2; *(LAS bf16_t*)(WH + ad) = (bf16_t)h; *(LAS bf16_t*)(WL + ad) = (bf16_t)lo; }
    if (tid < 32) hist[tid] = 0u;
    __syncthreads();
    const int niter = (l == 0 ? TA : TX) / 128;
    const int tt = lane & 15, q = lane >> 4;
    for (int it = blockIdx.x; it < niter; it += F.G) {
        const int trow = it * 128 + F.wave * 16 + tt; const int ms = trow < TX ? (trow >> 13) : 8;
        const float* xr = X + (size_t)trow * 1024 + q * 8; const float* mp = mod + (size_t)ms * 6144;
        float ss = 0.f;
#pragma unroll 8
        for (int ks = 0; ks < 32; ++ks) { const f32x4 xa = *(const f32x4*)(xr + ks * 32), xb = *(const f32x4*)(xr + ks * 32 + 4);
            ss += (xa[0] * xa[0] + xa[1] * xa[1]) + (xa[2] * xa[2] + xa[3] * xa[3]) + (xb[0] * xb[0] + xb[1] * xb[1]) + (xb[2] * xb[2] + xb[3] * xb[3]); }
        ss += __shfl_xor(ss, 16); ss += __shfl_xor(ss, 32);
        const float rstd = 1.0f / sqrtf(ss * (1.0f / 1024.0f) + EPS);
        f32x4 lacc[2]; lacc[0] = (f32x4){0.f, 0.f, 0.f, 0.f}; lacc[1] = lacc[0];
#pragma unroll 2
        for (int ks = 0; ks < 32; ++ks) { const int c = ks * 32 + q * 8;
            const f32x4 xa = *(const f32x4*)(xr + ks * 32), xb = *(const f32x4*)(xr + ks * 32 + 4);
            const f32x4 ga = *(const f32x4*)(n2g + c), gb = *(const f32x4*)(n2g + c + 4), sca = *(const f32x4*)(mp + 4 * 1024 + c), scb = *(const f32x4*)(mp + 4 * 1024 + c + 4),
                        sha = *(const f32x4*)(mp + 3 * 1024 + c), shb = *(const f32x4*)(mp + 3 * 1024 + c + 4);
            const f32x4 ha = (xa * rstd * ga) * (sca + 1.0f) + sha, hb = (xb * rstd * gb) * (scb + 1.0f) + shb;
            const u32x4 hw = pack8(ha, hb); f32x4 ra, rbb; unpack8(hw, ra, rbb);
            const u32x4 lw = pack8(ha - ra, hb - rbb);
            *(u32x4*)(H + (size_t)trow * 1024 + c) = hw;
            const bf16x8 Ah = __builtin_bit_cast(bf16x8, hw), Al = __builtin_bit_cast(bf16x8, lw);
#pragma unroll
            for (int nb = 0; nb < 2; ++nb) { const int e = nb * 16 + tt; const int ad = e * 2048 + (((ks * 4 + q) ^ tt) * 16);
                const bf16x8 bh = *(const LAS bf16x8*)(WH + ad), bl = *(const LAS bf16x8*)(WL + ad);
                lacc[nb] = __builtin_amdgcn_mfma_f32_16x16x32_bf16(Ah, bh, lacc[nb], 0, 0, 0);
                lacc[nb] = __builtin_amdgcn_mfma_f32_16x16x32_bf16(Ah, bl, lacc[nb], 0, 0, 0);
                lacc[nb] = __builtin_amdgcn_mfma_f32_16x16x32_bf16(Al, bh, lacc[nb], 0, 0, 0); }
        }
#pragma unroll
        for (int nb = 0; nb < 2; ++nb) { const float bias = rb[nb * 16 + tt];
#pragma unroll
            for (int r = 0; r < 4; ++r) LG[(4 * q + r) * 32 + nb * 16 + tt] = lacc[nb][r] + bias; }
        asm volatile("s_waitcnt lgkmcnt(0)" ::: "memory");
        int be[4] = {0, 0, 0, 0}; float gt[4] = {0.f, 0.f, 0.f, 0.f}; unsigned rk[4] = {0u, 0u, 0u, 0u};
        if (lane < 16) {
            float lg[32];
#pragma unroll
            for (int j = 0; j < 8; ++j) { const f32x4 v = *(const LAS f32x4*)(LG + lane * 32 + 4 * j); lg[4 * j] = v[0]; lg[4 * j + 1] = v[1]; lg[4 * j + 2] = v[2]; lg[4 * j + 3] = v[3]; }
            float bv[4];
#pragma unroll
            for (int k = 0; k < 4; ++k) { float best = lg[0]; int bi = 0;
#pragma unroll
                for (int e = 1; e < 32; ++e) { const bool gtb = lg[e] > best; best = gtb ? lg[e] : best; bi = gtb ? e : bi; }
                bv[k] = best; be[k] = bi;
#pragma unroll
                for (int e = 0; e < 32; ++e) lg[e] = (e == bi) ? -3.0e38f : lg[e]; }
            float sum = 0.f;
#pragma unroll
            for (int k = 0; k < 4; ++k) { gt[k] = __expf(bv[k] - bv[0]); sum += gt[k]; }
            const float isum = 1.0f / sum;
#pragma unroll
            for (int k = 0; k < 4; ++k) { gt[k] *= isum; rk[k] = __hip_atomic_fetch_add(hist + be[k], 1u, __ATOMIC_RELAXED, __HIP_MEMORY_SCOPE_WORKGROUP); }
        }
        __syncthreads();
        if (tid < 32) { const unsigned nn = hist[tid]; unsigned bs = 0u; if (nn) bs = __hip_atomic_fetch_add(F.ctl + CW_CNT + (l * 32 + tid) * 64, nn, __ATOMIC_RELAXED, __HIP_MEMORY_SCOPE_AGENT); basel[tid] = bs; }
        __syncthreads();
        if (lane < 16) { const int trw = it * 128 + F.wave * 16 + lane;
#pragma unroll
            for (int k = 0; k < 4; ++k) { const unsigned slot = basel[be[k]] + rk[k]; TI[(size_t)trw * 4 + k] = ((unsigned)be[k] << 20) | slot; TG[(size_t)trw * 4 + k] = gt[k]; LIST[(size_t)be[k] * TA + slot] = (unsigned)trw; } }
        __syncthreads();
        if (tid < 32) hist[tid] = 0u;
        __syncthreads();
    }
}

__device__ __forceinline__ void p_comb(Frame& F, const Args& a, int l) {
    const float* mod = (const float*)(F.ws + WS_MOD); float* X = (float*)(F.ws + WS_X); bf16_t* H = (bf16_t*)(F.ws + WS_H); const bf16_t* Y = (const bf16_t*)(F.ws + WS_R2);
    const unsigned* TI = (const unsigned*)(F.ws + WS_TI); const float* TG = (const float*)(F.ws + WS_TG);
    const LAS unsigned* tab = (const LAS unsigned*)(F.lds + LDS_TAB);
    const int gw = F.vcu * 8 + F.wave, NGW = F.G * 8; const int nrow = l == 0 ? TA : TX; const bool lastl = l == 1;
    for (int row = gw; row < nrow; row += NGW) {
        const int ms = row < TX ? (row >> 13) : 8;
        const u32x4 ti = *(const u32x4*)(TI + (size_t)row * 4); const f32x4 tg = *(const f32x4*)(TG + (size_t)row * 4);
        f32x4 f[4];
#pragma unroll
        for (int j = 0; j < 4; ++j) f[j] = (f32x4){0.f, 0.f, 0.f, 0.f};
#pragma unroll
        for (int k = 0; k < 4; ++k) { const unsigned info = ti[k]; const unsigned e = info >> 20, slot = info & 0xfffffu; const size_t pos = (size_t)tab[32 + e] * 256 + slot; const float gk = tg[k];
            const bf16_t* yr = Y + pos * 1024 + F.lane * 4;
#pragma unroll
            for (int j = 0; j < 4; ++j) { const u32x2 w = *(const u32x2*)(yr + 256 * j); f[j] += (f32x4){bflo(w.x), bfhi(w.x), bflo(w.y), bfhi(w.y)} * gk; } }
        const float* g2 = mod + (size_t)(l * 9 + ms) * 6144 + 5 * 1024;
        f32x4 v[4]; float ss = 0.f;
#pragma unroll
        for (int j = 0; j < 4; ++j) { const int c = F.lane * 4 + 256 * j; v[j] = *(const f32x4*)(X + (size_t)row * 1024 + c) + *(const f32x4*)(g2 + c) * f[j];
            ss += (v[j][0] * v[j][0] + v[j][1] * v[j][1]) + (v[j][2] * v[j][2] + v[j][3] * v[j][3]); }
        const float rstd = 1.0f / sqrtf(wave_sum(ss) * (1.0f / 1024.0f) + EPS);
        if (!lastl) {
            const float* mp = mod + (size_t)(9 + ms) * 6144; const float* n1g = a.in[6] + 1024;
#pragma unroll
            for (int j = 0; j < 4; ++j) { const int c = F.lane * 4 + 256 * j; *(f32x4*)(X + (size_t)row * 1024 + c) = v[j];
                const f32x4 g = *(const f32x4*)(n1g + c), sh = *(const f32x4*)(mp + c), sc = *(const f32x4*)(mp + 1024 + c);
                const f32x4 h = (v[j] * rstd * g) * (sc + 1.0f) + sh;
                u32x2 o; o.x = pk2(h[0], h[1]); o.y = pk2(h[2], h[3]); *(u32x2*)(H + (size_t)row * 1024 + c) = o; }
        } else {
#pragma unroll
            for (int j = 0; j < 4; ++j) { const int c = F.lane * 4 + 256 * j; *(f32x4*)(a.out + (size_t)row * 1024 + c) = v[j] * rstd * *(const f32x4*)(a.in[27] + c); }
        }
    }
}

__global__ void __launch_bounds__(512, 2) mk_fwd(Args args) {
    extern __shared__ __attribute__((aligned(16))) unsigned char lds_raw[];
    Frame F;
    F.lds = (LAS unsigned char*)lds_raw; F.ws = args.ws; F.ctl = (unsigned*)(args.ws + WS_CTL);
    F.tid = threadIdx.x; F.lane = F.tid & 63; F.wave = __builtin_amdgcn_readfirstlane(F.tid >> 6);
    F.G = gridDim.x; { const int bx = blockIdx.x; F.vcu = (F.G % 8 == 0) ? (bx % 8) * (F.G / 8) + bx / 8 : bx; }
    volatile LAS unsigned* MISC = (volatile LAS unsigned*)(F.lds + LDS_MISC);
    if (F.tid < 64) MISC[F.tid] = 0u;
    __syncthreads();
    XcdBarrier bar; bar.bar = (unsigned*)(F.ctl + CW_BAR); bar.x = 0; bar.st = nullptr;
#if !MK_PER_PHASE
    bar = xcd_barrier_post((unsigned*)(F.ctl + CW_BAR), MISC + 8);
#endif
    const int lo = args.ph_lo, hi = args.ph_hi; int bxo = blockIdx.x;
#ifndef PH_MASK
#define PH_MASK 0x3ff
#endif
#define INT(k, ty) (((PH_MASK >> (ty)) & 1) && lo <= (k) && (k) < hi)
#define IN(k) (lo <= (k) && (k) < hi)
#define REFRESH() do { int t_ = threadIdx.x; asm volatile("" : "+v"(t_)); F.tid = t_; F.lane = t_ & 63; int b_ = blockIdx.x; asm volatile("" : "+s"(b_)); bxo = b_; F.vcu = (F.G % 8 == 0) ? (b_ % 8) * (F.G / 8) + b_ / 8 : b_; } while (0)
#define SEAM(k) do { if (IN((k) + 1)) { xcd_barrier(bar); } } while (0)

    if (INT(0, 0)) { REFRESH(); p_prologue(F, args); SEAM(0); }
    if (INT(1, 1)) { REFRESH(); p_norm0(F, args); SEAM(1); }

    for (int l = 0; l < 2; ++l) {
        const int pb = 2 + l * 8;
        unsigned char* wl = F.ws + WS_W + (size_t)l * W_LAYER;
        unsigned char* r1 = F.ws + WS_R1; unsigned char* r2 = F.ws + WS_R2;
        const float* modl = (const float*)(F.ws + WS_MOD) + (size_t)l * 9 * 6144;
        const int nrt = l == 0 ? NTA : NTX;

        if (INT(pb + 0, 2)) { REFRESH();
            g8::SchedDense<1024> S{(const char*)(F.ws + WS_H), (const char*)(wl + W_IN), nrt, 21, F.G, bxo, l == 0 ? 0 : NTZ, 6};
            g8::EpiInProj E{(bf16_t*)(r1 + R1_AGLU), (bf16_t*)(r1 + R1_Q), (bf16_t*)(r1 + R1_K), (bf16_t*)(r1 + R1_VT), (bf16_t*)(r1 + R1_U), (bf16_t*)(r1 + R1_G),
                            args.in[8] + l * 3072, (const float*)(F.ws + WS_ROPE)};
            g8::gemm_phase<1024>(F.lds, S, E, F.tid);
            SEAM(pb + 0);
        }
        if (INT(pb + 1, 3)) { REFRESH();
            const bf16_t* Q = (const bf16_t*)(r1 + R1_Q); const bf16_t* Kb = (const bf16_t*)(r1 + R1_K); const bf16_t* VT = (const bf16_t*)(r1 + R1_VT);
            bf16_t* AT = (bf16_t*)(r2 + R2_AT); const float* sink = args.in[14] + l * 8;
            __syncthreads();
#if !defined(MIX_SUB) || (MIX_SUB & 1)
            {
                const int nu = l == 0 ? 2112 : 2048;
                for (int i = 0; i < 9; ++i) {
                    int id;
                    if (F.G == 256) { if (i < 8) id = F.vcu * 8 + i; else { if (F.vcu >= 64) break; id = 2048 + F.vcu; } }
                    else { id = F.vcu + i * F.G; if (i >= 9) break; }
                    if (id >= nu) break;
                    if (id < 2048) attn_unit(F, Q, Kb, VT, AT, sink, false, id >> 8, (id & 255) >> 2, (id >> 1) & 1, id & 1);
                    else { const int zz = id - 2048; attn_unit(F, Q, Kb, VT, AT, sink, true, zz >> 3, (zz >> 2) & 1, (zz >> 1) & 1, zz & 1); }
                }
                if (F.G != 256) for (int id = F.vcu + 9 * F.G; id < nu; id += F.G) {
                    if (id < 2048) attn_unit(F, Q, Kb, VT, AT, sink, false, id >> 8, (id & 255) >> 2, (id >> 1) & 1, id & 1);
                    else { const int zz = id - 2048; attn_unit(F, Q, Kb, VT, AT, sink, true, zz >> 3, (zz >> 2) & 1, (zz >> 1) & 1, zz & 1); }
                }
            }
#endif
            __syncthreads();
            LAS float* wlds = (LAS float*)F.lds;
            for (int i = F.tid; i < 31 * 512; i += 512) wlds[i] = args.in[9][(size_t)l * 31 * 512 + i];
            __syncthreads();
            const int ntask = (l == 0 ? TA : TX) / 8; const int gw = F.vcu * 8 + F.wave, NGW = F.G * 8;
#if !defined(MIX_SUB) || (MIX_SUB & 2)
            for (int tk = gw; tk < ntask; tk += NGW)
                conv_task(F, tk, (const bf16_t*)(r1 + R1_AGLU), (bf16_t*)(r2 + R2_AC), wlds, args.in[10] + l * 512, args.in[11] + l * 512, args.in[12] + l * 512);
#endif
#if !defined(MIX_SUB) || (MIX_SUB & 4)
            for (int tk = gw; tk < ntask; tk += NGW) pool_task(F, tk, (const bf16_t*)(r1 + R1_U), (bf16_t*)(r2 + R2_PL));
#endif
            SEAM(pb + 1);
        }
        if (INT(pb + 2, 4)) { REFRESH();
            g8::SchedBranch S{(const char*)(r2 + R2_AC), (const char*)(wl + W_CO), R2_AT, W_P_B, nrt, F.G, bxo};
            g8::EpiBranch E{(const bf16_t*)(r1 + R1_G), (bf16_t*)(r2 + R2_MG)};
            g8::gemm_phase<512>(F.lds, S, E, F.tid);
            SEAM(pb + 2);
        }
        if (INT(pb + 3, 5)) { REFRESH();
            g8::SchedDense<1024> S{(const char*)(r2 + R2_MG), (const char*)(wl + W_OUT), nrt, 4, F.G, bxo, 0, 0};
            g8::EpiWout E{args.in[0], args.in[2], (float*)(F.ws + WS_X), modl, l == 0 ? 1 : 0};
            g8::gemm_phase<1024>(F.lds, S, E, F.tid);
            SEAM(pb + 3);
        }
        if (INT(pb + 4, 6)) { REFRESH(); __syncthreads(); p_route(F, args, l); SEAM(pb + 4); }
        if (INT(pb + 5, 7)) { REFRESH();
            moe_tables(F, l);
            g8::SchedMoE<true> S{(const char*)(F.ws + WS_H), (const char*)(wl + W_GU), W_GU_E, (const unsigned*)(F.ws + WS_LIST), (const LAS unsigned*)(F.lds + LDS_TAB), 8, F.G, bxo};
            g8::EpiGU E{(bf16_t*)r1, args.in[24] + (size_t)l * 32 * 2048};
            g8::gemm_phase<1024>(F.lds, S, E, F.tid);
            SEAM(pb + 5);
        }
        if (INT(pb + 6, 8)) { REFRESH();
            moe_tables(F, l);
            g8::SchedMoE<false> S{(const char*)r1, (const char*)(wl + W_DN), W_DN_E, nullptr, (const LAS unsigned*)(F.lds + LDS_TAB), 4, F.G, bxo};
            g8::EpiDown E{(bf16_t*)r2, args.in[26] + (size_t)l * 32 * 1024};
            g8::gemm_phase<1024>(F.lds, S, E, F.tid);
            SEAM(pb + 6);
        }
        if (INT(pb + 7, 9)) { REFRESH(); moe_tables(F, l); p_comb(F, args, l); SEAM(pb + 7); }
    }
#undef IN
#undef INT
#undef SEAM
}

extern "C" void kernel_launch(void* const* d_in, const int* in_sizes, int n_in, void* d_out, int out_size, void* d_ws, size_t ws_size, hipStream_t stream) {
    static int grid = 0;
    if (grid == 0) {
        if (n_in != 28 || out_size != TX * D || ws_size < WS_END) { fprintf(stderr, "kernel_launch: unexpected shapes (n_in %d out %d ws %zu need %zu)\n", n_in, out_size, ws_size, (size_t)WS_END); grid = -1; return; }
        int dev = 0, cus = 0, per_cu = 0;
        if (hipGetDevice(&dev) != hipSuccess || hipDeviceGetAttribute(&cus, hipDeviceAttributeMultiprocessorCount, dev) != hipSuccess) { grid = -1; return; }
        if (hipFuncSetAttribute((const void*)mk_fwd, hipFuncAttributeMaxDynamicSharedMemorySize, LDS_BYTES) != hipSuccess) { fprintf(stderr, "kernel_launch: hipFuncSetAttribute failed\n"); grid = -1; return; }
        if (hipOccupancyMaxActiveBlocksPerMultiprocessor(&per_cu, (const void*)mk_fwd, 512, LDS_BYTES) != hipSuccess || per_cu < 1) { fprintf(stderr, "kernel_launch: occupancy query says %d\n", per_cu); }
        (void)hipGetLastError();
        grid = cus;
    }
    if (grid < 0) return;
    (void)in_sizes;
    hipMemsetAsync((char*)d_ws + WS_CTL, 0, CTL_BYTES, stream);
    Args a{};
    for (int i = 0; i < 28; ++i) a.in[i] = (const float*)d_in[i];
    a.out = (float*)d_out; a.ws = (unsigned char*)d_ws;
#if MK_PER_PHASE
    for (int p = 0; p < NPH; ++p) { a.ph_lo = p; a.ph_hi = p + 1; hipLaunchKernelGGL(mk_fwd, dim3(grid), dim3(512), LDS_BYTES, stream, a); }
#else
    a.ph_lo = 0; a.ph_hi = NPH; hipLaunchKernelGGL(mk_fwd, dim3(grid), dim3(512), LDS_BYTES, stream, a);
#endif
}
```

```cpp
#include <hip/hip_runtime.h>
#include <cstdio>
#include <cstdint>

#ifndef MK_PER_PHASE
#define MK_PER_PHASE 0
#endif

#define GAS __attribute__((address_space(1)))
#define LAS __attribute__((address_space(3)))
typedef unsigned short bf16_t;
typedef short bf16x8 __attribute__((ext_vector_type(8)));
typedef float f32x2 __attribute__((ext_vector_type(2)));
typedef float f32x4 __attribute__((ext_vector_type(4)));
typedef float f32x16 __attribute__((ext_vector_type(16)));
typedef unsigned u32x2 __attribute__((ext_vector_type(2)));
typedef unsigned u32x4 __attribute__((ext_vector_type(4)));
typedef __bf16 bf16x2_t __attribute__((ext_vector_type(2)));

constexpr int D = 1024, NB = 8, SEQ = 8192, CTXL = 256;
constexpr int TX = NB * SEQ, TZ = NB * CTXL, TA = TX + TZ;
constexpr int NTX = TX / 256, NTZ = TZ / 256, NTA = TA / 256;
constexpr int DIN = 5376, NE = 32;
constexpr int NPH = 18;
constexpr float EPS = 1e-6f;
constexpr float LOG2E = 1.4426950408889634f;

constexpr size_t al256(size_t x) { return (x + 255) & ~(size_t)255; }
constexpr size_t WS_CTL = 0, CTL_BYTES = 1u << 20;
constexpr size_t WS_MOD = WS_CTL + CTL_BYTES, MOD_BYTES = al256((size_t)2 * 9 * 6144 * 4);
constexpr size_t WS_ROPE = WS_MOD + MOD_BYTES, ROPE_BYTES = (size_t)2 * 8192 * 32 * 4;
constexpr size_t WS_W = WS_ROPE + ROPE_BYTES;
constexpr size_t W_IN = 0, W_IN_B = (size_t)DIN * 1024 * 2;
constexpr size_t W_CO = W_IN + W_IN_B, W_P_B = (size_t)1024 * 512 * 2;
constexpr size_t W_AO = W_CO + W_P_B;
constexpr size_t W_PE = W_AO + W_P_B;
constexpr size_t W_OUT = W_PE + W_P_B, W_OUT_B = (size_t)1024 * 1024 * 2;
constexpr size_t W_GU = W_OUT + W_OUT_B, W_GU_E = (size_t)2048 * 1024 * 2, W_GU_B = 32 * W_GU_E;
constexpr size_t W_DN = W_GU + W_GU_B, W_DN_E = (size_t)1024 * 1024 * 2, W_DN_B = 32 * W_DN_E;
constexpr size_t W_LAYER = W_DN + W_DN_B;
constexpr size_t WS_H = WS_W + 2 * W_LAYER;
constexpr size_t H_BYTES = (size_t)TA * 1024 * 2;
constexpr size_t WS_R1 = WS_H + H_BYTES;
constexpr size_t R1_AGLU = 0, R1_Q = R1_AGLU + (size_t)TA * 512 * 2, R1_K = R1_Q + (size_t)TA * 512 * 2, R1_VT = R1_K + (size_t)TA * 128 * 2,
                 R1_U = R1_VT + (size_t)TA * 128 * 2, R1_G = R1_U + (size_t)TA * 512 * 2, R1_BYTES = R1_G + (size_t)TA * 3072 * 2;
constexpr int PMAX = TA * 4 + 32 * 256;
constexpr size_t ACT_BYTES = (size_t)PMAX * 1024 * 2;
static_assert(ACT_BYTES <= R1_BYTES, "ACT must fit R1");
constexpr size_t WS_R2 = WS_R1 + R1_BYTES;
constexpr size_t R2_AC = 0, R2_AT = (size_t)TA * 512 * 2, R2_PL = 2 * R2_AT, R2_MG = 3 * R2_AT, R2_BYTES = ACT_BYTES;
static_assert(R2_MG + (size_t)TA * 1024 * 2 <= R2_BYTES, "R2");
constexpr size_t WS_X = WS_R2 + R2_BYTES;
constexpr size_t X_BYTES = (size_t)TA * 1024 * 4;
constexpr size_t WS_TI = WS_X + X_BYTES;
constexpr size_t WS_TG = WS_TI + (size_t)TA * 16;
constexpr size_t WS_LIST = WS_TG + (size_t)TA * 16;
constexpr size_t WS_END = WS_LIST + (size_t)32 * TA * 4;
constexpr int CW_TMO = 0, CW_BAR = 4096, CW_CNT = 16384;

constexpr int LDS_BYTES = 163840;
constexpr int LDS_MISC = 163840 - 256;
constexpr int LDS_TAB = 131072;

__device__ __forceinline__ unsigned f2bf(float f) { unsigned u = __builtin_bit_cast(unsigned, f); return (u + 0x7fffu + ((u >> 16) & 1u)) >> 16; }
__device__ __forceinline__ unsigned pk2(float lo, float hi) { f32x2 v = {lo, hi}; bf16x2_t b = __builtin_convertvector(v, bf16x2_t); return __builtin_bit_cast(unsigned, b); }
__device__ __forceinline__ float bflo(unsigned u) { return __builtin_bit_cast(float, u << 16); }
__device__ __forceinline__ float bfhi(unsigned u) { return __builtin_bit_cast(float, u & 0xffff0000u); }
__device__ __forceinline__ float wave_sum(float v) {
#pragma unroll
    for (int o = 1; o < 64; o <<= 1) v += __shfl_xor(v, o);
    return v;
}
__device__ __forceinline__ float sigmoidf_(float x) { return __builtin_amdgcn_rcpf(1.0f + __builtin_amdgcn_exp2f(-x * LOG2E)); }
__device__ __forceinline__ u32x4 pack8(const f32x4& a, const f32x4& b) { u32x4 w; w.x = pk2(a[0], a[1]); w.y = pk2(a[2], a[3]); w.z = pk2(b[0], b[1]); w.w = pk2(b[2], b[3]); return w; }
__device__ __forceinline__ void unpack8(const u32x4& w, f32x4& a, f32x4& b) { a = (f32x4){bflo(w.x), bfhi(w.x), bflo(w.y), bfhi(w.y)}; b = (f32x4){bflo(w.z), bfhi(w.z), bflo(w.w), bfhi(w.w)}; }
__device__ __forceinline__ int perm16(int s) { return (s & ~12) | ((s & 4) << 1) | ((s & 8) >> 1); }

#define XB_TMO      128
#define XB_XCNT(j)  (256  + 64 * (j))
#define XB_XSUB(j)  (1280 + 64 * (j))
#define XB_XGEN(j)  (2304 + 64 * (j))
#define XB_TOP      3328
#define XB_TOPGEN   3392
#define XCD_BAR_WORDS 3456
#define XB_SPIN_CAP (1u << 18)
__device__ __forceinline__ unsigned xb_ld(unsigned* p)              { return __hip_atomic_load(p, __ATOMIC_RELAXED, __HIP_MEMORY_SCOPE_AGENT); }
__device__ __forceinline__ unsigned xb_add(unsigned* p, unsigned v) { return __hip_atomic_fetch_add(p, v, __ATOMIC_RELAXED, __HIP_MEMORY_SCOPE_AGENT); }
__device__ __forceinline__ unsigned xb_xcc_id() { return (unsigned)__builtin_amdgcn_s_getreg((3 << 11) | 20) & 0xFu; }
#define XB_SPIN(cond, bar) do { unsigned _sp = 0; while (cond) { __builtin_amdgcn_s_sleep(1); \
    if ((++_sp & 255u) == 0u) { if (xb_ld(&(bar)[XB_TMO])) break; if (_sp > XB_SPIN_CAP) { atomicAdd(&(bar)[XB_TMO], 1u); break; } } } } while (0)
struct XcdBarrier { unsigned* bar; unsigned x; volatile LAS unsigned* st; };
__device__ __forceinline__ XcdBarrier xcd_barrier_post(unsigned* bar, volatile LAS unsigned* st) {
    XcdBarrier b; b.bar = bar; b.x = xb_xcc_id(); b.st = st;
    if (threadIdx.x == 0) (void)xb_add(&bar[XB_XCNT(b.x)], 1u);
    return b;
}
__device__ __forceinline__ void xcd_barrier_complete(unsigned* bar, unsigned x, unsigned& nloc, unsigned& nx) {
    const unsigned G = gridDim.x * gridDim.y * gridDim.z;
    unsigned sum, cnt, mine, sp = 0u;
    for (;;) {
        sum = 0u; cnt = 0u; mine = 0u;
#pragma unroll
        for (unsigned j = 0; j < 16; ++j) { const unsigned c = xb_ld(&bar[XB_XCNT(j)]); sum += c; cnt += (c > 0u) ? 1u : 0u; mine = (j == x) ? c : mine; }
        if (sum == G) break;
        __builtin_amdgcn_s_sleep(1);
        if ((++sp & 255u) == 0u) { if (xb_ld(&bar[XB_TMO])) break; if (sp > XB_SPIN_CAP) { atomicAdd(&bar[XB_TMO], 1u); break; } }
    }
    nloc = mine > 0u ? mine : 1u; nx = cnt > 0u ? cnt : 1u;
}
__device__ __forceinline__ void xcd_barrier(const XcdBarrier& b) {
    asm volatile("s_waitcnt vmcnt(0)" ::: "memory");
    __syncthreads();
    if (threadIdx.x == 0) {
        unsigned* bar = b.bar;
        __builtin_amdgcn_s_waitcnt(0);
        unsigned nloc = b.st[0], nx = b.st[1];
        if (nloc == 0u) { xcd_barrier_complete(bar, b.x, nloc, nx); b.st[0] = nloc; b.st[1] = nx; }
        const unsigned old = xb_add(&bar[XB_XSUB(b.x)], 1u);
        const unsigned gen = old / nloc;
        if (old + 1u == (gen + 1u) * nloc) {
            __builtin_amdgcn_fence(__ATOMIC_RELEASE, "agent");
            asm volatile("s_waitcnt vmcnt(0)" ::: "memory");
            const unsigned og = xb_add(&bar[XB_TOP], 1u);
            const unsigned tg = og / nx;
            if (og + 1u == (tg + 1u) * nx) xb_add(&bar[XB_TOPGEN], 1u);
            else XB_SPIN(xb_ld(&bar[XB_TOPGEN]) == tg, bar);
            __builtin_amdgcn_fence(__ATOMIC_ACQUIRE, "agent");
            xb_add(&bar[XB_XGEN(b.x)], 1u);
            asm volatile("s_waitcnt vmcnt(0)" ::: "memory");
        } else {
            XB_SPIN(xb_ld(&bar[XB_XGEN(b.x)]) == gen, bar);
            __builtin_amdgcn_fence(__ATOMIC_ACQUIRE, "agent");
            asm volatile("s_waitcnt vmcnt(0)" ::: "memory");
        }
    }
    __syncthreads();
}

namespace g8 {
constexpr int BM = 256, BK = 64, HALF = 128, HTB = HALF * BK * 2, STAGE_BYTES = 8 * HTB, NXCD = 8, WGM = 8;
__device__ __forceinline__ int lds_byte(int r, int c) { const int st = (r >> 4) * 2 + (c >> 5), rr = r & 15, cc = c & 31, ob = rr * 64 + cc * 2; return st * 1024 + (ob ^ (((ob >> 9) & 1) << 5)); }
__device__ __forceinline__ void stage_rc(int b, int& R, int& C) { const int st = b / 1024, sb = b % 1024, swz = sb ^ (((sb >> 9) & 1) << 5); R = (st >> 1) * 16 + swz / 64; C = (st & 1) * 32 + (swz % 64) / 2; }
__device__ __forceinline__ int perm32(int rho) { const int n = rho >> 4, i = rho & 15; return 8 * (i >> 2) + 4 * n + (i & 3); }

struct GUnit { const char* A; const char* B; int pm, pn, aux; };

__device__ __forceinline__ bool tile_map(int L, int nM, int nN, int& pm, int& pn) {
    const int nwg = nM * nN; if (L >= nwg) return false;
    int wgid = L; { const int q = nwg / NXCD, r = nwg % NXCD, xcd = wgid % NXCD, off = wgid / NXCD; wgid = (xcd < r ? xcd * (q + 1) : r * (q + 1) + (xcd - r) * q) + off; }
    const int nig = WGM * nN, gid = wgid / nig, fm = gid * WGM, gsz = (nM - fm) < WGM ? (nM - fm) : WGM;
    pm = fm + ((wgid % nig) % gsz); pn = (wgid % nig) / gsz; return true;
}

template <int K, class Epi, class Sched>
__device__ __forceinline__ void gemm_phase(LAS unsigned char* lds, const Sched& S, const Epi& E, const int tid) {
    const int wid = __builtin_amdgcn_readfirstlane(tid >> 6), lane = tid & 63, wr = wid >> 2, wc = wid & 3, fr = lane & 15, fq = lane >> 4;
    constexpr int nt = K / BK;
    unsigned voffB[2]; int sR[2], sC[2];
#pragma unroll
    for (int i = 0; i < 2; ++i) { int R, C; stage_rc(tid * 16 + i * 8192, R, C); const int Rb = Epi::PERM ? ((R & ~31) + perm32(R & 31)) : R;
        voffB[i] = (unsigned)(Rb * K + C) * 2u; sR[i] = R; sC[i] = C; }
    constexpr size_t kstep = (size_t)(BK * 2);
    constexpr size_t hstep = (size_t)HALF * K * 2;
    const unsigned ldsw = (unsigned)wid * 1024u;
    const int aoff = lds_byte(wr * 64 + fr, fq * 8), boff = lds_byte(wc * 32 + fr, fq * 8);
#define PG8_SA(b, h) (((b) * 2 + (h)) * HTB)
#define PG8_SB(b, h) ((4 + (b) * 2 + (h)) * HTB)
#define PG8_STAGE(bufoff, gbase, voff) do { _Pragma("unroll") for (int _i = 0; _i < 2; ++_i) \
        __builtin_amdgcn_global_load_lds((const unsigned*)((const char*)(gbase) + (voff)[_i]), (LAS unsigned*)(lds + (bufoff) + ldsw + _i * 8192), 16, 0, 0); } while (0)
#define PG8_LDA(dst, b, h) do { _Pragma("unroll") for (int m = 0; m < 4; ++m) _Pragma("unroll") for (int k = 0; k < 2; ++k) dst[m][k] = *(const LAS bf16x8*)(lds + PG8_SA(b, h) + aoff + m * 2048 + k * 1024); } while (0)
#define PG8_LDB(dst, b, h) do { _Pragma("unroll") for (int n = 0; n < 2; ++n) _Pragma("unroll") for (int k = 0; k < 2; ++k) dst[n][k] = *(const LAS bf16x8*)(lds + PG8_SB(b, h) + boff + n * 2048 + k * 1024); } while (0)
#define PG8_MMA(ai, bj, At, Bt) do { __builtin_amdgcn_s_setprio(1); _Pragma("unroll") for (int m = 0; m < 4; ++m) _Pragma("unroll") for (int n = 0; n < 2; ++n) _Pragma("unroll") for (int k = 0; k < 2; ++k) \
        acc[ai][bj][m][n] = __builtin_amdgcn_mfma_f32_16x16x32_bf16(Bt[n][k], At[m][k], acc[ai][bj][m][n], 0, 0, 0); __builtin_amdgcn_s_setprio(0); } while (0)
#define PG8_WAIT_V(n) asm volatile("s_waitcnt vmcnt(" #n ")" ::: "memory")
#define PG8_WAIT_L(n) asm volatile("s_waitcnt lgkmcnt(" #n ")" ::: "memory")
#define PG8_BAR __builtin_amdgcn_s_barrier()
#define PG8_SCHED __builtin_amdgcn_sched_barrier(0)
    GUnit cur, nxt; int ui = 0;
    if (!S.next(0, cur)) return;
    f32x4 acc[2][2][4][2];
#pragma unroll
    for (int a = 0; a < 2; ++a)
#pragma unroll
        for (int b = 0; b < 2; ++b)
#pragma unroll
            for (int m = 0; m < 4; ++m)
#pragma unroll
                for (int n = 0; n < 2; ++n) acc[a][b][m][n] = (f32x4){0.f, 0.f, 0.f, 0.f};
    bf16x8 At[4][2], B0[2][2], B1[2][2];
    unsigned ca0[2], ca1[2], na0[2], na1[2];
    S.aoff(cur, sR, sC, ca0, ca1);
    const char* cA = cur.A; const char* cB = cur.B;
    PG8_STAGE(PG8_SB(0, 0), cB, voffB); PG8_STAGE(PG8_SB(0, 1), cB + hstep, voffB); PG8_STAGE(PG8_SA(0, 0), cA, ca0); PG8_STAGE(PG8_SA(0, 1), cA, ca1);
    if (wr == 1) PG8_BAR;
    PG8_WAIT_V(2); PG8_BAR;
    PG8_STAGE(PG8_SB(1, 0), cB + kstep, voffB); PG8_STAGE(PG8_SA(1, 0), cA + kstep, ca0); PG8_STAGE(PG8_SB(1, 1), cB + hstep + kstep, voffB);
    PG8_WAIT_V(6); PG8_BAR;
    for (;;) {
        const bool has_next = S.next(ui + 1, nxt);
        if (has_next) S.aoff(nxt, sR, sC, na0, na1); else { na0[0] = ca0[0]; na0[1] = ca0[1]; na1[0] = ca1[0]; na1[1] = ca1[1]; }
        const char* nA = has_next ? nxt.A : cA; const char* nB = has_next ? nxt.B : cB;
        for (int t = 0; t < nt; t += 2) {
            const bool last = (t == nt - 2);
            const char* a1 = cA + (size_t)(t + 1) * kstep;
            const char* a2 = last ? nA : cA + (size_t)(t + 2) * kstep; const char* b2 = last ? nB : cB + (size_t)(t + 2) * kstep;
            const char* a3 = a2 + kstep; const char* b3 = b2 + kstep;
            unsigned xa0[2], xa1[2];
            xa0[0] = last ? na0[0] : ca0[0]; xa0[1] = last ? na0[1] : ca0[1]; xa1[0] = last ? na1[0] : ca1[0]; xa1[1] = last ? na1[1] : ca1[1];
            PG8_LDB(B0, 0, 0); PG8_LDB(B1, 0, 1); PG8_SCHED; PG8_LDA(At, 0, 0); PG8_STAGE(PG8_SA(1, 1), a1, ca1);
            PG8_WAIT_V(8); PG8_WAIT_L(0); PG8_BAR; PG8_MMA(0, 0, At, B0); PG8_MMA(0, 1, At, B1); PG8_BAR; PG8_SCHED;
            PG8_LDA(At, 0, 1); PG8_STAGE(PG8_SB(0, 0), b2, voffB); PG8_STAGE(PG8_SB(0, 1), b2 + hstep, voffB); PG8_STAGE(PG8_SA(0, 0), a2, xa0);
            PG8_WAIT_V(8); PG8_WAIT_L(0); PG8_BAR; PG8_MMA(1, 0, At, B0); PG8_MMA(1, 1, At, B1); PG8_BAR; PG8_SCHED;
            PG8_LDB(B0, 1, 0); PG8_LDB(B1, 1, 1); PG8_SCHED; PG8_LDA(At, 1, 0); PG8_STAGE(PG8_SA(0, 1), a2, xa1);
            PG8_WAIT_V(8); PG8_WAIT_L(0); PG8_BAR; PG8_MMA(0, 0, At, B0); PG8_MMA(0, 1, At, B1); PG8_BAR; PG8_SCHED;
            PG8_LDA(At, 1, 1); PG8_STAGE(PG8_SB(1, 0), b3, voffB); PG8_STAGE(PG8_SB(1, 1), b3 + hstep, voffB); PG8_STAGE(PG8_SA(1, 0), a3, xa0);
            PG8_WAIT_V(8); PG8_WAIT_L(0); PG8_BAR; PG8_MMA(1, 0, At, B0); PG8_MMA(1, 1, At, B1); PG8_BAR; PG8_SCHED;
        }
        if (wr == 0) PG8_BAR;
        E(acc, cur, wr, wc, fr, fq);
        if (!has_next) break;
#pragma unroll
        for (int a = 0; a < 2; ++a)
#pragma unroll
            for (int b = 0; b < 2; ++b)
#pragma unroll
                for (int m = 0; m < 4; ++m)
#pragma unroll
                    for (int n = 0; n < 2; ++n) acc[a][b][m][n] = (f32x4){0.f, 0.f, 0.f, 0.f};
        cur = nxt; cA = nA; cB = nB; ca0[0] = na0[0]; ca0[1] = na0[1]; ca1[0] = na1[0]; ca1[1] = na1[1]; ++ui;
        if (wr == 1) PG8_BAR;
    }
    PG8_WAIT_V(0);
    PG8_BAR;
#undef PG8_SA
#undef PG8_SB
#undef PG8_STAGE
#undef PG8_LDA
#undef PG8_LDB
#undef PG8_MMA
#undef PG8_WAIT_V
#undef PG8_WAIT_L
#undef PG8_BAR
#undef PG8_SCHED
}

template <int K> struct SchedDense {
    const char* A; const char* B; int nM, nN, G, c, extra, xpn;
    __device__ __forceinline__ bool next(int i, GUnit& u) const {
        const int L = i * G + c; int pm, pn;
        if (!tile_map(L, nM, nN, pm, pn)) { const int j = L - nM * nN; if (j >= extra) return false; pm = nM + j; pn = xpn; }
        u.pm = pm; u.pn = pn; u.aux = 0; u.A = A + (size_t)pm * 256 * K * 2; u.B = B + (size_t)pn * 256 * K * 2; return true;
    }
    __device__ __forceinline__ void aoff(const GUnit&, const int (&sR)[2], const int (&sC)[2], unsigned (&o0)[2], unsigned (&o1)[2]) const {
#pragma unroll
        for (int i = 0; i < 2; ++i) { o0[i] = (unsigned)(sR[i] * K + sC[i]) * 2u; o1[i] = (unsigned)((128 + sR[i]) * K + sC[i]) * 2u; }
    }
};
struct SchedBranch {
    const char* A0; const char* B0; size_t sa, sb; int nM, G, c;
    __device__ __forceinline__ bool next(int i, GUnit& u) const {
        const int ti = i / 3, br = i - 3 * ti; const int L = ti * G + c; int pm, pn;
        if (!tile_map(L, nM, 4, pm, pn)) return false;
        u.pm = pm; u.pn = pn; u.aux = br;
        u.A = A0 + (size_t)br * sa + (size_t)pm * 256 * 1024; u.B = B0 + (size_t)br * sb + (size_t)pn * 256 * 1024; return true;
    }
    __device__ __forceinline__ void aoff(const GUnit&, const int (&sR)[2], const int (&sC)[2], unsigned (&o0)[2], unsigned (&o1)[2]) const {
#pragma unroll
        for (int i = 0; i < 2; ++i) { o0[i] = (unsigned)(sR[i] * 512 + sC[i]) * 2u; o1[i] = (unsigned)((128 + sR[i]) * 512 + sC[i]) * 2u; }
    }
};
template <bool GATHER> struct SchedMoE {
    const char* A; const char* W; size_t wexp; const unsigned* list; const LAS unsigned* tab; int nN, G, c;
    __device__ __forceinline__ bool next(int i, GUnit& u) const {
        const int L = i * G + c; int pm, pn; const int nM = (int)tab[64];
        if (!tile_map(L, nM, nN, pm, pn)) return false;
        const int e = __builtin_amdgcn_readfirstlane((int)tab[96 + pm]);
        u.pm = pm; u.pn = pn; u.aux = e; u.B = W + (size_t)e * wexp + (size_t)pn * 256 * 2048;
        u.A = GATHER ? A : A + (size_t)pm * 256 * 2048; return true;
    }
    __device__ __forceinline__ void aoff(const GUnit& u, const int (&sR)[2], const int (&sC)[2], unsigned (&o0)[2], unsigned (&o1)[2]) const {
        if (GATHER) {
            const int e = u.aux; const int n_e = (int)tab[e]; const int idx0 = (u.pm - (int)tab[32 + e]) * 256;
            const unsigned* le = list + (size_t)e * TA;
#pragma unroll
            for (int i = 0; i < 2; ++i) {
                const int i0 = idx0 + sR[i], i1 = i0 + 128;
                const unsigned t0 = i0 < n_e ? le[i0] : 0u, t1 = i1 < n_e ? le[i1] : 0u;
                o0[i] = (t0 * 1024u + (unsigned)sC[i]) * 2u; o1[i] = (t1 * 1024u + (unsigned)sC[i]) * 2u; }
        } else {
#pragma unroll
            for (int i = 0; i < 2; ++i) { o0[i] = (unsigned)(sR[i] * 1024 + sC[i]) * 2u; o1[i] = (unsigned)((128 + sR[i]) * 1024 + sC[i]) * 2u; }
        }
    }
};

struct EpiInProj {
    static constexpr bool PERM = true;
    bf16_t* aglu; bf16_t* q; bf16_t* k; bf16_t* vt; bf16_t* u; bf16_t* g; const float* bgate; const float* rope;
    __device__ __forceinline__ void operator()(const f32x4 (&acc)[2][2][4][2], const GUnit& un, int wr, int wc, int fr, int fq) const {
        const int pn = un.pn; const int row0 = un.pm * 256 + wr * 64 + fr; const bool isx = un.pm < NTX;
        if (pn < 4) {
#pragma unroll
            for (int ai = 0; ai < 2; ++ai)
#pragma unroll
                for (int m = 0; m < 4; ++m) { const int row = row0 + ai * 128 + m * 16; f32x4 o0, o1;
#pragma unroll
                    for (int j = 0; j < 4; ++j) { o0[j] = acc[ai][0][m][0][j] * sigmoidf_(acc[ai][1][m][0][j]); o1[j] = acc[ai][0][m][1][j] * sigmoidf_(acc[ai][1][m][1][j]); }
                    *(u32x4*)(aglu + (size_t)row * 512 + pn * 128 + wc * 32 + fq * 8) = pack8(o0, o1); }
        } else if (pn < 6 || (pn == 6 && wc < 2)) {
            bf16_t* dst; int ld, c0;
            if (pn < 6) { dst = q; ld = 512; c0 = ((pn - 4) * 4 + wc) * 64 + fq * 8; } else { dst = k; ld = 128; c0 = wc * 64 + fq * 8; }
#pragma unroll
            for (int ai = 0; ai < 2; ++ai)
#pragma unroll
                for (int m = 0; m < 4; ++m) { const int row = row0 + ai * 128 + m * 16;
                    f32x4 x1a = acc[ai][0][m][0], x1b = acc[ai][0][m][1], x2a = acc[ai][1][m][0], x2b = acc[ai][1][m][1];
                    if (isx) { const int s = row & (SEQ - 1); const float* cp = rope + (size_t)s * 32 + fq * 8; const float* sp = cp + 8192 * 32;
                        const f32x4 ca = *(const f32x4*)cp, cb = *(const f32x4*)(cp + 4), sa = *(const f32x4*)sp, sb = *(const f32x4*)(sp + 4);
                        const f32x4 o1a = x1a * ca - x2a * sa, o1b = x1b * cb - x2b * sb, o2a = x2a * ca + x1a * sa, o2b = x2b * cb + x1b * sb;
                        x1a = o1a; x1b = o1b; x2a = o2a; x2b = o2b; }
                    *(u32x4*)(dst + (size_t)row * ld + c0) = pack8(x1a, x1b);
                    *(u32x4*)(dst + (size_t)row * ld + c0 + 32) = pack8(x2a, x2b); }
        } else if (pn == 6) {
            const int d0 = (wc - 2) * 32 + fq * 8;
#pragma unroll
            for (int ai = 0; ai < 2; ++ai)
#pragma unroll
                for (int m = 0; m < 4; ++m) { const int row = row0 + ai * 128 + m * 16;
#pragma unroll
                    for (int bj = 0; bj < 2; ++bj) {
                        bf16_t* base; size_t st;
                        if (isx) { const int b = row >> 13, s = row & (SEQ - 1); base = vt + ((size_t)((b * 2 + bj) * 64 + d0)) * SEQ + perm16(s); st = SEQ; }
                        else { const int zz = row - TX, b = zz >> 8, cp = zz & 255; base = vt + (size_t)TX * 128 + ((size_t)((b * 2 + bj) * 64 + d0)) * CTXL + perm16(cp); st = CTXL; }
#pragma unroll
                        for (int j = 0; j < 4; ++j) { base[(size_t)j * st] = (bf16_t)f2bf(acc[ai][bj][m][0][j]); base[(size_t)(4 + j) * st] = (bf16_t)f2bf(acc[ai][bj][m][1][j]); } } }
        } else if (pn < 9) {
#pragma unroll
            for (int ai = 0; ai < 2; ++ai)
#pragma unroll
                for (int m = 0; m < 4; ++m) { const int row = row0 + ai * 128 + m * 16;
#pragma unroll
                    for (int bj = 0; bj < 2; ++bj) *(u32x4*)(u + (size_t)row * 512 + (pn - 7) * 256 + bj * 128 + wc * 32 + fq * 8) = pack8(acc[ai][bj][m][0], acc[ai][bj][m][1]); }
        } else {
            const int gc0 = (pn - 9) * 256 + wc * 32 + fq * 8;
            f32x4 bv[2][2];
#pragma unroll
            for (int bj = 0; bj < 2; ++bj)
#pragma unroll
                for (int n = 0; n < 2; ++n) bv[bj][n] = *(const f32x4*)(bgate + gc0 + bj * 128 + 4 * n);
#pragma unroll
            for (int ai = 0; ai < 2; ++ai)
#pragma unroll
                for (int m = 0; m < 4; ++m) { const int row = row0 + ai * 128 + m * 16;
#pragma unroll
                    for (int bj = 0; bj < 2; ++bj) { f32x4 o0, o1;
#pragma unroll
                        for (int j = 0; j < 4; ++j) { o0[j] = sigmoidf_(acc[ai][bj][m][0][j] + bv[bj][0][j]); o1[j] = sigmoidf_(acc[ai][bj][m][1][j] + bv[bj][1][j]); }
                        *(u32x4*)(g + (size_t)row * 3072 + gc0 + bj * 128) = pack8(o0, o1); } }
        }
    }
};
struct EpiBranch {
    static constexpr bool PERM = true;
    const bf16_t* g; bf16_t* mg;
    __device__ __forceinline__ void operator()(const f32x4 (&acc)[2][2][4][2], const GUnit& un, int wr, int wc, int fr, int fq) const {
        const int br = un.aux; const int row0 = un.pm * 256 + wr * 64 + fr; const int c0 = un.pn * 256 + wc * 32 + fq * 8;
#pragma unroll
        for (int ai = 0; ai < 2; ++ai)
#pragma unroll
            for (int m = 0; m < 4; ++m) { const int row = row0 + ai * 128 + m * 16;
#pragma unroll
                for (int bj = 0; bj < 2; ++bj) {
                    const u32x4 gw = *(const u32x4*)(g + (size_t)row * 3072 + br * 1024 + c0 + bj * 128);
                    f32x4 ga, gb; unpack8(gw, ga, gb);
                    f32x4 o0 = ga * acc[ai][bj][m][0], o1 = gb * acc[ai][bj][m][1];
                    bf16_t* mp = mg + (size_t)row * 1024 + c0 + bj * 128;
                    if (br != 0) { const u32x4 pw = *(const u32x4*)mp; f32x4 pa, pb; unpack8(pw, pa, pb); o0 += pa; o1 += pb; }
                    *(u32x4*)mp = pack8(o0, o1); }
                asm volatile("" ::: "memory"); }
    }
};
struct EpiWout {
    static constexpr bool PERM = false;
    const float* resx; const float* resz; float* X; const float* modl; int first;
    __device__ __forceinline__ void operator()(const f32x4 (&acc)[2][2][4][2], const GUnit& un, int wr, int wc, int fr, int fq) const {
        const int row0 = un.pm * 256 + wr * 64 + fr; const int c0 = un.pn * 256 + wc * 32 + fq * 4; const bool isx = un.pm < NTX;
        const int ms = isx ? (un.pm >> 5) : 8;
        const float* gp = modl + (size_t)ms * 6144 + 2 * 1024 + c0;
        f32x4 gv[2][2];
#pragma unroll
        for (int bj = 0; bj < 2; ++bj)
#pragma unroll
            for (int n = 0; n < 2; ++n) gv[bj][n] = *(const f32x4*)(gp + bj * 128 + n * 16);
#pragma unroll
        for (int ai = 0; ai < 2; ++ai)
#pragma unroll
            for (int m = 0; m < 4; ++m) { const int row = row0 + ai * 128 + m * 16;
                const float* rp = first ? (isx ? resx + (size_t)row * 1024 : resz + (size_t)(row - TX) * 1024) : X + (size_t)row * 1024;
#pragma unroll
                for (int bj = 0; bj < 2; ++bj)
#pragma unroll
                    for (int n = 0; n < 2; ++n) { const f32x4 r = *(const f32x4*)(rp + c0 + bj * 128 + n * 16);
                        *(f32x4*)(X + (size_t)row * 1024 + c0 + bj * 128 + n * 16) = r + gv[bj][n] * acc[ai][bj][m][n]; }
                asm volatile("" ::: "memory"); }
    }
};
struct EpiGU {
    static constexpr bool PERM = true;
    bf16_t* act; const float* bgu;
    __device__ __forceinline__ void operator()(const f32x4 (&acc)[2][2][4][2], const GUnit& un, int wr, int wc, int fr, int fq) const {
        const int e = un.aux; const int row0 = un.pm * 256 + wr * 64 + fr; const int c0 = un.pn * 128 + wc * 32 + fq * 8;
        const float* bp = bgu + (size_t)e * 2048 + c0;
        const f32x4 bg0 = *(const f32x4*)bp, bg1 = *(const f32x4*)(bp + 4), bu0 = *(const f32x4*)(bp + 1024), bu1 = *(const f32x4*)(bp + 1028);
#pragma unroll
        for (int ai = 0; ai < 2; ++ai)
#pragma unroll
            for (int m = 0; m < 4; ++m) { const int row = row0 + ai * 128 + m * 16; f32x4 o0, o1;
#pragma unroll
                for (int j = 0; j < 4; ++j) {
                    float g0 = fminf(acc[ai][0][m][0][j] + bg0[j], 7.0f), u0 = fminf(fmaxf(acc[ai][1][m][0][j] + bu0[j], -7.0f), 7.0f);
                    float g1 = fminf(acc[ai][0][m][1][j] + bg1[j], 7.0f), u1 = fminf(fmaxf(acc[ai][1][m][1][j] + bu1[j], -7.0f), 7.0f);
                    o0[j] = (u0 + 1.0f) * (g0 * sigmoidf_(1.702f * g0)); o1[j] = (u1 + 1.0f) * (g1 * sigmoidf_(1.702f * g1)); }
                *(u32x4*)(act + (size_t)row * 1024 + c0) = pack8(o0, o1); }
    }
};
struct EpiDown {
    static constexpr bool PERM = true;
    bf16_t* y; const float* bdn;
    __device__ __forceinline__ void operator()(const f32x4 (&acc)[2][2][4][2], const GUnit& un, int wr, int wc, int fr, int fq) const {
        const int e = un.aux; const int row0 = un.pm * 256 + wr * 64 + fr; const int c0 = un.pn * 256 + wc * 32 + fq * 8;
        const float* bp = bdn + (size_t)e * 1024 + c0;
        f32x4 bv[2][2];
#pragma unroll
        for (int bj = 0; bj < 2; ++bj)
#pragma unroll
            for (int n = 0; n < 2; ++n) bv[bj][n] = *(const f32x4*)(bp + bj * 128 + 4 * n);
#pragma unroll
        for (int ai = 0; ai < 2; ++ai)
#pragma unroll
            for (int m = 0; m < 4; ++m) { const int row = row0 + ai * 128 + m * 16;
#pragma unroll
                for (int bj = 0; bj < 2; ++bj) *(u32x4*)(y + (size_t)row * 1024 + c0 + bj * 128) = pack8(acc[ai][bj][m][0] + bv[bj][0], acc[ai][bj][m][1] + bv[bj][1]); }
    }
};
}

struct Args { const float* in[28]; float* out; unsigned char* ws; int ph_lo, ph_hi; };
struct Frame {
    LAS unsigned char* lds; unsigned char* ws; unsigned* ctl;
    int tid, lane, wave, vcu, G;
};

__device__ __forceinline__ int colmap_in(int n) {
    const int pn = n >> 8, lc = n & 255, bj = lc >> 7, c = lc & 127;
    if (pn < 4) return bj * 512 + pn * 128 + c;
    if (pn < 6) return 1024 + ((pn - 4) * 4 + (c >> 5)) * 64 + bj * 32 + (c & 31);
    if (pn == 6) return c < 64 ? 1536 + (c >> 5) * 64 + bj * 32 + (c & 31) : 1664 + bj * 64 + (c - 64);
    if (pn < 9) return 1792 + (pn - 7) * 256 + lc;
    return 2304 + (pn - 9) * 256 + lc;
}
__device__ __forceinline__ void transpose_item(const float* src, int ld, int k0, int c0, bf16_t* dst, int r0, int Kd, LAS float* scr, int lane) {
#pragma unroll 8
    for (int i = 0; i < 32; ++i) { const int kk = 2 * i + (lane >> 5); scr[kk * 33 + (lane & 31)] = src[(size_t)(k0 + kk) * ld + c0 + (lane & 31)]; }
    asm volatile("s_waitcnt lgkmcnt(0)" ::: "memory");
    const int c = lane & 7;
#pragma unroll
    for (int j = 0; j < 4; ++j) { const int n = (lane >> 3) + 8 * j; const LAS float* s = scr + (8 * c) * 33 + n;
        u32x4 o; o.x = pk2(s[0 * 33], s[1 * 33]); o.y = pk2(s[2 * 33], s[3 * 33]); o.z = pk2(s[4 * 33], s[5 * 33]); o.w = pk2(s[6 * 33], s[7 * 33]);
        *(u32x4*)(dst + (size_t)(r0 + n) * Kd + k0 + 8 * c) = o; }
    asm volatile("s_waitcnt lgkmcnt(0)" ::: "memory");
}
__device__ __forceinline__ void p_prologue(Frame& F, const Args& a) {
    float* mod = (float*)(F.ws + WS_MOD);
    if (blockIdx.x < 192) {
        const int l = blockIdx.x / 96, n0 = (blockIdx.x % 96) * 64;
        LAS float* sc = (LAS float*)F.lds; LAS float* part = (LAS float*)(F.lds + 36864);
        for (int i = F.tid; i < 9 * 1024; i += 512) { const float v = i < 8192 ? a.in[1][i] : a.in[3][i - 8192]; sc[i] = v * sigmoidf_(v); }
        __syncthreads();
        const int ks = F.tid >> 6, col = F.tid & 63;
        float accv[9];
#pragma unroll
        for (int s = 0; s < 9; ++s) accv[s] = 0.f;
        const float* wp = a.in[4] + (size_t)l * 1024 * 6144 + n0 + col;
        for (int k = ks * 128; k < ks * 128 + 128; ++k) { const float w = wp[(size_t)k * 6144];
#pragma unroll
            for (int s = 0; s < 9; ++s) accv[s] += sc[s * 1024 + k] * w; }
#pragma unroll
        for (int s = 0; s < 9; ++s) part[(ks * 9 + s) * 64 + col] = accv[s];
        __syncthreads();
        for (int i = F.tid; i < 576; i += 512) { const int s = i >> 6, cc = i & 63; float v = a.in[5][l * 6144 + n0 + cc];
#pragma unroll
            for (int k2 = 0; k2 < 8; ++k2) v += part[(k2 * 9 + s) * 64 + cc];
            mod[(size_t)(l * 9 + s) * 6144 + n0 + cc] = v; }
        __syncthreads();
    }
    {
        const double inv[16] = {1.0, 0.5623413251903491, 0.31622776601683794, 0.1778279410038923, 0.1, 0.05623413251903491, 0.03162277660168379, 0.01778279410038923,
                                0.01, 0.005623413251903491, 0.0031622776601683794, 0.0017782794100389228, 0.001, 0.0005623413251903491, 0.00031622776601683794, 0.00017782794100389227};
        float* rope = (float*)(F.ws + WS_ROPE);
        for (int idx = F.vcu * 512 + F.tid; idx < 8192 * 32; idx += F.G * 512) {
            const int s = idx >> 5, dd = idx & 31; const int pos = dd < 16 ? (s >> 6) : (s & 63); const int i = dd & 15;
            double iv = inv[0];
#pragma unroll
            for (int q = 1; q < 16; ++q) iv = (i == q) ? inv[q] : iv;
            const double ang = (double)((float)pos * (float)iv);
            double rev = ang * 0.15915494309189535; rev -= __builtin_rint(rev); const double r = rev * 6.283185307179586, r2 = r * r;
            double sn = -1.0 / 51090942171709440000.0;
            sn = sn * r2 + 1.0 / 121645100408832000.0; sn = sn * r2 - 1.0 / 355687428096000.0; sn = sn * r2 + 1.0 / 1307674368000.0; sn = sn * r2 - 1.0 / 6227020800.0;
            sn = sn * r2 + 1.0 / 39916800.0; sn = sn * r2 - 1.0 / 362880.0; sn = sn * r2 + 1.0 / 5040.0; sn = sn * r2 - 1.0 / 120.0; sn = sn * r2 + 1.0 / 6.0; sn = sn * r2 - 1.0; sn = -sn * r;
            double cs = 1.0 / 1124000727777607680000.0;
            cs = cs * r2 - 1.0 / 2432902008176640000.0; cs = cs * r2 + 1.0 / 6402373705728000.0; cs = cs * r2 - 1.0 / 20922789888000.0; cs = cs * r2 + 1.0 / 87178291200.0;
            cs = cs * r2 - 1.0 / 479001600.0; cs = cs * r2 + 1.0 / 3628800.0; cs = cs * r2 - 1.0 / 40320.0; cs = cs * r2 + 1.0 / 720.0; cs = cs * r2 - 1.0 / 24.0; cs = cs * r2 + 0.5; cs = 1.0 - cs * r2;
            rope[idx] = (float)cs; rope[8192 * 32 + idx] = (float)sn;
        }
    }
    const int gw = F.vcu * 8 + F.wave, NGW = F.G * 8;
    for (int it = gw; it < 2048; it += NGW) {
        const int l = it >> 10, r = it & 1023, g = r >> 8, c0 = ((r & 255) >> 4) * 8, n = (r & 15) * 64 + F.lane;
        const float* wp = a.in[16] + ((size_t)(l * 4 + g) * 128 + c0) * 128; const float* ps = a.in[17] + l * 512 + g * 128; const float* wo = a.in[18] + ((size_t)l * 512 + g * 128) * 1024 + n;
        float accv[8];
#pragma unroll
        for (int i = 0; i < 8; ++i) accv[i] = 0.f;
        for (int d = 0; d < 128; ++d) { const float wv = wo[(size_t)d * 1024] * ps[d];
#pragma unroll
            for (int i = 0; i < 8; ++i) accv[i] += wp[i * 128 + d] * wv; }
        bf16_t* dst = (bf16_t*)(F.ws + WS_W + (size_t)l * W_LAYER + W_PE) + (size_t)n * 512 + g * 128 + c0;
        u32x4 o; o.x = pk2(accv[0], accv[1]); o.y = pk2(accv[2], accv[3]); o.z = pk2(accv[4], accv[5]); o.w = pk2(accv[6], accv[7]);
        *(u32x4*)dst = o;
    }
    LAS float* scr = (LAS float*)(F.lds + F.wave * 16384);
    constexpr int I_IN = 16 * 168, I_P = 8 * 32, I_O = 16 * 32, I_GU = 32 * 1024, I_DN = 32 * 512, I_L = I_IN + 2 * I_P + I_O + I_GU + I_DN;
    for (int it = gw; it < 2 * I_L; it += NGW) {
        const int l = it / I_L; int r = it - l * I_L; unsigned char* wl = F.ws + WS_W + (size_t)l * W_LAYER;
        if (r < I_IN) { const int kb = r / 168, nb = r % 168; transpose_item(a.in[7] + (size_t)l * 1024 * DIN, DIN, kb * 64, colmap_in(nb * 32), (bf16_t*)(wl + W_IN), nb * 32, 1024, scr, F.lane); continue; } r -= I_IN;
        if (r < I_P) { const int kb = r / 32, nb = r % 32; transpose_item(a.in[13] + (size_t)l * 512 * 1024, 1024, kb * 64, nb * 32, (bf16_t*)(wl + W_CO), nb * 32, 512, scr, F.lane); continue; } r -= I_P;
        if (r < I_P) { const int kb = r / 32, nb = r % 32; transpose_item(a.in[15] + (size_t)l * 512 * 1024, 1024, kb * 64, nb * 32, (bf16_t*)(wl + W_AO), nb * 32, 512, scr, F.lane); continue; } r -= I_P;
        if (r < I_O) { const int kb = r / 32, nb = r % 32; transpose_item(a.in[19] + (size_t)l * 1024 * 1024, 1024, kb * 64, nb * 32, (bf16_t*)(wl + W_OUT), nb * 32, 1024, scr, F.lane); continue; } r -= I_O;
        if (r < I_GU) { const int e = r >> 10, rr = r & 1023, kb = rr >> 6, nb = rr & 63, n0 = nb * 32; const int pn = n0 >> 8, lc = n0 & 255, c0 = (lc >> 7) * 1024 + pn * 128 + (lc & 127);
            transpose_item(a.in[23] + (size_t)(l * 32 + e) * 1024 * 2048, 2048, kb * 64, c0, (bf16_t*)(wl + W_GU + (size_t)e * W_GU_E), n0, 1024, scr, F.lane); continue; } r -= I_GU;
        { const int e = r >> 9, rr = r & 511, kb = rr >> 5, nb = rr & 31;
            transpose_item(a.in[25] + (size_t)(l * 32 + e) * 1024 * 1024, 1024, kb * 64, nb * 32, (bf16_t*)(wl + W_DN + (size_t)e * W_DN_E), nb * 32, 1024, scr, F.lane); }
    }
}

__device__ __forceinline__ void p_norm0(Frame& F, const Args& a) {
    const float* mod = (const float*)(F.ws + WS_MOD); bf16_t* H = (bf16_t*)(F.ws + WS_H);
    const int gw = F.vcu * 8 + F.wave, NGW = F.G * 8;
    for (int row = gw; row < TA; row += NGW) {
        const bool isx = row < TX; const float* src = isx ? a.in[0] + (size_t)row * 1024 : a.in[2] + (size_t)(row - TX) * 1024; const int ms = isx ? (row >> 13) : 8;
        f32x4 v[4]; float ss = 0.f;
#pragma unroll
        for (int j = 0; j < 4; ++j) { v[j] = *(const f32x4*)(src + F.lane * 4 + 256 * j); ss += (v[j][0] * v[j][0] + v[j][1] * v[j][1]) + (v[j][2] * v[j][2] + v[j][3] * v[j][3]); }
        const float rstd = 1.0f / sqrtf(wave_sum(ss) * (1.0f / 1024.0f) + EPS);
        const float* mp = mod + (size_t)ms * 6144;
#pragma unroll
        for (int j = 0; j < 4; ++j) { const int c = F.lane * 4 + 256 * j;
            const f32x4 g = *(const f32x4*)(a.in[6] + c), sh = *(const f32x4*)(mp + c), sc = *(const f32x4*)(mp + 1024 + c);
            const f32x4 h = (v[j] * rstd * g) * (sc + 1.0f) + sh;
            u32x2 o; o.x = pk2(h[0], h[1]); o.y = pk2(h[2], h[3]); *(u32x2*)(H + (size_t)row * 1024 + c) = o; }
    }
}

constexpr int AT_ROWB = 144;
constexpr int AT_TILEB = 64 * AT_ROWB;
__device__ __forceinline__ int crow(int r, int hi) { return (r & 3) + 8 * (r >> 2) + 4 * hi; }
__device__ __forceinline__ void attn_unit(Frame& F, const bf16_t* Q, const bf16_t* Kb, const bf16_t* VT, bf16_t* AT, const float* sink, bool isz, int b, int n, int kvh, int gh) {
    const int tid = F.tid, lane = F.lane, wave = F.wave, r32 = lane & 31, hi = lane >> 5;
    const int qq = wave & 3, head = kvh * 4 + gh * 2 + (wave >> 2);
    const int qrow = (isz ? TX + b * CTXL : b * SEQ) + n * 128 + qq * 32;
    bf16x8 qf[4];
#pragma unroll
    for (int ks = 0; ks < 4; ++ks) qf[ks] = *(const bf16x8*)(Q + (size_t)(qrow + r32) * 512 + head * 64 + ks * 16 + hi * 8);
    const float c2 = 0.125f * LOG2E;
    float mrun = sink[head] * LOG2E, lrun = (hi == 0) ? 1.0f : 0.0f;
    f32x16 o0, o1;
#pragma unroll
    for (int r = 0; r < 16; ++r) { o0[r] = 0.f; o1[r] = 0.f; }
    const int ntile = isz ? 4 : 10 - (n == 0 ? 2 : 0) - (n == SEQ / 128 - 1 ? 2 : 0);
    const int srow = tid >> 3, chunk = tid & 7;
    LAS unsigned char* KS = F.lds; LAS unsigned char* VS = F.lds + 2 * AT_TILEB;
#define AT_DESC(ti, cc, ksrc, vsrc) do { int c_ = (ti); if (isz) c_ += 6; else { if (n == 0) c_ += 2; if (n == SEQ / 128 - 1 && c_ >= 4) c_ += 2; } cc = c_; \
        if (c_ < 6) { const int blk = n - 1 + (c_ >> 1), j0_ = (c_ & 1) * 64; ksrc = Kb + (size_t)(b * SEQ + blk * 128 + j0_ + srow) * 128 + kvh * 64 + chunk * 8; \
                      vsrc = VT + ((size_t)((b * 2 + kvh) * 64 + srow)) * SEQ + blk * 128 + j0_ + chunk * 8; } \
        else { const int j0_ = (c_ - 6) * 64; ksrc = Kb + (size_t)(TX + b * CTXL + j0_ + srow) * 128 + kvh * 64 + chunk * 8; \
               vsrc = VT + (size_t)TX * 128 + ((size_t)((b * 2 + kvh) * 64 + srow)) * CTXL + j0_ + chunk * 8; } } while (0)
    int ccur; const bf16_t* ksrc; const bf16_t* vsrc;
    AT_DESC(0, ccur, ksrc, vsrc);
    u32x4 kreg = *(const u32x4*)ksrc, vreg = *(const u32x4*)vsrc;
    *(LAS u32x4*)(KS + srow * AT_ROWB + chunk * 16) = kreg; *(LAS u32x4*)(VS + srow * AT_ROWB + chunk * 16) = vreg;
    __syncthreads();
    const int qi = qq * 32 + r32;
    for (int ti = 0; ti < ntile; ++ti) {
        const int buf = ti & 1; int cnext = 0;
        if (ti + 1 < ntile) { AT_DESC(ti + 1, cnext, ksrc, vsrc); kreg = *(const u32x4*)ksrc; vreg = *(const u32x4*)vsrc; }
        const int type = ccur < 2 ? 0 : (ccur < 4 ? 1 : (ccur < 6 ? 2 : 3));
        const int j0 = (ccur & 1) * 64;
        const bool skip = (type == 0 && j0 == 0 && qq >= 2) || (type == 2 && j0 == 64 && qq < 2);
        if (!skip) {
            const LAS unsigned char* kb_ = KS + buf * AT_TILEB + r32 * AT_ROWB + hi * 16;
            const LAS unsigned char* vb_ = VS + buf * AT_TILEB + r32 * AT_ROWB + hi * 16;
            f32x16 s0, s1;
#pragma unroll
            for (int r = 0; r < 16; ++r) { s0[r] = 0.f; s1[r] = 0.f; }
#pragma unroll
            for (int ks = 0; ks < 4; ++ks) {
                const bf16x8 k0 = *(const LAS bf16x8*)(kb_ + ks * 32), k1 = *(const LAS bf16x8*)(kb_ + 32 * AT_ROWB + ks * 32);
                s0 = __builtin_amdgcn_mfma_f32_32x32x16_bf16(k0, qf[ks], s0, 0, 0, 0);
                s1 = __builtin_amdgcn_mfma_f32_32x32x16_bf16(k1, qf[ks], s1, 0, 0, 0);
            }
            if (type == 0) {
#pragma unroll
                for (int r = 0; r < 16; ++r) { const int jj = j0 + crow(r, hi); if (jj < qi) s0[r] = -1e30f; if (jj + 32 < qi) s1[r] = -1e30f; }
            } else if (type == 2) {
#pragma unroll
                for (int r = 0; r < 16; ++r) { const int jj = j0 + crow(r, hi); if (jj > qi) s0[r] = -1e30f; if (jj + 32 > qi) s1[r] = -1e30f; }
            }
            float tm = fmaxf(s0[0], s1[0]);
#pragma unroll
            for (int r = 1; r < 16; ++r) tm = fmaxf(tm, fmaxf(s0[r], s1[r]));
            tm = fmaxf(tm, __shfl_xor(tm, 32));
            const float mn = fmaxf(mrun, tm * c2);
            const float alpha = __builtin_amdgcn_exp2f(mrun - mn);
            mrun = mn;
            float ls = 0.f;
#pragma unroll
            for (int r = 0; r < 16; ++r) { s0[r] = __builtin_amdgcn_exp2f(s0[r] * c2 - mn); s1[r] = __builtin_amdgcn_exp2f(s1[r] * c2 - mn); ls += s0[r] + s1[r]; }
            lrun = lrun * alpha + ls;
#pragma unroll
            for (int r = 0; r < 16; ++r) { o0[r] *= alpha; o1[r] *= alpha; }
            u32x4 pw[4];
            pw[0] = (u32x4){pk2(s0[0], s0[1]), pk2(s0[2], s0[3]), pk2(s0[4], s0[5]), pk2(s0[6], s0[7])};
            pw[1] = (u32x4){pk2(s0[8], s0[9]), pk2(s0[10], s0[11]), pk2(s0[12], s0[13]), pk2(s0[14], s0[15])};
            pw[2] = (u32x4){pk2(s1[0], s1[1]), pk2(s1[2], s1[3]), pk2(s1[4], s1[5]), pk2(s1[6], s1[7])};
            pw[3] = (u32x4){pk2(s1[8], s1[9]), pk2(s1[10], s1[11]), pk2(s1[12], s1[13]), pk2(s1[14], s1[15])};
#pragma unroll
            for (int kk = 0; kk < 4; ++kk) {
                const bf16x8 v0 = *(const LAS bf16x8*)(vb_ + kk * 32), v1 = *(const LAS bf16x8*)(vb_ + 32 * AT_ROWB + kk * 32);
                o0 = __builtin_amdgcn_mfma_f32_32x32x16_bf16(v0, __builtin_bit_cast(bf16x8, pw[kk]), o0, 0, 0, 0);
                o1 = __builtin_amdgcn_mfma_f32_32x32x16_bf16(v1, __builtin_bit_cast(bf16x8, pw[kk]), o1, 0, 0, 0);
            }
        }
        if (ti + 1 < ntile) {
            *(LAS u32x4*)(KS + (buf ^ 1) * AT_TILEB + srow * AT_ROWB + chunk * 16) = kreg; *(LAS u32x4*)(VS + (buf ^ 1) * AT_TILEB + srow * AT_ROWB + chunk * 16) = vreg;
        }
        ccur = cnext;
        __syncthreads();
    }
#undef AT_DESC
    {
        const float lt = lrun + __shfl_xor(lrun, 32); const float inv = 1.0f / lt;
        bf16_t* op = AT + (size_t)(qrow + r32) * 512 + head * 64 + 4 * hi;
#pragma unroll
        for (int gi = 0; gi < 4; ++gi) { u32x2 w; w.x = pk2(o0[4 * gi] * inv, o0[4 * gi + 1] * inv); w.y = pk2(o0[4 * gi + 2] * inv, o0[4 * gi + 3] * inv); *(u32x2*)(op + 8 * gi) = w;
            u32x2 w2; w2.x = pk2(o1[4 * gi] * inv, o1[4 * gi + 1] * inv); w2.y = pk2(o1[4 * gi + 2] * inv, o1[4 * gi + 3] * inv); *(u32x2*)(op + 32 + 8 * gi) = w2; }
    }
}

__device__ __forceinline__ void conv_task(Frame& F, int tk, const bf16_t* AG, bf16_t* AC, const LAS float* wl, const float* bdw, const float* lng, const float* lnb) {
    const int t0 = tk * 8; int s0, s1;
    if (t0 < TX) { s0 = t0 & ~(SEQ - 1); s1 = s0 + SEQ; } else { s0 = TX + ((t0 - TX) & ~(CTXL - 1)); s1 = s0 + CTXL; }
    const int cA = 4 * F.lane;
    float acc[8][8];
#pragma unroll
    for (int o = 0; o < 8; ++o)
#pragma unroll
        for (int i = 0; i < 8; ++i) acc[o][i] = 0.f;
#pragma unroll 1
    for (int r = -15; r <= 22; ++r) {
        const int row = t0 + r; const bool inr = row >= s0 && row < s1; const int rr = inr ? row : t0;
        const u32x2 wa = *(const u32x2*)(AG + (size_t)rr * 512 + cA), wb = *(const u32x2*)(AG + (size_t)rr * 512 + 256 + cA);
        float x[8];
        x[0] = inr ? bflo(wa.x) : 0.f; x[1] = inr ? bfhi(wa.x) : 0.f; x[2] = inr ? bflo(wa.y) : 0.f; x[3] = inr ? bfhi(wa.y) : 0.f;
        x[4] = inr ? bflo(wb.x) : 0.f; x[5] = inr ? bfhi(wb.x) : 0.f; x[6] = inr ? bflo(wb.y) : 0.f; x[7] = inr ? bfhi(wb.y) : 0.f;
#pragma unroll
        for (int o = 0; o < 8; ++o) { const int j = r - o + 15;
            if ((unsigned)j <= 30u) { const f32x4 w0 = *(const LAS f32x4*)(wl + j * 512 + cA), w1 = *(const LAS f32x4*)(wl + j * 512 + 256 + cA);
#pragma unroll
                for (int i = 0; i < 4; ++i) { acc[o][i] += w0[i] * x[i]; acc[o][4 + i] += w1[i] * x[4 + i]; } } }
    }
    const f32x4 b0 = *(const f32x4*)(bdw + cA), b1 = *(const f32x4*)(bdw + 256 + cA), g0 = *(const f32x4*)(lng + cA), g1 = *(const f32x4*)(lng + 256 + cA),
                e0 = *(const f32x4*)(lnb + cA), e1 = *(const f32x4*)(lnb + 256 + cA);
#pragma unroll
    for (int o = 0; o < 8; ++o) {
        float v[8]; float s = 0.f;
#pragma unroll
        for (int i = 0; i < 4; ++i) { v[i] = acc[o][i] + b0[i]; v[4 + i] = acc[o][4 + i] + b1[i]; s += v[i] + v[4 + i]; }
        const float mu = wave_sum(s) * (1.0f / 512.0f); float q = 0.f;
#pragma unroll
        for (int i = 0; i < 8; ++i) { v[i] -= mu; q += v[i] * v[i]; }
        const float rstd = 1.0f / sqrtf(wave_sum(q) * (1.0f / 512.0f) + EPS);
        float y[8];
#pragma unroll
        for (int i = 0; i < 4; ++i) { const float ya = v[i] * rstd * g0[i] + e0[i], yb = v[4 + i] * rstd * g1[i] + e1[i]; y[i] = ya * sigmoidf_(ya); y[4 + i] = yb * sigmoidf_(yb); }
        u32x2 oa, ob; oa.x = pk2(y[0], y[1]); oa.y = pk2(y[2], y[3]); ob.x = pk2(y[4], y[5]); ob.y = pk2(y[6], y[7]);
        *(u32x2*)(AC + (size_t)(t0 + o) * 512 + cA) = oa; *(u32x2*)(AC + (size_t)(t0 + o) * 512 + 256 + cA) = ob;
    }
}
__device__ __forceinline__ void pool_task(Frame& F, int tk, const bf16_t* U, bf16_t* PL) {
    const int t0 = tk * 8; int s0, s1;
    if (t0 < TX) { s0 = t0 & ~(SEQ - 1); s1 = s0 + SEQ; } else { s0 = TX + ((t0 - TX) & ~(CTXL - 1)); s1 = s0 + CTXL; }
    const int c0 = 8 * F.lane; const int hw = 1 << (F.lane >> 4);
    float acc[8][8], cnt[8];
#pragma unroll
    for (int o = 0; o < 8; ++o) { cnt[o] = 0.f;
#pragma unroll
        for (int i = 0; i < 8; ++i) acc[o][i] = 0.f; }
#pragma unroll 1
    for (int r = -8; r <= 14; ++r) {
        const int row = t0 + r; const bool inr = row >= s0 && row < s1; const int rr = inr ? row : t0;
        const u32x4 w = *(const u32x4*)(U + (size_t)rr * 512 + c0);
        f32x4 xa, xb; unpack8(w, xa, xb);
#pragma unroll
        for (int o = 0; o < 8; ++o) { const int rel = r - o;
            const float mm = (inr && rel >= -hw && rel < hw) ? 1.0f : 0.0f; cnt[o] += mm;
#pragma unroll
            for (int i = 0; i < 4; ++i) { acc[o][i] += mm * xa[i]; acc[o][4 + i] += mm * xb[i]; } }
    }
#pragma unroll
    for (int o = 0; o < 8; ++o) {
        const u32x4 w = *(const u32x4*)(U + (size_t)(t0 + o) * 512 + c0); f32x4 xa, xb; unpack8(w, xa, xb);
        const float ic = 1.0f / cnt[o]; f32x4 pa, pb;
#pragma unroll
        for (int i = 0; i < 4; ++i) { pa[i] = acc[o][i] * ic - xa[i]; pb[i] = acc[o][4 + i] * ic - xb[i]; }
        *(u32x4*)(PL + (size_t)(t0 + o) * 512 + c0) = pack8(pa, pb);
    }
}

__device__ __forceinline__ void moe_tables(Frame& F, int l) {
    LAS unsigned* tab = (LAS unsigned*)(F.lds + LDS_TAB);
    __syncthreads();
    if (F.tid < 32) { const unsigned n = __hip_atomic_load(F.ctl + CW_CNT + (l * 32 + F.tid) * 64, __ATOMIC_RELAXED, __HIP_MEMORY_SCOPE_AGENT); tab[F.tid] = n; tab[1400 + F.tid] = (n + 255u) >> 8; }
    __syncthreads();
    if (F.tid < 32) { unsigned tb = 0; for (int e = 0; e < F.tid; ++e) tb += tab[1400 + e]; const unsigned nte = tab[1400 + F.tid]; tab[32 + F.tid] = tb; if (F.tid == 31) tab[64] = tb + nte;
        for (unsigned i = 0; i < nte; ++i) tab[96 + tb + i] = (unsigned)F.tid; }
    __syncthreads();
}

__device__ __forceinline__ void p_route(Frame& F, const Args& a, int l) {
    const float* mod = (const float*)(F.ws + WS_MOD) + (size_t)l * 9 * 6144; const float* X = (const float*)(F.ws + WS_X); bf16_t* H = (bf16_t*)(F.ws + WS_H);
    unsigned* TI = (unsigned*)(F.ws + WS_TI); float* TG = (float*)(F.ws + WS_TG); unsigned* LIST = (unsigned*)(F.ws + WS_LIST);
    const float* rw = a.in[21] + (size_t)l * 1024 * 32; const float* rb = a.in[22] + l * 32; const float* n2g = a.in[20] + l * 1024;
    LAS unsigned char* WH = F.lds; LAS unsigned char* WL = F.lds + 65536; LAS float* LG = (LAS float*)(F.lds + 131072) + F.wave * 512;
    LAS unsigned* hist = (LAS unsigned*)(F.lds + 131072 + 16384); LAS unsigned* basel = hist + 32;
    const int tid = F.tid, lane = F.lane;
    for (int idx = tid; idx < 32768; idx += 512) { const int c = idx >> 5, e = idx & 31; const float w = rw[idx]; const unsigned h = f2bf(w); const float wh = __builtin_bit_cast(float, h << 16); const unsigned lo = f2bf(w - wh);
        const int ad = e * 2048 + (((c >> 3) ^ (e & 15)) * 16) + (c & 7) * 2; *(LAS bf16_t*)(WH + ad) = (bf16_t)h; *(LAS bf16_t*)(WL + ad) = (bf16_t)lo; }
    if (tid < 32) hist[tid] = 0u;
    __syncthreads();
    const int niter = (l == 0 ? TA : TX) / 128;
    const int tt = lane & 15, q = lane >> 4;
    for (int it = blockIdx.x; it < niter; it += F.G) {
        const int trow = it * 128 + F.wave * 16 + tt; const int ms = trow < TX ? (trow >> 13) : 8;
        const float* xr = X + (size_t)trow * 1024 + q * 8; const float* mp = mod + (size_t)ms * 6144;
        float ss = 0.f;
#pragma unroll 8
        for (int ks = 0; ks < 32; ++ks) { const f32x4 xa = *(const f32x4*)(xr + ks * 32), xb = *(const f32x4*)(xr + ks * 32 + 4);
            ss += (xa[0] * xa[0] + xa[1] * xa[1]) + (xa[2] * xa[2] + xa[3] * xa[3]) + (xb[0] * xb[0] + xb[1] * xb[1]) + (xb[2] * xb[2] + xb[3] * xb[3]); }
        ss += __shfl_xor(ss, 16); ss += __shfl_xor(ss, 32);
        const float rstd = 1.0f / sqrtf(ss * (1.0f / 1024.0f) + EPS);
        f32x4 lacc[2]; lacc[0] = (f32x4){0.f, 0.f, 0.f, 0.f}; lacc[1] = lacc[0];
#pragma unroll 2
        for (int ks = 0; ks < 32; ++ks) { const int c = ks * 32 + q * 8;
            const f32x4 xa = *(const f32x4*)(xr + ks * 32), xb = *(const f32x4*)(xr + ks * 32 + 4);
            const f32x4 ga = *(const f32x4*)(n2g + c), gb = *(const f32x4*)(n2g + c + 4), sca = *(const f32x4*)(mp + 4 * 1024 + c), scb = *(const f32x4*)(mp + 4 * 1024 + c + 4),
                        sha = *(const f32x4*)(mp + 3 * 1024 + c), shb = *(const f32x4*)(mp + 3 * 1024 + c + 4);
            const f32x4 ha = (xa * rstd * ga) * (sca + 1.0f) + sha, hb = (xb * rstd * gb) * (scb + 1.0f) + shb;
            const u32x4 hw = pack8(ha, hb); f32x4 ra, rbb; unpack8(hw, ra, rbb);
            const u32x4 lw = pack8(ha - ra, hb - rbb);
            *(u32x4*)(H + (size_t)trow * 1024 + c) = hw;
            const bf16x8 Ah = __builtin_bit_cast(bf16x8, hw), Al = __builtin_bit_cast(bf16x8, lw);
#pragma unroll
            for (int nb = 0; nb < 2; ++nb) { const int e = nb * 16 + tt; const int ad = e * 2048 + (((ks * 4 + q) ^ tt) * 16);
                const bf16x8 bh = *(const LAS bf16x8*)(WH + ad), bl = *(const LAS bf16x8*)(WL + ad);
                lacc[nb] = __builtin_amdgcn_mfma_f32_16x16x32_bf16(Ah, bh, lacc[nb], 0, 0, 0);
                lacc[nb] = __builtin_amdgcn_mfma_f32_16x16x32_bf16(Ah, bl, lacc[nb], 0, 0, 0);
                lacc[nb] = __builtin_amdgcn_mfma_f32_16x16x32_bf16(Al, bh, lacc[nb], 0, 0, 0); }
        }
#pragma unroll
        for (int nb = 0; nb < 2; ++nb) { const float bias = rb[nb * 16 + tt];
#pragma unroll
            for (int r = 0; r < 4; ++r) LG[(4 * q + r) * 32 + nb * 16 + tt] = lacc[nb][r] + bias; }
        asm volatile("s_waitcnt lgkmcnt(0)" ::: "memory");
        int be[4] = {0, 0, 0, 0}; float gt[4] = {0.f, 0.f, 0.f, 0.f}; unsigned rk[4] = {0u, 0u, 0u, 0u};
        if (lane < 16) {
            float lg[32];
#pragma unroll
            for (int j = 0; j < 8; ++j) { const f32x4 v = *(const LAS f32x4*)(LG + lane * 32 + 4 * j); lg[4 * j] = v[0]; lg[4 * j + 1] = v[1]; lg[4 * j + 2] = v[2]; lg[4 * j + 3] = v[3]; }
            float bv[4];
#pragma unroll
            for (int k = 0; k < 4; ++k) { float best = lg[0]; int bi = 0;
#pragma unroll
                for (int e = 1; e < 32; ++e) { const bool gtb = lg[e] > best; best = gtb ? lg[e] : best; bi = gtb ? e : bi; }
                bv[k] = best; be[k] = bi;
#pragma unroll
                for (int e = 0; e < 32; ++e) lg[e] = (e == bi) ? -3.0e38f : lg[e]; }
            float sum = 0.f;
#pragma unroll
            for (int k = 0; k < 4; ++k) { gt[k] = __expf(bv[k] - bv[0]); sum += gt[k]; }
            const float isum = 1.0f / sum;
#pragma unroll
            for (int k = 0; k < 4; ++k) { gt[k] *= isum; rk[k] = __hip_atomic_fetch_add(hist + be[k], 1u, __ATOMIC_RELAXED, __HIP_MEMORY_SCOPE_WORKGROUP); }
        }
        __syncthreads();
        if (tid < 32) { const unsigned nn = hist[tid]; unsigned bs = 0u; if (nn) bs = __hip_atomic_fetch_add(F.ctl + CW_CNT + (l * 32 + tid) * 64, nn, __ATOMIC_RELAXED, __HIP_MEMORY_SCOPE_AGENT); basel[tid] = bs; }
        __syncthreads();
        if (lane < 16) { const int trw = it * 128 + F.wave * 16 + lane;
#pragma unroll
            for (int k = 0; k < 4; ++k) { const unsigned slot = basel[be[k]] + rk[k]; TI[(size_t)trw * 4 + k] = ((unsigned)be[k] << 20) | slot; TG[(size_t)trw * 4 + k] = gt[k]; LIST[(size_t)be[k] * TA + slot] = (unsigned)trw; } }
        __syncthreads();
        if (tid < 32) hist[tid] = 0u;
        __syncthreads();
    }
}

__device__ __forceinline__ void p_comb(Frame& F, const Args& a, int l) {
    const float* mod = (const float*)(F.ws + WS_MOD); float* X = (float*)(F.ws + WS_X); bf16_t* H = (bf16_t*)(F.ws + WS_H); const bf16_t* Y = (const bf16_t*)(F.ws + WS_R2);
    const unsigned* TI = (const unsigned*)(F.ws + WS_TI); const float* TG = (const float*)(F.ws + WS_TG);
    const LAS unsigned* tab = (const LAS unsigned*)(F.lds + LDS_TAB);
    const int gw = F.vcu * 8 + F.wave, NGW = F.G * 8; const int nrow = l == 0 ? TA : TX; const bool lastl = l == 1;
    for (int row = gw; row < nrow; row += NGW) {
        const int ms = row < TX ? (row >> 13) : 8;
        const u32x4 ti = *(const u32x4*)(TI + (size_t)row * 4); const f32x4 tg = *(const f32x4*)(TG + (size_t)row * 4);
        f32x4 f[4];
#pragma unroll
        for (int j = 0; j < 4; ++j) f[j] = (f32x4){0.f, 0.f, 0.f, 0.f};
#pragma unroll
        for (int k = 0; k < 4; ++k) { const unsigned info = ti[k]; const unsigned e = info >> 20, slot = info & 0xfffffu; const size_t pos = (size_t)tab[32 + e] * 256 + slot; const float gk = tg[k];
            const bf16_t* yr = Y + pos * 1024 + F.lane * 4;
#pragma unroll
            for (int j = 0; j < 4; ++j) { const u32x2 w = *(const u32x2*)(yr + 256 * j); f[j] += (f32x4){bflo(w.x), bfhi(w.x), bflo(w.y), bfhi(w.y)} * gk; } }
        const float* g2 = mod + (size_t)(l * 9 + ms) * 6144 + 5 * 1024;
        f32x4 v[4]; float ss = 0.f;
#pragma unroll
        for (int j = 0; j < 4; ++j) { const int c = F.lane * 4 + 256 * j; v[j] = *(const f32x4*)(X + (size_t)row * 1024 + c) + *(const f32x4*)(g2 + c) * f[j];
            ss += (v[j][0] * v[j][0] + v[j][1] * v[j][1]) + (v[j][2] * v[j][2] + v[j][3] * v[j][3]); }
        const float rstd = 1.0f / sqrtf(wave_sum(ss) * (1.0f / 1024.0f) + EPS);
        if (!lastl) {
            const float* mp = mod + (size_t)(9 + ms) * 6144; const float* n1g = a.in[6] + 1024;
#pragma unroll
            for (int j = 0; j < 4; ++j) { const int c = F.lane * 4 + 256 * j; *(f32x4*)(X + (size_t)row * 1024 + c) = v[j];
                const f32x4 g = *(const f32x4*)(n1g + c), sh = *(const f32x4*)(mp + c), sc = *(const f32x4*)(mp + 1024 + c);
                const f32x4 h = (v[j] * rstd * g) * (sc + 1.0f) + sh;
                u32x2 o; o.x = pk2(h[0], h[1]); o.y = pk2(h[2], h[3]); *(u32x2*)(H + (size_t)row * 1024 + c) = o; }
        } else {
#pragma unroll
            for (int j = 0; j < 4; ++j) { const int c = F.lane * 4 + 256 * j; *(f32x4*)(a.out + (size_t)row * 1024 + c) = v[j] * rstd * *(const f32x4*)(a.in[27] + c); }
        }
    }
}

__global__ void __launch_bounds__(512, 2) mk_fwd(Args args) {
    extern __shared__ __attribute__((aligned(16))) unsigned char lds_raw[];
    Frame F;
    F.lds = (LAS unsigned char*)lds_raw; F.ws = args.ws; F.ctl = (unsigned*)(args.ws + WS_CTL);
    F.tid = threadIdx.x; F.lane = F.tid & 63; F.wave = __builtin_amdgcn_readfirstlane(F.tid >> 6);
    F.G = gridDim.x; { const int bx = blockIdx.x; F.vcu = (F.G % 8 == 0) ? (bx % 8) * (F.G / 8) + bx / 8 : bx; }
    volatile LAS unsigned* MISC = (volatile LAS unsigned*)(F.lds + LDS_MISC);
    if (F.tid < 64) MISC[F.tid] = 0u;
    __syncthreads();
    XcdBarrier bar; bar.bar = (unsigned*)(F.ctl + CW_BAR); bar.x = 0; bar.st = nullptr;
#if !MK_PER_PHASE
    bar = xcd_barrier_post((unsigned*)(F.ctl + CW_BAR), MISC + 8);
#endif
    const int lo = args.ph_lo, hi = args.ph_hi; int bxo = blockIdx.x;
#ifndef PH_MASK
#define PH_MASK 0x3ff
#endif
#define INT(k, ty) (((PH_MASK >> (ty)) & 1) && lo <= (k) && (k) < hi)
#define IN(k) (lo <= (k) && (k) < hi)
#define REFRESH() do { int t_ = threadIdx.x; asm volatile("" : "+v"(t_)); F.tid = t_; F.lane = t_ & 63; int b_ = blockIdx.x; asm volatile("" : "+s"(b_)); bxo = b_; F.vcu = (F.G % 8 == 0) ? (b_ % 8) * (F.G / 8) + b_ / 8 : b_; } while (0)
#define SEAM(k) do { if (IN((k) + 1)) { xcd_barrier(bar); } } while (0)

    if (INT(0, 0)) { REFRESH(); p_prologue(F, args); SEAM(0); }
    if (INT(1, 1)) { REFRESH(); p_norm0(F, args); SEAM(1); }

    for (int l = 0; l < 2; ++l) {
        const int pb = 2 + l * 8;
        unsigned char* wl = F.ws + WS_W + (size_t)l * W_LAYER;
        unsigned char* r1 = F.ws + WS_R1; unsigned char* r2 = F.ws + WS_R2;
        const float* modl = (const float*)(F.ws + WS_MOD) + (size_t)l * 9 * 6144;
        const int nrt = l == 0 ? NTA : NTX;

        if (INT(pb + 0, 2)) { REFRESH();
            g8::SchedDense<1024> S{(const char*)(F.ws + WS_H), (const char*)(wl + W_IN), nrt, 21, F.G, bxo, l == 0 ? 0 : NTZ, 6};
            g8::EpiInProj E{(bf16_t*)(r1 + R1_AGLU), (bf16_t*)(r1 + R1_Q), (bf16_t*)(r1 + R1_K), (bf16_t*)(r1 + R1_VT), (bf16_t*)(r1 + R1_U), (bf16_t*)(r1 + R1_G),
                            args.in[8] + l * 3072, (const float*)(F.ws + WS_ROPE)};
            g8::gemm_phase<1024>(F.lds, S, E, F.tid);
            SEAM(pb + 0);
        }
        if (INT(pb + 1, 3)) { REFRESH();
            const bf16_t* Q = (const bf16_t*)(r1 + R1_Q); const bf16_t* Kb = (const bf16_t*)(r1 + R1_K); const bf16_t* VT = (const bf16_t*)(r1 + R1_VT);
            bf16_t* AT = (bf16_t*)(r2 + R2_AT); const float* sink = args.in[14] + l * 8;
            __syncthreads();
#if !defined(MIX_SUB) || (MIX_SUB & 1)
            {
                const int nu = l == 0 ? 2112 : 2048;
                for (int i = 0; i < 9; ++i) {
                    int id;
                    if (F.G == 256) { if (i < 8) id = F.vcu * 8 + i; else { if (F.vcu >= 64) break; id = 2048 + F.vcu; } }
                    else { id = F.vcu + i * F.G; if (i >= 9) break; }
                    if (id >= nu) break;
                    if (id < 2048) attn_unit(F, Q, Kb, VT, AT, sink, false, id >> 8, (id & 255) >> 2, (id >> 1) & 1, id & 1);
                    else { const int zz = id - 2048; attn_unit(F, Q, Kb, VT, AT, sink, true, zz >> 3, (zz >> 2) & 1, (zz >> 1) & 1, zz & 1); }
                }
                if (F.G != 256) for (int id = F.vcu + 9 * F.G; id < nu; id += F.G) {
                    if (id < 2048) attn_unit(F, Q, Kb, VT, AT, sink, false, id >> 8, (id & 255) >> 2, (id >> 1) & 1, id & 1);
                    else { const int zz = id - 2048; attn_unit(F, Q, Kb, VT, AT, sink, true, zz >> 3, (zz >> 2) & 1, (zz >> 1) & 1, zz & 1); }
                }
            }
#endif
            __syncthreads();
            LAS float* wlds = (LAS float*)F.lds;
            for (int i = F.tid; i < 31 * 512; i += 512) wlds[i] = args.in[9][(size_t)l * 31 * 512 + i];
            __syncthreads();
            const int ntask = (l == 0 ? TA : TX) / 8; const int gw = F.vcu * 8 + F.wave, NGW = F.G * 8;
#if !defined(MIX_SUB) || (MIX_SUB & 2)
            for (int tk = gw; tk < ntask; tk += NGW)
                conv_task(F, tk, (const bf16_t*)(r1 + R1_AGLU), (bf16_t*)(r2 + R2_AC), wlds, args.in[10] + l * 512, args.in[11] + l * 512, args.in[12] + l * 512);
#endif
#if !defined(MIX_SUB) || (MIX_SUB & 4)
            for (int tk = gw; tk < ntask; tk += NGW) pool_task(F, tk, (const bf16_t*)(r1 + R1_U), (bf16_t*)(r2 + R2_PL));
#endif
            SEAM(pb + 1);
        }
        if (INT(pb + 2, 4)) { REFRESH();
            g8::SchedBranch S{(const char*)(r2 + R2_AC), (const char*)(wl + W_CO), R2_AT, W_P_B, nrt, F.G, bxo};
            g8::EpiBranch E{(const bf16_t*)(r1 + R1_G), (bf16_t*)(r2 + R2_MG)};
            g8::gemm_phase<512>(F.lds, S, E, F.tid);
            SEAM(pb + 2);
        }
        if (INT(pb + 3, 5)) { REFRESH();
            g8::SchedDense<1024> S{(const char*)(r2 + R2_MG), (const char*)(wl + W_OUT), nrt, 4, F.G, bxo, 0, 0};
            g8::EpiWout E{args.in[0], args.in[2], (float*)(F.ws + WS_X), modl, l == 0 ? 1 : 0};
            g8::gemm_phase<1024>(F.lds, S, E, F.tid);
            SEAM(pb + 3);
        }
        if (INT(pb + 4, 6)) { REFRESH(); __syncthreads(); p_route(F, args, l); SEAM(pb + 4); }
        if (INT(pb + 5, 7)) { REFRESH();
            moe_tables(F, l);
            g8::SchedMoE<true> S{(const char*)(F.ws + WS_H), (const char*)(wl + W_GU), W_GU_E, (const unsigned*)(F.ws + WS_LIST), (const LAS unsigned*)(F.lds + LDS_TAB), 8, F.G, bxo};
            g8::EpiGU E{(bf16_t*)r1, args.in[24] + (size_t)l * 32 * 2048};
            g8::gemm_phase<1024>(F.lds, S, E, F.tid);
            SEAM(pb + 5);
        }
        if (INT(pb + 6, 8)) { REFRESH();
            moe_tables(F, l);
            g8::SchedMoE<false> S{(const char*)r1, (const char*)(wl + W_DN), W_DN_E, nullptr, (const LAS unsigned*)(F.lds + LDS_TAB), 4, F.G, bxo};
            g8::EpiDown E{(bf16_t*)r2, args.in[26] + (size_t)l * 32 * 1024};
            g8::gemm_phase<1024>(F.lds, S, E, F.tid);
            SEAM(pb + 6);
        }
        if (INT(pb + 7, 9)) { REFRESH(); moe_tables(F, l); p_comb(F, args, l); SEAM(pb + 7); }
    }
#undef IN
#undef INT
#undef SEAM
}

extern "C" void kernel_launch(void* const* d_in, const int* in_sizes, int n_in, void* d_out, int out_size, void* d_ws, size_t ws_size, hipStream_t stream) {
    static int grid = 0;
    if (grid == 0) {
        if (n_in != 28 || out_size != TX * D || ws_size < WS_END) { fprintf(stderr, "kernel_launch: unexpected shapes (n_in %d out %d ws %zu need %zu)\n", n_in, out_size, ws_size, (size_t)WS_END); grid = -1; return; }
        int dev = 0, cus = 0, per_cu = 0;
        if (hipGetDevice(&dev) != hipSuccess || hipDeviceGetAttribute(&cus, hipDeviceAttributeMultiprocessorCount, dev) != hipSuccess) { grid = -1; return; }
        if (hipFuncSetAttribute((const void*)mk_fwd, hipFuncAttributeMaxDynamicSharedMemorySize, LDS_BYTES) != hipSuccess) { fprintf(stderr, "kernel_launch: hipFuncSetAttribute failed\n"); grid = -1; return; }
        if (hipOccupancyMaxActiveBlocksPerMultiprocessor(&per_cu, (const void*)mk_fwd, 512, LDS_BYTES) != hipSuccess || per_cu < 1) { fprintf(stderr, "kernel_launch: occupancy query says %d\n", per_cu); }
        (void)hipGetLastError();
        grid = cus;
    }
    if (grid < 0) return;
    (void)in_sizes;
    hipMemsetAsync((char*)d_ws + WS_CTL, 0, CTL_BYTES, stream);
    Args a{};
    for (int i = 0; i < 28; ++i) a.in[i] = (const float*)d_in[i];
    a.out = (float*)d_out; a.ws = (unsigned char*)d_ws;
#if MK_PER_PHASE
    for (int p = 0; p < NPH; ++p) { a.ph_lo = p; a.ph_hi = p + 1; hipLaunchKernelGGL(mk_fwd, dim3(grid), dim3(512), LDS_BYTES, stream, a); }
#else
    a.ph_lo = 0; a.ph_hi = NPH; hipLaunchKernelGGL(mk_fwd, dim3(grid), dim3(512), LDS_BYTES, stream, a);
#endif
}
```

```cpp
#include <hip/hip_runtime.h>
#include <cstdio>
#include <cstdint>

#ifndef GEMM_STAGGER
#define GEMM_STAGGER 0
#endif
#ifndef XBF16
#define XBF16 1
#endif
#ifndef PG8_ALIGN_EPI
#define PG8_ALIGN_EPI 1
#endif
#ifndef MK_PER_PHASE
#define MK_PER_PHASE 0
#endif

#define GAS __attribute__((address_space(1)))
#define LAS __attribute__((address_space(3)))
typedef unsigned short bf16_t;
typedef short bf16x8 __attribute__((ext_vector_type(8)));
typedef float f32x2 __attribute__((ext_vector_type(2)));
typedef float f32x4 __attribute__((ext_vector_type(4)));
typedef float f32x16 __attribute__((ext_vector_type(16)));
typedef unsigned u32x2 __attribute__((ext_vector_type(2)));
typedef unsigned u32x4 __attribute__((ext_vector_type(4)));
typedef __bf16 bf16x2_t __attribute__((ext_vector_type(2)));

constexpr int D = 1024, NB = 8, SEQ = 8192, CTXL = 256;
constexpr int TX = NB * SEQ, TZ = NB * CTXL, TA = TX + TZ;
constexpr int NTX = TX / 256, NTZ = TZ / 256, NTA = TA / 256;
constexpr int DIN = 5376, NE = 32;
constexpr int NPH = 18;
constexpr float EPS = 1e-6f;
constexpr float LOG2E = 1.4426950408889634f;

constexpr size_t al256(size_t x) { return (x + 255) & ~(size_t)255; }
constexpr size_t WS_CTL = 0, CTL_BYTES = 1u << 20, CTL_ZERO = 128u << 10;
constexpr size_t WS_MOD = WS_CTL + CTL_BYTES, MOD_BYTES = al256((size_t)2 * 9 * 6144 * 4);
constexpr size_t WS_ROPE = WS_MOD + MOD_BYTES, ROPE_BYTES = (size_t)2 * 8192 * 32 * 4;
constexpr size_t WS_W = WS_ROPE + ROPE_BYTES;
constexpr size_t W_IN = 0, W_IN_B = (size_t)DIN * 1024 * 2;
constexpr size_t W_CO = W_IN + W_IN_B, W_P_B = (size_t)1024 * 512 * 2;
constexpr size_t W_AO = W_CO + W_P_B;
constexpr size_t W_PE = W_AO + W_P_B;
constexpr size_t W_OUT = W_PE + W_P_B, W_OUT_B = (size_t)1024 * 1024 * 2;
constexpr size_t W_GU = W_OUT + W_OUT_B, W_GU_E = (size_t)2048 * 1024 * 2, W_GU_B = 32 * W_GU_E;
constexpr size_t W_DN = W_GU + W_GU_B, W_DN_E = (size_t)1024 * 1024 * 2, W_DN_B = 32 * W_DN_E;
constexpr size_t W_LAYER = W_DN + W_DN_B;
constexpr size_t WS_H = WS_W + 2 * W_LAYER;
constexpr size_t H_BYTES = (size_t)TA * 1024 * 2;
constexpr size_t WS_R1 = WS_H + H_BYTES;
constexpr size_t R1_AGLU = 0, R1_Q = R1_AGLU + (size_t)TA * 512 * 2, R1_K = R1_Q + (size_t)TA * 512 * 2, R1_VT = R1_K + (size_t)TA * 128 * 2,
                 R1_U = R1_VT + (size_t)TA * 128 * 2, R1_G = R1_U + (size_t)TA * 512 * 2, R1_BYTES = R1_G + (size_t)TA * 3072 * 2;
constexpr int PMAX = TA * 4 + 32 * 256;
constexpr size_t ACT_BYTES = (size_t)PMAX * 1024 * 2;
static_assert(ACT_BYTES <= R1_BYTES, "ACT must fit R1");
constexpr size_t WS_R2 = WS_R1 + R1_BYTES;
constexpr size_t R2_AC = 0, R2_AT = (size_t)TA * 512 * 2, R2_PL = 2 * R2_AT, R2_MG = 3 * R2_AT, R2_BYTES = ACT_BYTES;
static_assert(R2_MG + (size_t)TA * 1024 * 2 <= R2_BYTES, "R2");
constexpr size_t WS_X = WS_R2 + R2_BYTES;
constexpr size_t X_BYTES = (size_t)TA * 1024 * 4;
constexpr size_t WS_TI = WS_X + X_BYTES;
constexpr size_t WS_TG = WS_TI + (size_t)TA * 16;
constexpr size_t WS_LIST = WS_TG + (size_t)TA * 16;
constexpr size_t WS_SS = WS_LIST + (size_t)32 * TA * 4;
constexpr size_t WS_END = WS_SS + (size_t)TA * 16 * 4;
constexpr int CW_TMO = 0, CW_BAR = 4096, CW_CNT = 16384;

constexpr int LDS_BYTES = 163840;
constexpr int LDS_MISC = 163840 - 256;
constexpr int LDS_TAB = 131072;

__device__ __forceinline__ unsigned f2bf(float f) { unsigned u = __builtin_bit_cast(unsigned, f); return (u + 0x7fffu + ((u >> 16) & 1u)) >> 16; }
__device__ __forceinline__ unsigned pk2(float lo, float hi) { f32x2 v = {lo, hi}; bf16x2_t b = __builtin_convertvector(v, bf16x2_t); return __builtin_bit_cast(unsigned, b); }
__device__ __forceinline__ float bflo(unsigned u) { return __builtin_bit_cast(float, u << 16); }
__device__ __forceinline__ float bfhi(unsigned u) { return __builtin_bit_cast(float, u & 0xffff0000u); }
__device__ __forceinline__ float wave_sum(float v) {
#pragma unroll
    for (int o = 1; o < 64; o <<= 1) v += __shfl_xor(v, o);
    return v;
}
__device__ __forceinline__ float sigmoidf_(float x) { return __builtin_amdgcn_rcpf(1.0f + __builtin_amdgcn_exp2f(-x * LOG2E)); }
__device__ __forceinline__ u32x4 pack8(const f32x4& a, const f32x4& b) { u32x4 w; w.x = pk2(a[0], a[1]); w.y = pk2(a[2], a[3]); w.z = pk2(b[0], b[1]); w.w = pk2(b[2], b[3]); return w; }
__device__ __forceinline__ void unpack8(const u32x4& w, f32x4& a, f32x4& b) { a = (f32x4){bflo(w.x), bfhi(w.x), bflo(w.y), bfhi(w.y)}; b = (f32x4){bflo(w.z), bfhi(w.z), bflo(w.w), bfhi(w.w)}; }
__device__ __forceinline__ int perm16(int s) { return (s & ~12) | ((s & 4) << 1) | ((s & 8) >> 1); }

#define XB_TMO      128
#define XB_XCNT(j)  (256  + 64 * (j))
#define XB_XSUB(j)  (1280 + 64 * (j))
#define XB_XGEN(j)  (2304 + 64 * (j))
#define XB_TOP      3328
#define XB_TOPGEN   3392
#define XCD_BAR_WORDS 3456
#define XB_SPIN_CAP (1u << 18)
__device__ __forceinline__ unsigned xb_ld(unsigned* p)              { return __hip_atomic_load(p, __ATOMIC_RELAXED, __HIP_MEMORY_SCOPE_AGENT); }
__device__ __forceinline__ unsigned xb_add(unsigned* p, unsigned v) { return __hip_atomic_fetch_add(p, v, __ATOMIC_RELAXED, __HIP_MEMORY_SCOPE_AGENT); }
__device__ __forceinline__ unsigned xb_xcc_id() { return (unsigned)__builtin_amdgcn_s_getreg((3 << 11) | 20) & 0xFu; }
#define XB_SPIN(cond, bar) do { unsigned _sp = 0; while (cond) { __builtin_amdgcn_s_sleep(1); \
    if ((++_sp & 255u) == 0u) { if (xb_ld(&(bar)[XB_TMO])) break; if (_sp > XB_SPIN_CAP) { atomicAdd(&(bar)[XB_TMO], 1u); break; } } } } while (0)
struct XcdBarrier { unsigned* bar; unsigned x; volatile LAS unsigned* st; };
__device__ __forceinline__ XcdBarrier xcd_barrier_post(unsigned* bar, volatile LAS unsigned* st) {
    XcdBarrier b; b.bar = bar; b.x = xb_xcc_id(); b.st = st;
    if (threadIdx.x == 0) (void)xb_add(&bar[XB_XCNT(b.x)], 1u);
    return b;
}
__device__ __forceinline__ void xcd_barrier_complete(unsigned* bar, unsigned x, unsigned& nloc, unsigned& nx) {
    const unsigned G = gridDim.x * gridDim.y * gridDim.z;
    unsigned sum, cnt, mine, sp = 0u;
    for (;;) {
        sum = 0u; cnt = 0u; mine = 0u;
#pragma unroll
        for (unsigned j = 0; j < 16; ++j) { const unsigned c = xb_ld(&bar[XB_XCNT(j)]); sum += c; cnt += (c > 0u) ? 1u : 0u; mine = (j == x) ? c : mine; }
        if (sum == G) break;
        __builtin_amdgcn_s_sleep(1);
        if ((++sp & 255u) == 0u) { if (xb_ld(&bar[XB_TMO])) break; if (sp > XB_SPIN_CAP) { atomicAdd(&bar[XB_TMO], 1u); break; } }
    }
    nloc = mine > 0u ? mine : 1u; nx = cnt > 0u ? cnt : 1u;
}
__device__ __forceinline__ void xcd_barrier(const XcdBarrier& b) {
    asm volatile("s_waitcnt vmcnt(0)" ::: "memory");
    __syncthreads();
    if (threadIdx.x == 0) {
        unsigned* bar = b.bar;
        __builtin_amdgcn_s_waitcnt(0);
        unsigned nloc = b.st[0], nx = b.st[1];
        if (nloc == 0u) { xcd_barrier_complete(bar, b.x, nloc, nx); b.st[0] = nloc; b.st[1] = nx; }
        const unsigned old = xb_add(&bar[XB_XSUB(b.x)], 1u);
        const unsigned gen = old / nloc;
        if (old + 1u == (gen + 1u) * nloc) {
            __builtin_amdgcn_fence(__ATOMIC_RELEASE, "agent");
            asm volatile("s_waitcnt vmcnt(0)" ::: "memory");
            const unsigned og = xb_add(&bar[XB_TOP], 1u);
            const unsigned tg = og / nx;
            if (og + 1u == (tg + 1u) * nx) xb_add(&bar[XB_TOPGEN], 1u);
            else XB_SPIN(xb_ld(&bar[XB_TOPGEN]) == tg, bar);
            __builtin_amdgcn_fence(__ATOMIC_ACQUIRE, "agent");
            xb_add(&bar[XB_XGEN(b.x)], 1u);
            asm volatile("s_waitcnt vmcnt(0)" ::: "memory");
        } else {
            XB_SPIN(xb_ld(&bar[XB_XGEN(b.x)]) == gen, bar);
            __builtin_amdgcn_fence(__ATOMIC_ACQUIRE, "agent");
            asm volatile("s_waitcnt vmcnt(0)" ::: "memory");
        }
    }
    __syncthreads();
}

namespace g8 {
constexpr int BM = 256, BK = 64, HALF = 128, HTB = HALF * BK * 2, STAGE_BYTES = 8 * HTB, NXCD = 8, WGM = 8;
__device__ __forceinline__ int lds_byte(int r, int c) { const int st = (r >> 4) * 2 + (c >> 5), rr = r & 15, cc = c & 31, ob = rr * 64 + cc * 2; return st * 1024 + (ob ^ (((ob >> 9) & 1) << 5)); }
__device__ __forceinline__ void stage_rc(int b, int& R, int& C) { const int st = b / 1024, sb = b % 1024, swz = sb ^ (((sb >> 9) & 1) << 5); R = (st >> 1) * 16 + swz / 64; C = (st & 1) * 32 + (swz % 64) / 2; }
__device__ __forceinline__ int perm32(int rho) { const int n = rho >> 4, i = rho & 15; return 8 * (i >> 2) + 4 * n + (i & 3); }

struct GUnit { const char* A; const char* B; int pm, pn, aux; };

__device__ __forceinline__ bool tile_map(int L, int nM, int nN, int& pm, int& pn) {
    const int nwg = nM * nN; if (L >= nwg) return false;
    int wgid = L; { const int q = nwg / NXCD, r = nwg % NXCD, xcd = wgid % NXCD, off = wgid / NXCD; wgid = (xcd < r ? xcd * (q + 1) : r * (q + 1) + (xcd - r) * q) + off; }
    const int nig = WGM * nN, gid = wgid / nig, fm = gid * WGM, gsz = (nM - fm) < WGM ? (nM - fm) : WGM;
    pm = fm + ((wgid % nig) % gsz); pn = (wgid % nig) / gsz; return true;
}

template <int K, class Epi, class Sched>
__device__ __forceinline__ void gemm_phase(LAS unsigned char* lds, const Sched& S, const Epi& E, const int tid) {
    const int wid = __builtin_amdgcn_readfirstlane(tid >> 6), lane = tid & 63, wr = wid >> 2, wc = wid & 3, fr = lane & 15, fq = lane >> 4;
    constexpr int nt = K / BK;
    unsigned voffB[2]; int sR[2], sC[2];
#pragma unroll
    for (int i = 0; i < 2; ++i) { int R, C; stage_rc(tid * 16 + i * 8192, R, C); const int Rb = Epi::PERM ? ((R & ~31) + perm32(R & 31)) : R;
        voffB[i] = (unsigned)(Rb * K + C) * 2u; sR[i] = R; sC[i] = C; }
    constexpr size_t kstep = (size_t)(BK * 2);
    constexpr size_t hstep = (size_t)HALF * K * 2;
    const unsigned ldsw = (unsigned)wid * 1024u;
    const int aoff = lds_byte(wr * 64 + fr, fq * 8), boff = lds_byte(wc * 32 + fr, fq * 8);
#define PG8_SA(b, h) (((b) * 2 + (h)) * HTB)
#define PG8_SB(b, h) ((4 + (b) * 2 + (h)) * HTB)
#define PG8_STAGE(bufoff, gbase, voff) do { _Pragma("unroll") for (int _i = 0; _i < 2; ++_i) \
        __builtin_amdgcn_global_load_lds((const unsigned*)((const char*)(gbase) + (voff)[_i]), (LAS unsigned*)(lds + (bufoff) + ldsw + _i * 8192), 16, 0, 0); } while (0)
#define PG8_LDA(dst, b, h) do { _Pragma("unroll") for (int m = 0; m < 4; ++m) _Pragma("unroll") for (int k = 0; k < 2; ++k) dst[m][k] = *(const LAS bf16x8*)(lds + PG8_SA(b, h) + aoff + m * 2048 + k * 1024); } while (0)
#define PG8_LDB(dst, b, h) do { _Pragma("unroll") for (int n = 0; n < 2; ++n) _Pragma("unroll") for (int k = 0; k < 2; ++k) dst[n][k] = *(const LAS bf16x8*)(lds + PG8_SB(b, h) + boff + n * 2048 + k * 1024); } while (0)
#define PG8_MMA(ai, bj, At, Bt) do { __builtin_amdgcn_s_setprio(1); _Pragma("unroll") for (int m = 0; m < 4; ++m) _Pragma("unroll") for (int n = 0; n < 2; ++n) _Pragma("unroll") for (int k = 0; k < 2; ++k) \
        acc[ai][bj][m][n] = __builtin_amdgcn_mfma_f32_16x16x32_bf16(Bt[n][k], At[m][k], acc[ai][bj][m][n], 0, 0, 0); __builtin_amdgcn_s_setprio(0); } while (0)
#define PG8_WAIT_V(n) asm volatile("s_waitcnt vmcnt(" #n ")" ::: "memory")
#define PG8_WAIT_L(n) asm volatile("s_waitcnt lgkmcnt(" #n ")" ::: "memory")
#define PG8_BAR __builtin_amdgcn_s_barrier()
#define PG8_SCHED __builtin_amdgcn_sched_barrier(0)
    GUnit cur, nxt; int ui = 0;
    if (!S.next(0, cur)) return;
#if defined(GEMM_STAGGER) && GEMM_STAGGER > 0
    {
        const unsigned grp = ((unsigned)blockIdx.x >> 3) & 3u; const unsigned long long t0 = __builtin_amdgcn_s_memrealtime();
        while (__builtin_amdgcn_s_memrealtime() - t0 < (unsigned long long)(grp * GEMM_STAGGER)) __builtin_amdgcn_s_sleep(8);
    }
#endif
    f32x4 acc[2][2][4][2];
    E.init(acc, cur, wr, wc, fr, fq);
    bf16x8 At[4][2], B0[2][2], B1[2][2];
    unsigned ca0[2], ca1[2], na0[2], na1[2];
    S.aoff(cur, sR, sC, ca0, ca1);
    const char* cA = cur.A; const char* cB = cur.B;
    PG8_STAGE(PG8_SB(0, 0), cB, voffB); PG8_STAGE(PG8_SB(0, 1), cB + hstep, voffB); PG8_STAGE(PG8_SA(0, 0), cA, ca0); PG8_STAGE(PG8_SA(0, 1), cA, ca1);
    if (wr == 1) PG8_BAR;
    PG8_WAIT_V(2); PG8_BAR;
    PG8_STAGE(PG8_SB(1, 0), cB + kstep, voffB); PG8_STAGE(PG8_SA(1, 0), cA + kstep, ca0); PG8_STAGE(PG8_SB(1, 1), cB + hstep + kstep, voffB);
    PG8_WAIT_V(6); PG8_BAR;
    for (;;) {
        const bool has_next = S.next(ui + 1, nxt);
        if (has_next) S.aoff(nxt, sR, sC, na0, na1); else { na0[0] = ca0[0]; na0[1] = ca0[1]; na1[0] = ca1[0]; na1[1] = ca1[1]; }
        const char* nA = has_next ? nxt.A : cA; const char* nB = has_next ? nxt.B : cB;
        for (int t = 0; t < nt; t += 2) {
            const bool last = (t == nt - 2);
            const char* a1 = cA + (size_t)(t + 1) * kstep;
            const char* a2 = last ? nA : cA + (size_t)(t + 2) * kstep; const char* b2 = last ? nB : cB + (size_t)(t + 2) * kstep;
            const char* a3 = a2 + kstep; const char* b3 = b2 + kstep;
            unsigned xa0[2], xa1[2];
            xa0[0] = last ? na0[0] : ca0[0]; xa0[1] = last ? na0[1] : ca0[1]; xa1[0] = last ? na1[0] : ca1[0]; xa1[1] = last ? na1[1] : ca1[1];
            PG8_LDB(B0, 0, 0); PG8_LDB(B1, 0, 1); PG8_SCHED; PG8_LDA(At, 0, 0); PG8_STAGE(PG8_SA(1, 1), a1, ca1);
            PG8_WAIT_V(8); PG8_WAIT_L(0); PG8_BAR; PG8_MMA(0, 0, At, B0); PG8_MMA(0, 1, At, B1); PG8_BAR; PG8_SCHED;
            PG8_LDA(At, 0, 1); PG8_STAGE(PG8_SB(0, 0), b2, voffB); PG8_STAGE(PG8_SB(0, 1), b2 + hstep, voffB); PG8_STAGE(PG8_SA(0, 0), a2, xa0);
            PG8_WAIT_V(8); PG8_WAIT_L(0); PG8_BAR; PG8_MMA(1, 0, At, B0); PG8_MMA(1, 1, At, B1); PG8_BAR; PG8_SCHED;
            PG8_LDB(B0, 1, 0); PG8_LDB(B1, 1, 1); PG8_SCHED; PG8_LDA(At, 1, 0); PG8_STAGE(PG8_SA(0, 1), a2, xa1);
            PG8_WAIT_V(8); PG8_WAIT_L(0); PG8_BAR; PG8_MMA(0, 0, At, B0); PG8_MMA(0, 1, At, B1); PG8_BAR; PG8_SCHED;
            PG8_LDA(At, 1, 1); PG8_STAGE(PG8_SB(1, 0), b3, voffB); PG8_STAGE(PG8_SB(1, 1), b3 + hstep, voffB); PG8_STAGE(PG8_SA(1, 0), a3, xa0);
            PG8_WAIT_V(8); PG8_WAIT_L(0); PG8_BAR; PG8_MMA(1, 0, At, B0); PG8_MMA(1, 1, At, B1); PG8_BAR; PG8_SCHED;
        }
#if PG8_ALIGN_EPI
        if (wr == 0) PG8_BAR;
#endif
        const bool keepacc = E(acc, cur, wr, wc, fr, fq);
        if (!has_next) break;
        if (!keepacc) E.init(acc, nxt, wr, wc, fr, fq);
        cur = nxt; cA = nA; cB = nB; ca0[0] = na0[0]; ca0[1] = na0[1]; ca1[0] = na1[0]; ca1[1] = na1[1]; ++ui;
#if PG8_ALIGN_EPI
        if (wr == 1) PG8_BAR;
#endif
    }
    PG8_WAIT_V(0);
#if !PG8_ALIGN_EPI
    if (wr == 0) PG8_BAR;
#endif
    PG8_BAR;
#undef PG8_SA
#undef PG8_SB
#undef PG8_STAGE
#undef PG8_LDA
#undef PG8_LDB
#undef PG8_MMA
#undef PG8_WAIT_V
#undef PG8_WAIT_L
#undef PG8_BAR
#undef PG8_SCHED
}

template <int K> struct SchedDense {
    const char* A; const char* B; int nM, nN, G, c, extra, xpn;
    __device__ __forceinline__ bool next(int i, GUnit& u) const {
        const int L = i * G + c; int pm, pn;
        if (!tile_map(L, nM, nN, pm, pn)) { const int j = L - nM * nN; if (j >= extra) return false; pm = nM + j; pn = xpn; }
        u.pm = pm; u.pn = pn; u.aux = 0; u.A = A + (size_t)pm * 256 * K * 2; u.B = B + (size_t)pn * 256 * K * 2; return true;
    }
    __device__ __forceinline__ void aoff(const GUnit&, const int (&sR)[2], const int (&sC)[2], unsigned (&o0)[2], unsigned (&o1)[2]) const {
#pragma unroll
        for (int i = 0; i < 2; ++i) { o0[i] = (unsigned)(sR[i] * K + sC[i]) * 2u; o1[i] = (unsigned)((128 + sR[i]) * K + sC[i]) * 2u; }
    }
};
struct SchedSame {
    const char* A; const char* B; int n, c;
    __device__ __forceinline__ bool next(int i, GUnit& u) const {
        if (i >= n) return false; const int pm = (c >> 3) & 7, pn = (c >> 6) & 3;
        u.pm = pm; u.pn = pn; u.aux = 0; u.A = A + (size_t)pm * 256 * 2048; u.B = B + (size_t)pn * 256 * 2048; return true;
    }
    __device__ __forceinline__ void aoff(const GUnit&, const int (&sR)[2], const int (&sC)[2], unsigned (&o0)[2], unsigned (&o1)[2]) const {
#pragma unroll
        for (int i = 0; i < 2; ++i) { o0[i] = (unsigned)(sR[i] * 1024 + sC[i]) * 2u; o1[i] = (unsigned)((128 + sR[i]) * 1024 + sC[i]) * 2u; }
    }
};
struct SchedBranch {
    const char* A0; const char* B0; size_t sa, sb; int nM, G, c;
    __device__ __forceinline__ bool next(int i, GUnit& u) const {
        const int ti = i / 3, br = i - 3 * ti; const int L = ti * G + c; int pm, pn;
        if (!tile_map(L, nM, 4, pm, pn)) return false;
        u.pm = pm; u.pn = pn; u.aux = br;
        u.A = A0 + (size_t)br * sa + (size_t)pm * 256 * 1024; u.B = B0 + (size_t)br * sb + (size_t)pn * 256 * 1024; return true;
    }
    __device__ __forceinline__ void aoff(const GUnit&, const int (&sR)[2], const int (&sC)[2], unsigned (&o0)[2], unsigned (&o1)[2]) const {
#pragma unroll
        for (int i = 0; i < 2; ++i) { o0[i] = (unsigned)(sR[i] * 512 + sC[i]) * 2u; o1[i] = (unsigned)((128 + sR[i]) * 512 + sC[i]) * 2u; }
    }
};
template <bool GATHER> struct SchedMoE {
    const char* A; const char* W; size_t wexp; const unsigned* list; const LAS unsigned* tab; int nN, G, c;
    __device__ __forceinline__ bool next(int i, GUnit& u) const {
        const int L = i * G + c; int pm, pn; const int nM = (int)tab[64];
        if (!tile_map(L, nM, nN, pm, pn)) return false;
        const int e = __builtin_amdgcn_readfirstlane((int)tab[96 + pm]);
        u.pm = pm; u.pn = pn; u.aux = e; u.B = W + (size_t)e * wexp + (size_t)pn * 256 * 2048;
        u.A = GATHER ? A : A + (size_t)pm * 256 * 2048; return true;
    }
    __device__ __forceinline__ void aoff(const GUnit& u, const int (&sR)[2], const int (&sC)[2], unsigned (&o0)[2], unsigned (&o1)[2]) const {
        if (GATHER) {
            const int e = u.aux; const int n_e = (int)tab[e]; const int idx0 = (u.pm - (int)tab[32 + e]) * 256;
            const unsigned* le = list + (size_t)e * TA;
#pragma unroll
            for (int i = 0; i < 2; ++i) {
                const int i0 = idx0 + sR[i], i1 = i0 + 128;
                const unsigned t0 = i0 < n_e ? le[i0] : 0u, t1 = i1 < n_e ? le[i1] : 0u;
                o0[i] = (t0 * 1024u + (unsigned)sC[i]) * 2u; o1[i] = (t1 * 1024u + (unsigned)sC[i]) * 2u; }
        } else {
#pragma unroll
            for (int i = 0; i < 2; ++i) { o0[i] = (unsigned)(sR[i] * 1024 + sC[i]) * 2u; o1[i] = (unsigned)((128 + sR[i]) * 1024 + sC[i]) * 2u; }
        }
    }
};

struct EpiInProj {
    static constexpr bool PERM = true; static constexpr int MINOPS = 8;
    bf16_t* aglu; bf16_t* q; bf16_t* k; bf16_t* vt; bf16_t* u; bf16_t* g; const float* bgate; const float* rope;
    __device__ __forceinline__ void init(f32x4 (&acc)[2][2][4][2], const GUnit& un, int wr, int wc, int fr, int fq) const {
        f32x4 bv[2][2];
        if (un.pn >= 9) { const int gc0 = (un.pn - 9) * 256 + wc * 64 + fq * 8;
#pragma unroll
            for (int bj = 0; bj < 2; ++bj)
#pragma unroll
                for (int n = 0; n < 2; ++n) bv[bj][n] = *(const f32x4*)(bgate + gc0 + bj * 32 + 4 * n);
        } else { bv[0][0] = (f32x4){0.f, 0.f, 0.f, 0.f}; bv[0][1] = bv[0][0]; bv[1][0] = bv[0][0]; bv[1][1] = bv[0][0]; }
#pragma unroll
        for (int a = 0; a < 2; ++a)
#pragma unroll
            for (int b = 0; b < 2; ++b)
#pragma unroll
                for (int m = 0; m < 4; ++m)
#pragma unroll
                    for (int n = 0; n < 2; ++n) acc[a][b][m][n] = bv[b][n];
    }
    __device__ __forceinline__ bool operator()(f32x4 (&acc)[2][2][4][2], const GUnit& un, int wr, int wc, int fr, int fq) const {
        const int pn = un.pn; const int row0 = un.pm * 256 + wr * 64 + fr; const bool isx = un.pm < NTX;
        if (pn < 4) {
#pragma unroll
            for (int ai = 0; ai < 2; ++ai)
#pragma unroll
                for (int m = 0; m < 4; ++m) { const int row = row0 + ai * 128 + m * 16; f32x4 o0, o1;
#pragma unroll
                    for (int j = 0; j < 4; ++j) { o0[j] = acc[ai][0][m][0][j] * sigmoidf_(acc[ai][1][m][0][j]); o1[j] = acc[ai][0][m][1][j] * sigmoidf_(acc[ai][1][m][1][j]); }
                    *(u32x4*)(aglu + (size_t)row * 512 + pn * 128 + wc * 32 + fq * 8) = pack8(o0, o1); }
        } else if (pn < 6 || (pn == 6 && wc < 2)) {
            bf16_t* dst; int ld, c0;
            if (pn < 6) { dst = q; ld = 512; c0 = ((pn - 4) * 4 + wc) * 64 + fq * 8; } else { dst = k; ld = 128; c0 = wc * 64 + fq * 8; }
#pragma unroll
            for (int ai = 0; ai < 2; ++ai)
#pragma unroll
                for (int m = 0; m < 4; ++m) { const int row = row0 + ai * 128 + m * 16;
                    f32x4 x1a = acc[ai][0][m][0], x1b = acc[ai][0][m][1], x2a = acc[ai][1][m][0], x2b = acc[ai][1][m][1];
                    { const int s = isx ? (row & (SEQ - 1)) : 0;
                        const float* cp = rope + (size_t)s * 32 + fq * 8; const float* sp = cp + 8192 * 32;
                        const f32x4 ca = *(const f32x4*)cp, cb = *(const f32x4*)(cp + 4), sa = *(const f32x4*)sp, sb = *(const f32x4*)(sp + 4);
                        const f32x4 o1a = x1a * ca - x2a * sa, o1b = x1b * cb - x2b * sb, o2a = x2a * ca + x1a * sa, o2b = x2b * cb + x1b * sb;
                        x1a = o1a; x1b = o1b; x2a = o2a; x2b = o2b; }
                    *(u32x4*)(dst + (size_t)row * ld + c0) = pack8(x1a, x1b);
                    *(u32x4*)(dst + (size_t)row * ld + c0 + 32) = pack8(x2a, x2b); }
        } else if (pn == 6) {
            const int d0 = (wc - 2) * 32 + fq * 8;
#pragma unroll
            for (int ai = 0; ai < 2; ++ai)
#pragma unroll
                for (int m = 0; m < 4; ++m) { const int row = row0 + ai * 128 + m * 16;
#pragma unroll
                    for (int bj = 0; bj < 2; ++bj) {
                        bf16_t* base; size_t st;
                        if (isx) { const int b = row >> 13, s = row & (SEQ - 1); base = vt + ((size_t)((b * 2 + bj) * 64 + d0)) * SEQ + perm16(s); st = SEQ; }
                        else { const int zz = row - TX, b = zz >> 8, cp = zz & 255; base = vt + (size_t)TX * 128 + ((size_t)((b * 2 + bj) * 64 + d0)) * CTXL + perm16(cp); st = CTXL; }
#pragma unroll
                        for (int j = 0; j < 4; ++j) { base[(size_t)j * st] = (bf16_t)f2bf(acc[ai][bj][m][0][j]); base[(size_t)(4 + j) * st] = (bf16_t)f2bf(acc[ai][bj][m][1][j]); } } }
        } else if (pn < 9) {
#pragma unroll
            for (int ai = 0; ai < 2; ++ai)
#pragma unroll
                for (int m = 0; m < 4; ++m) { const int row = row0 + ai * 128 + m * 16;
#pragma unroll
                    for (int bj = 0; bj < 2; ++bj) *(u32x4*)(u + (size_t)row * 512 + (pn - 7) * 256 + wc * 64 + bj * 32 + fq * 8) = pack8(acc[ai][bj][m][0], acc[ai][bj][m][1]); }
        } else {
            const int gc0 = (pn - 9) * 256 + wc * 64 + fq * 8;
#pragma unroll
            for (int ai = 0; ai < 2; ++ai)
#pragma unroll
                for (int m = 0; m < 4; ++m) { const int row = row0 + ai * 128 + m * 16;
#pragma unroll
                    for (int bj = 0; bj < 2; ++bj) { f32x4 o0, o1;
#pragma unroll
                        for (int j = 0; j < 4; ++j) { o0[j] = sigmoidf_(acc[ai][bj][m][0][j]); o1[j] = sigmoidf_(acc[ai][bj][m][1][j]); }
                        *(u32x4*)(g + (size_t)row * 3072 + gc0 + bj * 32) = pack8(o0, o1); } }
        }
        return false;
    }
};
struct EpiBranch {
    static constexpr bool PERM = true; static constexpr int MINOPS = 8;
    const bf16_t* g; bf16_t* mg;
    __device__ __forceinline__ void init(f32x4 (&acc)[2][2][4][2], const GUnit&, int, int, int, int) const {
#pragma unroll
        for (int a = 0; a < 2; ++a)
#pragma unroll
            for (int b = 0; b < 2; ++b)
#pragma unroll
                for (int m = 0; m < 4; ++m)
#pragma unroll
                    for (int n = 0; n < 2; ++n) acc[a][b][m][n] = (f32x4){0.f, 0.f, 0.f, 0.f};
    }
    __device__ __forceinline__ bool operator()(f32x4 (&acc)[2][2][4][2], const GUnit& un, int wr, int wc, int fr, int fq) const {
        const int br = un.aux; const int row0 = un.pm * 256 + wr * 64 + fr; const int c0 = un.pn * 256 + wc * 64 + fq * 8;
        if (br < 2) {
#pragma unroll
            for (int ai = 0; ai < 2; ++ai) {
                u32x4 ga[4][2], gb[4][2];
#pragma unroll
                for (int m = 0; m < 4; ++m)
#pragma unroll
                    for (int bj = 0; bj < 2; ++bj) { const bf16_t* gp = g + (size_t)(row0 + ai * 128 + m * 16) * 3072 + br * 1024 + c0 + bj * 32;
                        ga[m][bj] = *(const u32x4*)gp; gb[m][bj] = *(const u32x4*)(gp + 1024); }
#pragma unroll
                for (int m = 0; m < 4; ++m)
#pragma unroll
                    for (int bj = 0; bj < 2; ++bj) { f32x4 a0, a1, b0, b1; unpack8(ga[m][bj], a0, a1); unpack8(gb[m][bj], b0, b1);
#pragma unroll
                        for (int j = 0; j < 4; ++j) { acc[ai][bj][m][0][j] *= a0[j] * __builtin_amdgcn_rcpf(b0[j]); acc[ai][bj][m][1][j] *= a1[j] * __builtin_amdgcn_rcpf(b1[j]); } }
                asm volatile("" ::: "memory");
            }
            return true;
        }
#pragma unroll
        for (int ai = 0; ai < 2; ++ai) {
            u32x4 gw[4][2];
#pragma unroll
            for (int m = 0; m < 4; ++m)
#pragma unroll
                for (int bj = 0; bj < 2; ++bj) gw[m][bj] = *(const u32x4*)(g + (size_t)(row0 + ai * 128 + m * 16) * 3072 + 2048 + c0 + bj * 32);
#pragma unroll
            for (int m = 0; m < 4; ++m)
#pragma unroll
                for (int bj = 0; bj < 2; ++bj) { f32x4 a0, a1; unpack8(gw[m][bj], a0, a1);
                    *(u32x4*)(mg + (size_t)(row0 + ai * 128 + m * 16) * 1024 + c0 + bj * 32) = pack8(a0 * acc[ai][bj][m][0], a1 * acc[ai][bj][m][1]); }
            asm volatile("" ::: "memory");
        }
        return false;
    }
};
#if XBF16
struct EpiWout {
    static constexpr bool PERM = true; static constexpr int MINOPS = 8;
    const float* resx; const float* resz; bf16_t* X; const float* modl; float* SS; int first;
    __device__ __forceinline__ void init(f32x4 (&acc)[2][2][4][2], const GUnit&, int, int, int, int) const {
#pragma unroll
        for (int a = 0; a < 2; ++a)
#pragma unroll
            for (int b = 0; b < 2; ++b)
#pragma unroll
                for (int m = 0; m < 4; ++m)
#pragma unroll
                    for (int n = 0; n < 2; ++n) acc[a][b][m][n] = (f32x4){0.f, 0.f, 0.f, 0.f};
    }
    __device__ __forceinline__ bool operator()(f32x4 (&acc)[2][2][4][2], const GUnit& un, int wr, int wc, int fr, int fq) const {
        const int row0 = un.pm * 256 + wr * 64 + fr; const int c0 = un.pn * 256 + wc * 64 + fq * 8; const bool isx = un.pm < NTX;
        const int ms = isx ? (un.pm >> 5) : 8;
        const float* gp = modl + (size_t)ms * 6144 + 2 * 1024 + c0;
        f32x4 gv[2][2];
#pragma unroll
        for (int bj = 0; bj < 2; ++bj)
#pragma unroll
            for (int n = 0; n < 2; ++n) gv[bj][n] = *(const f32x4*)(gp + bj * 32 + n * 4);
#pragma unroll
        for (int ai = 0; ai < 2; ++ai)
#pragma unroll
        for (int mh = 0; mh < 2; ++mh) {
            f32x4 rv[2][2][2];
            if (first) {
#pragma unroll
                for (int m2 = 0; m2 < 2; ++m2) { const int row = row0 + ai * 128 + (mh * 2 + m2) * 16; const float* rp = isx ? resx + (size_t)row * 1024 : resz + (size_t)(row - TX) * 1024;
#pragma unroll
                    for (int bj = 0; bj < 2; ++bj)
#pragma unroll
                        for (int n = 0; n < 2; ++n) rv[m2][bj][n] = *(const f32x4*)(rp + c0 + bj * 32 + n * 4); }
            } else {
#pragma unroll
                for (int m2 = 0; m2 < 2; ++m2) { const int row = row0 + ai * 128 + (mh * 2 + m2) * 16;
#pragma unroll
                    for (int bj = 0; bj < 2; ++bj) { const u32x4 w = *(const u32x4*)(X + (size_t)row * 1024 + c0 + bj * 32); unpack8(w, rv[m2][bj][0], rv[m2][bj][1]); } }
            }
#pragma unroll
            for (int m2 = 0; m2 < 2; ++m2) { const int m = mh * 2 + m2; const int row = row0 + ai * 128 + m * 16; float sq = 0.f;
#pragma unroll
                for (int bj = 0; bj < 2; ++bj) { const u32x4 w = pack8(rv[m2][bj][0] + gv[bj][0] * acc[ai][bj][m][0], rv[m2][bj][1] + gv[bj][1] * acc[ai][bj][m][1]);
                    f32x4 va, vb; unpack8(w, va, vb);
                    sq += (va[0] * va[0] + va[1] * va[1]) + (va[2] * va[2] + va[3] * va[3]) + (vb[0] * vb[0] + vb[1] * vb[1]) + (vb[2] * vb[2] + vb[3] * vb[3]);
                    *(u32x4*)(X + (size_t)row * 1024 + c0 + bj * 32) = w; }
                sq += __shfl_xor(sq, 16); sq += __shfl_xor(sq, 32);
                if (fq == 0) SS[(size_t)row * 16 + un.pn * 4 + wc] = sq; }
            asm volatile("" ::: "memory");
        }
        return false;
    }
};
#else
struct EpiWout {
    static constexpr bool PERM = false; static constexpr int MINOPS = 8;
    const float* resx; const float* resz; float* X; const float* modl; float* SS; int first;
    __device__ __forceinline__ void init(f32x4 (&acc)[2][2][4][2], const GUnit&, int, int, int, int) const {
#pragma unroll
        for (int a = 0; a < 2; ++a)
#pragma unroll
            for (int b = 0; b < 2; ++b)
#pragma unroll
                for (int m = 0; m < 4; ++m)
#pragma unroll
                    for (int n = 0; n < 2; ++n) acc[a][b][m][n] = (f32x4){0.f, 0.f, 0.f, 0.f};
    }
    __device__ __forceinline__ bool operator()(f32x4 (&acc)[2][2][4][2], const GUnit& un, int wr, int wc, int fr, int fq) const {
        const int row0 = un.pm * 256 + wr * 64 + fr; const int c0 = un.pn * 256 + wc * 32 + fq * 4; const bool isx = un.pm < NTX;
        const int ms = isx ? (un.pm >> 5) : 8;
        const float* gp = modl + (size_t)ms * 6144 + 2 * 1024 + c0;
        f32x4 gv[2][2];
#pragma unroll
        for (int bj = 0; bj < 2; ++bj)
#pragma unroll
            for (int n = 0; n < 2; ++n) gv[bj][n] = *(const f32x4*)(gp + bj * 128 + n * 16);
#pragma unroll
        for (int ai = 0; ai < 2; ++ai) {
            f32x4 rv[4][2][2];
#pragma unroll
            for (int m = 0; m < 4; ++m) { const int row = row0 + ai * 128 + m * 16;
                const float* rp = first ? (isx ? resx + (size_t)row * 1024 : resz + (size_t)(row - TX) * 1024) : X + (size_t)row * 1024;
#pragma unroll
                for (int bj = 0; bj < 2; ++bj)
#pragma unroll
                    for (int n = 0; n < 2; ++n) rv[m][bj][n] = *(const f32x4*)(rp + c0 + bj * 128 + n * 16); }
#pragma unroll
            for (int m = 0; m < 4; ++m) { const int row = row0 + ai * 128 + m * 16; float sq = 0.f;
#pragma unroll
                for (int bj = 0; bj < 2; ++bj)
#pragma unroll
                    for (int n = 0; n < 2; ++n) { const f32x4 v = rv[m][bj][n] + gv[bj][n] * acc[ai][bj][m][n]; sq += (v[0] * v[0] + v[1] * v[1]) + (v[2] * v[2] + v[3] * v[3]);
                        *(f32x4*)(X + (size_t)row * 1024 + c0 + bj * 128 + n * 16) = v; }
                sq += __shfl_xor(sq, 16); sq += __shfl_xor(sq, 32);
                if (fq == 0) SS[(size_t)row * 16 + un.pn * 4 + wc] = sq; }
            asm volatile("" ::: "memory");
        }
        return false;
    }
};
#endif
struct EpiGU {
    static constexpr bool PERM = true; static constexpr int MINOPS = 8;
    bf16_t* act; const float* bgu;
    __device__ __forceinline__ void init(f32x4 (&acc)[2][2][4][2], const GUnit& un, int wr, int wc, int fr, int fq) const {
        f32x4 bv[2][2];
        { const float* bp = bgu + (size_t)un.aux * 2048 + un.pn * 128 + wc * 32 + fq * 8;
          bv[0][0] = *(const f32x4*)bp; bv[0][1] = *(const f32x4*)(bp + 4); bv[1][0] = *(const f32x4*)(bp + 1024); bv[1][1] = *(const f32x4*)(bp + 1028); }
#pragma unroll
        for (int a = 0; a < 2; ++a)
#pragma unroll
            for (int b = 0; b < 2; ++b)
#pragma unroll
                for (int m = 0; m < 4; ++m)
#pragma unroll
                    for (int n = 0; n < 2; ++n) acc[a][b][m][n] = bv[b][n];
    }
    __device__ __forceinline__ bool operator()(f32x4 (&acc)[2][2][4][2], const GUnit& un, int wr, int wc, int fr, int fq) const {
        const int row0 = un.pm * 256 + wr * 64 + fr; const int c0 = un.pn * 128 + wc * 32 + fq * 8;
#pragma unroll
        for (int ai = 0; ai < 2; ++ai)
#pragma unroll
            for (int m = 0; m < 4; ++m) { const int row = row0 + ai * 128 + m * 16; f32x4 o0, o1;
#pragma unroll
                for (int j = 0; j < 4; ++j) {
                    const float g0 = fminf(acc[ai][0][m][0][j], 7.0f), u0 = __builtin_amdgcn_fmed3f(acc[ai][1][m][0][j], -7.0f, 7.0f);
                    const float g1 = fminf(acc[ai][0][m][1][j], 7.0f), u1 = __builtin_amdgcn_fmed3f(acc[ai][1][m][1][j], -7.0f, 7.0f);
                    const float t0 = g0 * __builtin_amdgcn_rcpf(1.0f + __builtin_amdgcn_exp2f(g0 * (-1.702f * LOG2E)));
                    const float t1 = g1 * __builtin_amdgcn_rcpf(1.0f + __builtin_amdgcn_exp2f(g1 * (-1.702f * LOG2E)));
                    o0[j] = u0 * t0 + t0; o1[j] = u1 * t1 + t1; }
                *(u32x4*)(act + (size_t)row * 1024 + c0) = pack8(o0, o1); }
        return false;
    }
};
struct EpiDown {
    static constexpr bool PERM = true; static constexpr int MINOPS = 8;
    bf16_t* y; const float* bdn;
    __device__ __forceinline__ void init(f32x4 (&acc)[2][2][4][2], const GUnit& un, int wr, int wc, int fr, int fq) const {
        f32x4 bv[2][2];
        { const float* bp = bdn + (size_t)un.aux * 1024 + un.pn * 256 + wc * 64 + fq * 8;
#pragma unroll
          for (int bj = 0; bj < 2; ++bj)
#pragma unroll
              for (int n = 0; n < 2; ++n) bv[bj][n] = *(const f32x4*)(bp + bj * 32 + 4 * n); }
#pragma unroll
        for (int a = 0; a < 2; ++a)
#pragma unroll
            for (int b = 0; b < 2; ++b)
#pragma unroll
                for (int m = 0; m < 4; ++m)
#pragma unroll
                    for (int n = 0; n < 2; ++n) acc[a][b][m][n] = bv[b][n];
    }
    __device__ __forceinline__ bool operator()(f32x4 (&acc)[2][2][4][2], const GUnit& un, int wr, int wc, int fr, int fq) const {
        const int row0 = un.pm * 256 + wr * 64 + fr; const int c0 = un.pn * 256 + wc * 64 + fq * 8;
#pragma unroll
        for (int ai = 0; ai < 2; ++ai)
#pragma unroll
            for (int m = 0; m < 4; ++m) { const int row = row0 + ai * 128 + m * 16;
#pragma unroll
                for (int bj = 0; bj < 2; ++bj) *(u32x4*)(y + (size_t)row * 1024 + c0 + bj * 32) = pack8(acc[ai][bj][m][0], acc[ai][bj][m][1]); }
        return false;
    }
};
struct EpiNull {
    static constexpr bool PERM = true; static constexpr int MINOPS = 0;
    __device__ __forceinline__ void init(f32x4 (&acc)[2][2][4][2], const GUnit&, int, int, int, int) const {
#pragma unroll
        for (int a = 0; a < 2; ++a)
#pragma unroll
            for (int b = 0; b < 2; ++b)
#pragma unroll
                for (int m = 0; m < 4; ++m)
#pragma unroll
                    for (int n = 0; n < 2; ++n) acc[a][b][m][n] = (f32x4){0.f, 0.f, 0.f, 0.f};
    }
    __device__ __forceinline__ bool operator()(f32x4 (&acc)[2][2][4][2], const GUnit&, int, int, int, int) const {
#pragma unroll
        for (int ai = 0; ai < 2; ++ai)
#pragma unroll
            for (int bj = 0; bj < 2; ++bj)
#pragma unroll
                for (int m = 0; m < 4; ++m)
#pragma unroll
                    for (int n = 0; n < 2; ++n) asm volatile("" :: "v"(acc[ai][bj][m][n]));
        return false;
    }
};
}

struct Args { const float* in[28]; float* out; unsigned char* ws; int ph_lo, ph_hi; };
struct Frame {
    LAS unsigned char* lds; unsigned char* ws; unsigned* ctl;
    int tid, lane, wave, vcu, G;
};

__device__ __forceinline__ int semcol(int lc) { return ((lc >> 5) & 3) * 64 + (lc >> 7) * 32 + (lc & 31); }
__device__ __forceinline__ int logcol(int sc) { return ((sc >> 5) & 1) * 128 + ((sc >> 6) & 3) * 32 + (sc & 31); }
__device__ __forceinline__ int colmap_in(int n) {
    const int pn = n >> 8, lc = n & 255, bj = lc >> 7, c = lc & 127;
    if (pn < 4) return bj * 512 + pn * 128 + c;
    if (pn < 6) return 1024 + ((pn - 4) * 4 + (c >> 5)) * 64 + bj * 32 + (c & 31);
    if (pn == 6) return c < 64 ? 1536 + (c >> 5) * 64 + bj * 32 + (c & 31) : 1664 + bj * 64 + (c - 64);
    if (pn < 9) return 1792 + (pn - 7) * 256 + semcol(lc);
    return 2304 + (pn - 9) * 256 + semcol(lc);
}
__device__ __forceinline__ void transpose_item(const float* src, int ld, int k0, int c0, bf16_t* dst, int r0, int Kd, LAS float* scr, int lane) {
    const int kr = lane >> 3, nq = (lane & 7) * 4;
    f32x4 v[8];
#pragma unroll
    for (int i = 0; i < 8; ++i) v[i] = __builtin_nontemporal_load((const f32x4*)(src + (size_t)(k0 + 8 * i + kr) * ld + c0 + nq));
#pragma unroll
    for (int i = 0; i < 8; ++i) { LAS float* p = scr + (8 * i + kr) * 33 + nq; p[0] = v[i][0]; p[1] = v[i][1]; p[2] = v[i][2]; p[3] = v[i][3]; }
    asm volatile("s_waitcnt lgkmcnt(0)" ::: "memory");
    const int c = lane & 7;
#pragma unroll
    for (int j = 0; j < 4; ++j) { const int n = (lane >> 3) + 8 * j; const LAS float* s = scr + (8 * c) * 33 + n;
        u32x4 o; o.x = pk2(s[0 * 33], s[1 * 33]); o.y = pk2(s[2 * 33], s[3 * 33]); o.z = pk2(s[4 * 33], s[5 * 33]); o.w = pk2(s[6 * 33], s[7 * 33]);
        *(u32x4*)(dst + (size_t)(r0 + n) * Kd + k0 + 8 * c) = o; }
    asm volatile("s_waitcnt lgkmcnt(0)" ::: "memory");
}
__device__ __forceinline__ void p_prologue(Frame& F, const Args& a) {
    float* mod = (float*)(F.ws + WS_MOD);
    if (blockIdx.x < 192) {
        const int l = blockIdx.x / 96, n0 = (blockIdx.x % 96) * 64;
        LAS float* sc = (LAS float*)F.lds; LAS float* part = (LAS float*)(F.lds + 36864);
        { float cv[18];
#pragma unroll
          for (int q = 0; q < 18; ++q) { const int i = q * 512 + F.tid; cv[q] = i < 8192 ? a.in[1][i] : a.in[3][i - 8192]; }
#pragma unroll
          for (int q = 0; q < 18; ++q) sc[q * 512 + F.tid] = cv[q] * sigmoidf_(cv[q]); }
        __syncthreads();
        const int ks = F.tid >> 6, col = F.tid & 63;
        float accv[9];
#pragma unroll
        for (int s = 0; s < 9; ++s) accv[s] = 0.f;
        const float* wp = a.in[4] + (size_t)l * 1024 * 6144 + n0 + col;
#pragma unroll 1
        for (int k0 = ks * 128; k0 < ks * 128 + 128; k0 += 16) { float w[16];
#pragma unroll
            for (int j = 0; j < 16; ++j) w[j] = wp[(size_t)(k0 + j) * 6144];
#pragma unroll
            for (int j = 0; j < 16; ++j)
#pragma unroll
                for (int s = 0; s < 9; ++s) accv[s] += sc[s * 1024 + k0 + j] * w[j]; }
#pragma unroll
        for (int s = 0; s < 9; ++s) part[(ks * 9 + s) * 64 + col] = accv[s];
        __syncthreads();
        for (int i = F.tid; i < 576; i += 512) { const int s = i >> 6, cc = i & 63; float v = a.in[5][l * 6144 + n0 + cc];
#pragma unroll
            for (int k2 = 0; k2 < 8; ++k2) v += part[(k2 * 9 + s) * 64 + cc];
            mod[(size_t)(l * 9 + s) * 6144 + n0 + cc] = v; }
        __syncthreads();
    }
    {
        const double inv[16] = {1.0, 0.5623413251903491, 0.31622776601683794, 0.1778279410038923, 0.1, 0.05623413251903491, 0.03162277660168379, 0.01778279410038923,
                                0.01, 0.005623413251903491, 0.0031622776601683794, 0.0017782794100389228, 0.001, 0.0005623413251903491, 0.00031622776601683794, 0.00017782794100389227};
        float* rope = (float*)(F.ws + WS_ROPE);
        for (int idx = F.vcu * 512 + F.tid; idx < 8192 * 32; idx += F.G * 512) {
            const int s = idx >> 5, dd = idx & 31; const int pos = dd < 16 ? (s >> 6) : (s & 63); const int i = dd & 15;
            double iv = inv[0];
#pragma unroll
            for (int q = 1; q < 16; ++q) iv = (i == q) ? inv[q] : iv;
            const double ang = (double)((float)pos * (float)iv);
            double rev = ang * 0.15915494309189535; rev -= __builtin_rint(rev); const double r = rev * 6.283185307179586, r2 = r * r;
            double sn = -1.0 / 51090942171709440000.0;
            sn = sn * r2 + 1.0 / 121645100408832000.0; sn = sn * r2 - 1.0 / 355687428096000.0; sn = sn * r2 + 1.0 / 1307674368000.0; sn = sn * r2 - 1.0 / 6227020800.0;
            sn = sn * r2 + 1.0 / 39916800.0; sn = sn * r2 - 1.0 / 362880.0; sn = sn * r2 + 1.0 / 5040.0; sn = sn * r2 - 1.0 / 120.0; sn = sn * r2 + 1.0 / 6.0; sn = sn * r2 - 1.0; sn = -sn * r;
            double cs = 1.0 / 1124000727777607680000.0;
            cs = cs * r2 - 1.0 / 2432902008176640000.0; cs = cs * r2 + 1.0 / 6402373705728000.0; cs = cs * r2 - 1.0 / 20922789888000.0; cs = cs * r2 + 1.0 / 87178291200.0;
            cs = cs * r2 - 1.0 / 479001600.0; cs = cs * r2 + 1.0 / 3628800.0; cs = cs * r2 - 1.0 / 40320.0; cs = cs * r2 + 1.0 / 720.0; cs = cs * r2 - 1.0 / 24.0; cs = cs * r2 + 0.5; cs = 1.0 - cs * r2;
            rope[idx] = (float)cs; rope[8192 * 32 + idx] = (float)sn;
        }
    }
    const int gw = F.vcu * 8 + F.wave, NGW = F.G * 8;
    for (int it = gw; it < 2048; it += NGW) {
        const int l = it >> 10, r = it & 1023, g = r >> 8, c0 = ((r & 255) >> 4) * 8, n = (r & 15) * 64 + F.lane;
        const float* wp = a.in[16] + ((size_t)(l * 4 + g) * 128 + c0) * 128; const float* ps = a.in[17] + l * 512 + g * 128; const float* wo = a.in[18] + ((size_t)l * 512 + g * 128) * 1024 + n;
        float accv[8];
#pragma unroll
        for (int i = 0; i < 8; ++i) accv[i] = 0.f;
        for (int d = 0; d < 128; ++d) { const float wv = wo[(size_t)d * 1024] * ps[d];
#pragma unroll
            for (int i = 0; i < 8; ++i) accv[i] += wp[i * 128 + d] * wv; }
        bf16_t* dst = (bf16_t*)(F.ws + WS_W + (size_t)l * W_LAYER + W_PE) + (size_t)((n & ~255) + logcol(n & 255)) * 512 + g * 128 + c0;
        u32x4 o; o.x = pk2(accv[0], accv[1]); o.y = pk2(accv[2], accv[3]); o.z = pk2(accv[4], accv[5]); o.w = pk2(accv[6], accv[7]);
        *(u32x4*)dst = o;
    }
    LAS float* scr = (LAS float*)(F.lds + F.wave * 16384);
    constexpr int I_IN = 16 * 168, I_P = 8 * 32, I_O = 16 * 32, I_GU = 32 * 1024, I_DN = 32 * 512, I_L = I_IN + 2 * I_P + I_O + I_GU + I_DN;
    for (int it = gw; it < 2 * I_L; it += NGW) {
        const int l = it / I_L; int r = it - l * I_L; unsigned char* wl = F.ws + WS_W + (size_t)l * W_LAYER;
        if (r < I_IN) { const int kb = r / 168, nb = r % 168; transpose_item(a.in[7] + (size_t)l * 1024 * DIN, DIN, kb * 64, colmap_in(nb * 32), (bf16_t*)(wl + W_IN), nb * 32, 1024, scr, F.lane); continue; } r -= I_IN;
        if (r < I_P) { const int kb = r / 32, nb = r % 32; transpose_item(a.in[13] + (size_t)l * 512 * 1024, 1024, kb * 64, ((nb * 32) & ~255) + semcol((nb * 32) & 255), (bf16_t*)(wl + W_CO), nb * 32, 512, scr, F.lane); continue; } r -= I_P;
        if (r < I_P) { const int kb = r / 32, nb = r % 32; transpose_item(a.in[15] + (size_t)l * 512 * 1024, 1024, kb * 64, ((nb * 32) & ~255) + semcol((nb * 32) & 255), (bf16_t*)(wl + W_AO), nb * 32, 512, scr, F.lane); continue; } r -= I_P;
        if (r < I_O) { const int kb = r / 32, nb = r % 32; transpose_item(a.in[19] + (size_t)l * 1024 * 1024, 1024, kb * 64, XBF16 ? ((nb * 32) & ~255) + semcol((nb * 32) & 255) : nb * 32, (bf16_t*)(wl + W_OUT), nb * 32, 1024, scr, F.lane); continue; } r -= I_O;
        if (r < I_GU) { const int e = r >> 10, rr = r & 1023, kb = rr >> 6, nb = rr & 63, n0 = nb * 32; const int pn = n0 >> 8, lc = n0 & 255, c0 = (lc >> 7) * 1024 + pn * 128 + (lc & 127);
            transpose_item(a.in[23] + (size_t)(l * 32 + e) * 1024 * 2048, 2048, kb * 64, c0, (bf16_t*)(wl + W_GU + (size_t)e * W_GU_E), n0, 1024, scr, F.lane); continue; } r -= I_GU;
        { const int e = r >> 9, rr = r & 511, kb = rr >> 5, nb = rr & 31;
            const int n0 = nb * 32, lc = n0 & 255; const int c0 = (n0 & ~255) + ((lc & 127) >> 5) * 64 + (lc >> 7) * 32;
            transpose_item(a.in[25] + (size_t)(l * 32 + e) * 1024 * 1024, 1024, kb * 64, c0, (bf16_t*)(wl + W_DN + (size_t)e * W_DN_E), n0, 1024, scr, F.lane); }
    }
}

__device__ __forceinline__ void p_norm0(Frame& F, const Args& a) {
    const float* mod = (const float*)(F.ws + WS_MOD); bf16_t* H = (bf16_t*)(F.ws + WS_H);
    const int gw = F.vcu * 8 + F.wave, NGW = F.G * 8; const int c0 = 8 * F.lane;
    for (int r0 = gw * 2; r0 < TA; r0 += NGW * 2) {
        const bool isx = r0 < TX; const int ms = isx ? (r0 >> 13) : 8;
        f32x4 v[2][4]; float ss[2];
#pragma unroll
        for (int q = 0; q < 2; ++q) { const float* src = isx ? a.in[0] + (size_t)(r0 + q) * 1024 : a.in[2] + (size_t)(r0 + q - TX) * 1024;
#pragma unroll
            for (int j = 0; j < 4; ++j) v[q][j] = __builtin_nontemporal_load((const f32x4*)(src + 512 * (j >> 1) + c0 + 4 * (j & 1))); }
        const float* mp = mod + (size_t)ms * 6144;
        f32x4 pg[4], psh[4], psc[4];
#pragma unroll
        for (int j = 0; j < 4; ++j) { const int c = 512 * (j >> 1) + c0 + 4 * (j & 1); pg[j] = *(const f32x4*)(a.in[6] + c); psh[j] = *(const f32x4*)(mp + c); psc[j] = *(const f32x4*)(mp + 1024 + c); }
#pragma unroll
        for (int q = 0; q < 2; ++q) { float s_ = 0.f;
#pragma unroll
            for (int j = 0; j < 4; ++j) s_ += (v[q][j][0] * v[q][j][0] + v[q][j][1] * v[q][j][1]) + (v[q][j][2] * v[q][j][2] + v[q][j][3] * v[q][j][3]);
            ss[q] = s_; }
#pragma unroll
        for (int o = 1; o < 64; o <<= 1) { ss[0] += __shfl_xor(ss[0], o); ss[1] += __shfl_xor(ss[1], o); }
#pragma unroll
        for (int q = 0; q < 2; ++q) { const float rstd = 1.0f / sqrtf(ss[q] * (1.0f / 1024.0f) + EPS); f32x4 h[4];
#pragma unroll
            for (int j = 0; j < 4; ++j) h[j] = (v[q][j] * rstd * pg[j]) * (psc[j] + 1.0f) + psh[j];
            *(u32x4*)(H + (size_t)(r0 + q) * 1024 + c0) = pack8(h[0], h[1]); *(u32x4*)(H + (size_t)(r0 + q) * 1024 + 512 + c0) = pack8(h[2], h[3]); }
    }
}

constexpr int AT_BUFB = 16384;
__device__ __forceinline__ int crow(int r, int hi) { return (r & 3) + 8 * (r >> 2) + 4 * hi; }
__device__ __forceinline__ void attn_unit(Frame& F, const bf16_t* Q, const bf16_t* Kb, const bf16_t* VT, bf16_t* AT, const float* sink, bool isz, int b, int n, int kvh) {
    const int tid = F.tid, lane = F.lane, wave = F.wave, r32 = lane & 31, hi = lane >> 5;
    const int qq = (wave & 3) ^ ((wave >> 2) * 2), headA = kvh * 4 + (wave >> 2) * 2;
    const int qrow = (isz ? TX + b * CTXL : b * SEQ) + n * 128 + qq * 32;
    LAS unsigned char* KV = F.lds;
    LAS unsigned char* QS = F.lds + 3 * AT_BUFB + wave * 8192;
    const int n0 = (isz || n == 0) ? 0 : 2, n2 = n0 + ((isz || n == SEQ / 128 - 1) ? 0 : 2), ntile = isz ? 4 : n2 + 6;
    const int srow = tid >> 3, chunk = (tid & 7) ^ ((srow >> 1) & 7);
#define AT_CODE(ti, cc) do { const int t_ = (ti); cc = isz ? t_ + 6 : (t_ < n0 ? t_ : (t_ < n2 ? 4 + (t_ - n0) : (t_ - n2 < 2 ? 2 + (t_ - n2) : 4 + (t_ - n2)))); } while (0)
#define AT_ISSUE(ti, bo_) do { int c_; AT_CODE(ti, c_); const bf16_t* ksrc; const bf16_t* vsrc; \
        if (c_ < 6) { const int blk = n - 1 + (c_ >> 1), j0_ = (c_ & 1) * 64; ksrc = Kb + (size_t)(b * SEQ + blk * 128 + j0_ + srow) * 128 + kvh * 64 + chunk * 8; \
                      vsrc = VT + ((size_t)((b * 2 + kvh) * 64 + srow)) * SEQ + blk * 128 + j0_ + chunk * 8; } \
        else { const int j0_ = (c_ - 6) * 64; ksrc = Kb + (size_t)(TX + b * CTXL + j0_ + srow) * 128 + kvh * 64 + chunk * 8; \
               vsrc = VT + (size_t)TX * 128 + ((size_t)((b * 2 + kvh) * 64 + srow)) * CTXL + j0_ + chunk * 8; } \
        __builtin_amdgcn_global_load_lds((const unsigned*)ksrc, (LAS unsigned*)(KV + (bo_) + wave * 1024), 16, 0, 0); \
        __builtin_amdgcn_global_load_lds((const unsigned*)vsrc, (LAS unsigned*)(KV + (bo_) + 8192 + wave * 1024), 16, 0, 0); } while (0)
    { const int qr = lane >> 4, qc = lane & 15;
#pragma unroll
        for (int i = 0; i < 8; ++i) { const int row = 4 * i + qr;
            __builtin_amdgcn_global_load_lds((const unsigned*)(Q + (size_t)(qrow + row) * 512 + headA * 64 + ((qc ^ (row & 15)) * 8)), (LAS unsigned*)(QS + i * 1024), 16, 0, 0); } }
    asm volatile("" ::: "memory");
    __builtin_amdgcn_s_barrier();
    asm volatile("" ::: "memory");
    AT_ISSUE(0, 0);
    AT_ISSUE(1, AT_BUFB);
    const int qo_ = r32 * 256 + (((r32 & 15) ^ hi) << 4);
    const int a0 = r32 * 128 + (((r32 >> 2) & 3) << 5) + ((hi ^ ((r32 >> 1) & 1)) << 4);
    const float c2 = 0.125f * LOG2E;
    float mrA = sink[headA] * LOG2E, mrB = sink[headA + 1] * LOG2E, lrA = (hi == 0) ? 1.0f : 0.0f, lrB = lrA;
    f32x16 oA0, oA1, oB0, oB1;
#pragma unroll
    for (int r = 0; r < 16; ++r) { oA0[r] = 0.f; oA1[r] = 0.f; oB0[r] = 0.f; oB1[r] = 0.f; }
#define AT_SOFTMAX(s0, s1, mrun, lrun, o0, o1, pw) do { \
        const f32x2 c2v = {c2, c2};                                           \
        _Pragma("unroll") for (int r = 0; r < 16; r += 2) { const f32x2 a = (f32x2){s0[r], s0[r + 1]} * c2v, b = (f32x2){s1[r], s1[r + 1]} * c2v; s0[r] = a.x; s0[r + 1] = a.y; s1[r] = b.x; s1[r + 1] = b.y; } \
        float tma = fmaxf(s0[0], s1[0]), tmb = fmaxf(s0[1], s1[1]), tmc = fmaxf(s0[2], s1[2]), tmd = fmaxf(s0[3], s1[3]); \
        _Pragma("unroll") for (int r = 4; r < 16; r += 4) { tma = fmaxf(tma, fmaxf(s0[r], s1[r])); tmb = fmaxf(tmb, fmaxf(s0[r + 1], s1[r + 1])); tmc = fmaxf(tmc, fmaxf(s0[r + 2], s1[r + 2])); tmd = fmaxf(tmd, fmaxf(s0[r + 3], s1[r + 3])); } \
        float tm = fmaxf(fmaxf(tma, tmb), fmaxf(tmc, tmd)); tm = fmaxf(tm, __shfl_xor(tm, 32)); \
        const float mn = fmaxf(mrun, tm); const bool grew = __any(mn > mrun); const float alpha = __builtin_amdgcn_exp2f(mrun - mn); mrun = mn; \
        const f32x2 mnv = {mn, mn}, alv = {alpha, alpha}; f32x2 ls0 = {0.f, 0.f}, ls1 = {0.f, 0.f}; \
        _Pragma("unroll") for (int r = 0; r < 16; r += 2) { \
            f32x2 a = (f32x2){s0[r], s0[r + 1]} - mnv, b = (f32x2){s1[r], s1[r + 1]} - mnv; \
            a.x = __builtin_amdgcn_exp2f(a.x); a.y = __builtin_amdgcn_exp2f(a.y); b.x = __builtin_amdgcn_exp2f(b.x); b.y = __builtin_amdgcn_exp2f(b.y); \
            s0[r] = a.x; s0[r + 1] = a.y; s1[r] = b.x; s1[r + 1] = b.y; ls0 += a; ls1 += b; } \
        ls0 += ls1; lrun = lrun * alpha + (ls0.x + ls0.y); \
        if (grew) { _Pragma("unroll") for (int r = 0; r < 16; r += 2) { const f32x2 x0 = (f32x2){o0[r], o0[r + 1]} * alv, x1 = (f32x2){o1[r], o1[r + 1]} * alv; o0[r] = x0.x; o0[r + 1] = x0.y; o1[r] = x1.x; o1[r + 1] = x1.y; } } \
        pw[0] = (u32x4){pk2(s0[0], s0[1]), pk2(s0[2], s0[3]), pk2(s0[4], s0[5]), pk2(s0[6], s0[7])}; \
        pw[1] = (u32x4){pk2(s0[8], s0[9]), pk2(s0[10], s0[11]), pk2(s0[12], s0[13]), pk2(s0[14], s0[15])}; \
        pw[2] = (u32x4){pk2(s1[0], s1[1]), pk2(s1[2], s1[3]), pk2(s1[4], s1[5]), pk2(s1[6], s1[7])}; \
        pw[3] = (u32x4){pk2(s1[8], s1[9]), pk2(s1[10], s1[11]), pk2(s1[12], s1[13]), pk2(s1[14], s1[15])}; } while (0)
#define AT_MASK(MODE, s0, s1) do { if (MODE == 0) { _Pragma("unroll") for (int r = 0; r < 16; ++r) { const int cr = (r & 3) + 8 * (r >> 2); if (cr < tq) s0[r] = -1e30f; if (cr + 32 < tq) s1[r] = -1e30f; } } \
        else if (MODE == 2) { _Pragma("unroll") for (int r = 0; r < 16; ++r) { const int cr = (r & 3) + 8 * (r >> 2); if (cr > tq) s0[r] = -1e30f; if (cr + 32 > tq) s1[r] = -1e30f; } } } while (0)
#define AT_TILE(MODE) do { \
        if (ti + 1 < ntile) asm volatile("s_waitcnt vmcnt(2)" ::: "memory"); else asm volatile("s_waitcnt vmcnt(0)" ::: "memory"); \
        __builtin_amdgcn_s_barrier();                                          \
        asm volatile("" ::: "memory"); \
        if (ti + 2 < ntile) { const int bn = bo >= AT_BUFB ? bo - AT_BUFB : bo + 2 * AT_BUFB; AT_ISSUE(ti + 2, bn); } \
        int ccur; AT_CODE(ti, ccur); const int j0 = (ccur & 1) * 64; \
        const bool skip = (MODE == 0 && j0 == 0 && qq >= 2) || (MODE == 2 && j0 == 64 && qq < 2); \
        if (!skip) { \
            const LAS unsigned char* tb = KV + bo; const int tq = qt - j0; (void)tq; \
            f32x16 sA0, sA1, sB0, sB1; u32x4 pwA[4], pwB[4]; \
            _Pragma("unroll") for (int r = 0; r < 16; ++r) { sA0[r] = 0.f; sA1[r] = 0.f; sB0[r] = 0.f; sB1[r] = 0.f; } \
            _Pragma("unroll") for (int ks = 0; ks < 4; ++ks) { \
                const bf16x8 k0 = *(const LAS bf16x8*)(tb + (a0 ^ (ks * 32))), k1 = *(const LAS bf16x8*)(tb + 4096 + (a0 ^ (ks * 32))); \
                const bf16x8 qa = *(const LAS bf16x8*)(QS + (qo_ ^ (ks * 32))), qb = *(const LAS bf16x8*)(QS + (qo_ ^ (128 + ks * 32))); \
                sA0 = __builtin_amdgcn_mfma_f32_32x32x16_bf16(k0, qa, sA0, 0, 0, 0); sA1 = __builtin_amdgcn_mfma_f32_32x32x16_bf16(k1, qa, sA1, 0, 0, 0); \
                sB0 = __builtin_amdgcn_mfma_f32_32x32x16_bf16(k0, qb, sB0, 0, 0, 0); sB1 = __builtin_amdgcn_mfma_f32_32x32x16_bf16(k1, qb, sB1, 0, 0, 0); } \
            AT_MASK(MODE, sA0, sA1); AT_MASK(MODE, sB0, sB1); \
            AT_SOFTMAX(sA0, sA1, mrA, lrA, oA0, oA1, pwA); \
            AT_SOFTMAX(sB0, sB1, mrB, lrB, oB0, oB1, pwB); \
            _Pragma("unroll") for (int kk = 0; kk < 4; ++kk) { \
                const bf16x8 v0 = *(const LAS bf16x8*)(tb + 8192 + (a0 ^ (kk * 32))), v1 = *(const LAS bf16x8*)(tb + 12288 + (a0 ^ (kk * 32))); \
                oA0 = __builtin_amdgcn_mfma_f32_32x32x16_bf16(v0, __builtin_bit_cast(bf16x8, pwA[kk]), oA0, 0, 0, 0); oA1 = __builtin_amdgcn_mfma_f32_32x32x16_bf16(v1, __builtin_bit_cast(bf16x8, pwA[kk]), oA1, 0, 0, 0); \
                oB0 = __builtin_amdgcn_mfma_f32_32x32x16_bf16(v0, __builtin_bit_cast(bf16x8, pwB[kk]), oB0, 0, 0, 0); oB1 = __builtin_amdgcn_mfma_f32_32x32x16_bf16(v1, __builtin_bit_cast(bf16x8, pwB[kk]), oB1, 0, 0, 0); } \
        } \
        bo = bo == 2 * AT_BUFB ? 0 : bo + AT_BUFB; } while (0)
    int qt = qq * 32 + r32 - 4 * hi; asm volatile("" : "+v"(qt));
    int bo = 0, ti = 0;
#pragma unroll 1
    for (; ti < n0; ++ti) AT_TILE(0);
#pragma unroll 1
    for (; ti < n2; ++ti) AT_TILE(2);
#pragma unroll 1
    for (; ti < ntile; ++ti) AT_TILE(1);
#undef AT_CODE
#undef AT_ISSUE
#undef AT_SOFTMAX
#undef AT_MASK
#undef AT_TILE
    {
        const float ltA = lrA + __shfl_xor(lrA, 32), ltB = lrB + __shfl_xor(lrB, 32); const float invA = 1.0f / ltA, invB = 1.0f / ltB;
        bf16_t* op = AT + (size_t)(qrow + r32) * 512 + headA * 64 + 4 * hi;
#pragma unroll
        for (int gi = 0; gi < 4; ++gi) {
            u32x2 w; w.x = pk2(oA0[4 * gi] * invA, oA0[4 * gi + 1] * invA); w.y = pk2(oA0[4 * gi + 2] * invA, oA0[4 * gi + 3] * invA); *(u32x2*)(op + 8 * gi) = w;
            w.x = pk2(oA1[4 * gi] * invA, oA1[4 * gi + 1] * invA); w.y = pk2(oA1[4 * gi + 2] * invA, oA1[4 * gi + 3] * invA); *(u32x2*)(op + 32 + 8 * gi) = w;
            w.x = pk2(oB0[4 * gi] * invB, oB0[4 * gi + 1] * invB); w.y = pk2(oB0[4 * gi + 2] * invB, oB0[4 * gi + 3] * invB); *(u32x2*)(op + 64 + 8 * gi) = w;
            w.x = pk2(oB1[4 * gi] * invB, oB1[4 * gi + 1] * invB); w.y = pk2(oB1[4 * gi + 2] * invB, oB1[4 * gi + 3] * invB); *(u32x2*)(op + 96 + 8 * gi) = w; }
    }
}

__device__ __forceinline__ void conv_task(Frame& F, int tk, const bf16_t* AG, bf16_t* AC, const LAS float* wl, const float* bdw, const float* lng, const float* lnb) {
    const int t0 = tk * 8; int s0, s1;
    if (t0 < TX) { s0 = t0 & ~(SEQ - 1); s1 = s0 + SEQ; } else { s0 = TX + ((t0 - TX) & ~(CTXL - 1)); s1 = s0 + CTXL; }
    int cA = 4 * F.lane; asm volatile("" : "+v"(cA));
    float acc[8][8];
#pragma unroll
    for (int o = 0; o < 8; ++o)
#pragma unroll
        for (int i = 0; i < 8; ++i) acc[o][i] = 0.f;
    u32x2 cwa[8], cwb[8], nwa[8], nwb[8];
    const bf16_t* zrow = (const bf16_t*)(F.ws + WS_CTL + 126 * 1024);
#pragma unroll
    for (int i = 0; i < 8; ++i) { const int row = t0 - 15 + i; const bool inr = row >= s0 && row < s1; const bf16_t* rp = inr ? AG + (size_t)row * 512 : zrow;
        cwa[i] = *(const u32x2*)(rp + cA); cwb[i] = *(const u32x2*)(rp + 256 + cA); }
#pragma unroll 1
    for (int grp = 0; grp < 5; ++grp) {
        if (grp < 4) {
#pragma unroll
            for (int i = 0; i < 8; ++i) { const int row = t0 - 15 + 8 * (grp + 1) + i; const bool inr = row >= s0 && row < s1; const bf16_t* rp = inr ? AG + (size_t)row * 512 : zrow;
                nwa[i] = *(const u32x2*)(rp + cA); nwb[i] = *(const u32x2*)(rp + 256 + cA); }
        }
        float x[8][8];
#pragma unroll
        for (int i = 0; i < 8; ++i) { x[i][0] = bflo(cwa[i].x); x[i][1] = bfhi(cwa[i].x); x[i][2] = bflo(cwa[i].y); x[i][3] = bfhi(cwa[i].y);
            x[i][4] = bflo(cwb[i].x); x[i][5] = bfhi(cwb[i].x); x[i][6] = bflo(cwb[i].y); x[i][7] = bfhi(cwb[i].y); }
        const LAS float* wg = wl + (8 * grp + 8) * 512 + cA;
#pragma unroll
        for (int d = -7; d <= 7; ++d) {
            const f32x4 w0 = *(const LAS f32x4*)(wg + d * 512), w1 = *(const LAS f32x4*)(wg + d * 512 + 256);
#pragma unroll
            for (int o = 0; o < 8; ++o) { const int i = o + d;
                if (i >= 0 && i < 8) {
#pragma unroll
                    for (int q = 0; q < 4; ++q) { acc[o][q] += w0[q] * x[i][q]; acc[o][4 + q] += w1[q] * x[i][4 + q]; } } }
        }
#pragma unroll
        for (int i = 0; i < 8; ++i) { cwa[i] = nwa[i]; cwb[i] = nwb[i]; }
    }
    const f32x4 b0 = *(const f32x4*)(bdw + cA), b1 = *(const f32x4*)(bdw + 256 + cA), g0 = *(const f32x4*)(lng + cA), g1 = *(const f32x4*)(lng + 256 + cA),
                e0 = *(const f32x4*)(lnb + cA), e1 = *(const f32x4*)(lnb + 256 + cA);
#pragma unroll
    for (int o = 0; o < 8; ++o) {
        float v[8]; float s = 0.f;
#pragma unroll
        for (int i = 0; i < 4; ++i) { v[i] = acc[o][i] + b0[i]; v[4 + i] = acc[o][4 + i] + b1[i]; s += v[i] + v[4 + i]; }
        const float mu = wave_sum(s) * (1.0f / 512.0f); float q = 0.f;
#pragma unroll
        for (int i = 0; i < 8; ++i) { v[i] -= mu; q += v[i] * v[i]; }
        const float rstd = 1.0f / sqrtf(wave_sum(q) * (1.0f / 512.0f) + EPS);
        float y[8];
#pragma unroll
        for (int i = 0; i < 4; ++i) { const float ya = v[i] * rstd * g0[i] + e0[i], yb = v[4 + i] * rstd * g1[i] + e1[i]; y[i] = ya * sigmoidf_(ya); y[4 + i] = yb * sigmoidf_(yb); }
        u32x2 oa, ob; oa.x = pk2(y[0], y[1]); oa.y = pk2(y[2], y[3]); ob.x = pk2(y[4], y[5]); ob.y = pk2(y[6], y[7]);
        *(u32x2*)(AC + (size_t)(t0 + o) * 512 + cA) = oa; *(u32x2*)(AC + (size_t)(t0 + o) * 512 + 256 + cA) = ob;
    }
}
__device__ __forceinline__ void conv_task1(Frame& F, int t, const bf16_t* AG, bf16_t* AC, const LAS float* wl, const float* bdw, const float* lng, const float* lnb) {
    const int s0 = t < TX ? (t & ~(SEQ - 1)) : TX + ((t - TX) & ~(CTXL - 1)), s1 = s0 + (t < TX ? SEQ : CTXL);
    int c0 = 8 * F.lane; asm volatile("" : "+v"(c0));
    const bf16_t* zrow1 = (const bf16_t*)(F.ws + WS_CTL + 126 * 1024);
    float acc[8];
#pragma unroll
    for (int i = 0; i < 8; ++i) acc[i] = 0.f;
#pragma unroll 1
    for (int hb = 0; hb < 2; ++hb) {
        u32x4 xr[16];
#pragma unroll
        for (int i = 0; i < 16; ++i) { const int j = hb * 16 + i, row = t + j - 15; const bool inr = j < 31 && row >= s0 && row < s1;
            xr[i] = *(const u32x4*)((inr ? AG + (size_t)row * 512 : zrow1) + c0); }
#pragma unroll
        for (int i = 0; i < 16; ++i) { const int j = hb * 16 + i; f32x4 xa, xb; unpack8(xr[i], xa, xb);
            const f32x4 w0 = *(const LAS f32x4*)(wl + (j + 8) * 512 + c0), w1 = *(const LAS f32x4*)(wl + (j + 8) * 512 + c0 + 4);
#pragma unroll
            for (int q = 0; q < 4; ++q) { acc[q] += w0[q] * xa[q]; acc[4 + q] += w1[q] * xb[q]; } }
    }
    const f32x4 b0 = *(const f32x4*)(bdw + c0), b1 = *(const f32x4*)(bdw + c0 + 4), g0 = *(const f32x4*)(lng + c0), g1 = *(const f32x4*)(lng + c0 + 4), e0 = *(const f32x4*)(lnb + c0), e1 = *(const f32x4*)(lnb + c0 + 4);
    float v[8]; float s = 0.f;
#pragma unroll
    for (int i = 0; i < 4; ++i) { v[i] = acc[i] + b0[i]; v[4 + i] = acc[4 + i] + b1[i]; s += v[i] + v[4 + i]; }
    const float mu = wave_sum(s) * (1.0f / 512.0f); float q = 0.f;
#pragma unroll
    for (int i = 0; i < 8; ++i) { v[i] -= mu; q += v[i] * v[i]; }
    const float rstd = 1.0f / sqrtf(wave_sum(q) * (1.0f / 512.0f) + EPS);
    f32x4 ya, yb;
#pragma unroll
    for (int i = 0; i < 4; ++i) { const float a = v[i] * rstd * g0[i] + e0[i], b = v[4 + i] * rstd * g1[i] + e1[i]; ya[i] = a * sigmoidf_(a); yb[i] = b * sigmoidf_(b); }
    *(u32x4*)(AC + (size_t)t * 512 + c0) = pack8(ya, yb);
}
__device__ __forceinline__ void pool_task(Frame& F, int tk, const bf16_t* U, bf16_t* PL) {
    const int t0 = tk * 8; int s0, s1;
    if (t0 < TX) { s0 = t0 & ~(SEQ - 1); s1 = s0 + SEQ; } else { s0 = TX + ((t0 - TX) & ~(CTXL - 1)); s1 = s0 + CTXL; }
    int c0 = 8 * F.lane; asm volatile("" : "+v"(c0)); const int hw = 1 << (F.lane >> 4);
    float acc[8][8], cnt[8];
#pragma unroll
    for (int o = 0; o < 8; ++o) { cnt[o] = 0.f;
#pragma unroll
        for (int i = 0; i < 8; ++i) acc[o][i] = 0.f; }
    u32x4 cu[4], nu[4];
#pragma unroll
    for (int i = 0; i < 4; ++i) { const int row = t0 - 8 + i; const int rr = (row >= s0 && row < s1) ? row : t0; cu[i] = *(const u32x4*)(U + (size_t)rr * 512 + c0); }
#pragma unroll 1
    for (int grp = 0; grp < 6; ++grp) {
        if (grp < 5) {
#pragma unroll
            for (int i = 0; i < 4; ++i) { const int row = t0 - 8 + 4 * (grp + 1) + i; const int rr = (row >= s0 && row < s1) ? row : t0; nu[i] = *(const u32x4*)(U + (size_t)rr * 512 + c0); }
        }
#pragma unroll
        for (int i = 0; i < 4; ++i) {
            const int r = -8 + 4 * grp + i; const int row = t0 + r; const bool inr = row >= s0 && row < s1;
            f32x4 xa, xb; unpack8(cu[i], xa, xb);
#pragma unroll
            for (int o = 0; o < 8; ++o) { const int rel = r - o;
                const float mm = (inr && rel >= -hw && rel < hw) ? 1.0f : 0.0f; cnt[o] += mm;
#pragma unroll
                for (int q = 0; q < 4; ++q) { acc[o][q] += mm * xa[q]; acc[o][4 + q] += mm * xb[q]; } }
            __builtin_amdgcn_sched_barrier(0);
        }
#pragma unroll
        for (int i = 0; i < 4; ++i) cu[i] = nu[i];
    }
    u32x4 wown[8];
#pragma unroll
    for (int o = 0; o < 8; ++o) wown[o] = *(const u32x4*)(U + (size_t)(t0 + o) * 512 + c0);
#pragma unroll
    for (int o = 0; o < 8; ++o) {
        const u32x4 w = wown[o]; f32x4 xa, xb; unpack8(w, xa, xb);
        const float ic = 1.0f / cnt[o]; f32x4 pa, pb;
#pragma unroll
        for (int i = 0; i < 4; ++i) { pa[i] = acc[o][i] * ic - xa[i]; pb[i] = acc[o][4 + i] * ic - xb[i]; }
        *(u32x4*)(PL + (size_t)(t0 + o) * 512 + c0) = pack8(pa, pb);
    }
}

__device__ __forceinline__ void moe_tables(Frame& F, int l) {
    LAS unsigned* tab = (LAS unsigned*)(F.lds + LDS_TAB);
    __syncthreads();
    if (F.tid < 32) { const unsigned n = __hip_atomic_load(F.ctl + CW_CNT + (l * 32 + F.tid) * 64, __ATOMIC_RELAXED, __HIP_MEMORY_SCOPE_AGENT); tab[F.tid] = n; tab[1400 + F.tid] = (n + 255u) >> 8; }
    __syncthreads();
    if (F.tid < 32) { unsigned tb = 0; for (int e = 0; e < F.tid; ++e) tb += tab[1400 + e]; const unsigned nte = tab[1400 + F.tid]; tab[32 + F.tid] = tb; if (F.tid == 31) tab[64] = tb + nte;
        for (unsigned i = 0; i < nte; ++i) tab[96 + tb + i] = (unsigned)F.tid; }
    __syncthreads();
}

__device__ __forceinline__ void p_route(Frame& F, const Args& a, int l, int dummy) {
    const float* mod = (const float*)(F.ws + WS_MOD) + (size_t)l * 9 * 6144; bf16_t* H = (bf16_t*)(F.ws + WS_H);
#if XBF16
    const bf16_t* X = (const bf16_t*)(F.ws + WS_X);
#else
    const float* X = (const float*)(F.ws + WS_X);
#endif
    unsigned* TI = (unsigned*)(F.ws + WS_TI + (dummy ? WS_END - WS_TI : 0)); float* TG = (float*)(F.ws + WS_TG + (dummy ? WS_END - WS_TI : 0)); unsigned* LIST = (unsigned*)(F.ws + WS_LIST + (dummy ? WS_END - WS_TI : 0));
    unsigned* cntw = F.ctl + CW_CNT + (dummy ? 8192 : 0);
    const float* rw = a.in[21] + (size_t)l * 1024 * 32; const float* rb = a.in[22] + l * 32; const float* n2g = a.in[20] + l * 1024;
    LAS unsigned char* WH = F.lds; LAS unsigned char* WL = F.lds + 65536; LAS float* LG = (LAS float*)(F.lds + 131072) + F.wave * 512;
    LAS unsigned* hist = (LAS unsigned*)(F.lds + 131072 + 16384); LAS unsigned* basel = hist + 32;
    const int tid = F.tid, lane = F.lane;
    {
        f32x4 wv[16];
#pragma unroll
        for (int k = 0; k < 16; ++k) wv[k] = *(const f32x4*)(rw + 4 * (k * 512 + tid));
#pragma unroll
        for (int k = 0; k < 16; ++k) { const int v = k * 512 + tid, c = v >> 3, e0 = (v & 7) * 4;
#pragma unroll
            for (int j = 0; j < 4; ++j) { const int e = e0 + j; const float w = wv[k][j]; const unsigned h = f2bf(w); const float wh = __builtin_bit_cast(float, h << 16); const unsigned lo = f2bf(w - wh);
                const int ad = e * 2048 + (((c >> 3) ^ (e & 15)) * 16) + (c & 7) * 2; *(LAS bf16_t*)(WH + ad) = (bf16_t)h; *(LAS bf16_t*)(WL + ad) = (bf16_t)lo; } }
    }
    if (tid < 32) hist[tid] = 0u;
    __syncthreads();
    const int niter = (l == 0 ? TA : TX) / 128;
    const int tt = lane & 15, q = lane >> 4;
    const float* SSp = (const float*)(F.ws + WS_SS);
    LAS float* GL = (LAS float*)(F.lds + 131072 + 16384 + 512); LAS float* SL = GL + 1024;
    for (int it = blockIdx.x; it < niter; it += F.G) {
        const int trow = it * 128 + F.wave * 16 + tt; const int ms = (it * 128) < TX ? ((it * 128) >> 13) : 8;
        const auto* xr = X + (size_t)trow * 1024 + q * 8; const float* mp = mod + (size_t)ms * 6144;
        { const float ga0 = n2g[tid], ga1 = n2g[tid + 512], sc0 = mp[4 * 1024 + tid], sc1 = mp[4 * 1024 + tid + 512], sh0 = mp[3 * 1024 + tid], sh1 = mp[3 * 1024 + tid + 512];
          GL[tid] = ga0 * (sc0 + 1.0f); GL[tid + 512] = ga1 * (sc1 + 1.0f); SL[tid] = sh0; SL[tid + 512] = sh1; }
        const f32x4 sp = *(const f32x4*)(SSp + (size_t)trow * 16 + q * 4);
        float ss = (sp[0] + sp[1]) + (sp[2] + sp[3]);
        ss += __shfl_xor(ss, 16); ss += __shfl_xor(ss, 32);
        const float rstd = 1.0f / sqrtf(ss * (1.0f / 1024.0f) + EPS);
        __syncthreads();
        f32x4 lacc[2]; lacc[0] = (f32x4){0.f, 0.f, 0.f, 0.f}; lacc[1] = lacc[0];
#if XBF16
        const bf16_t* xr2 = X + (size_t)trow * 1024 + q * 16;
#pragma unroll 2
        for (int st = 0; st < 16; ++st) { const int c = st * 64 + q * 16;
            const u32x4 xw0 = *(const u32x4*)(xr2 + st * 64), xw1 = *(const u32x4*)(xr2 + st * 64 + 8);
            u32x4 hw[2], lw[2];
#pragma unroll
            for (int j = 0; j < 2; ++j) { f32x4 xa, xb; unpack8(j ? xw1 : xw0, xa, xb); const int cj = c + 8 * j;
                const f32x4 ga = *(const LAS f32x4*)(GL + cj), gb = *(const LAS f32x4*)(GL + cj + 4), sha = *(const LAS f32x4*)(SL + cj), shb = *(const LAS f32x4*)(SL + cj + 4);
                const f32x4 ha = (xa * rstd) * ga + sha, hb = (xb * rstd) * gb + shb;
                hw[j] = pack8(ha, hb); f32x4 ra, rbb; unpack8(hw[j], ra, rbb); lw[j] = pack8(ha - ra, hb - rbb); }
            *(u32x4*)(H + (size_t)trow * 1024 + c) = hw[0]; *(u32x4*)(H + (size_t)trow * 1024 + c + 8) = hw[1];
#pragma unroll
            for (int j = 0; j < 2; ++j) { const bf16x8 Ah = __builtin_bit_cast(bf16x8, hw[j]), Al = __builtin_bit_cast(bf16x8, lw[j]);
#pragma unroll
                for (int nb = 0; nb < 2; ++nb) { const int e = nb * 16 + tt; const int ad = e * 2048 + (((st * 8 + q * 2 + j) ^ tt) * 16);
                    const bf16x8 bh = *(const LAS bf16x8*)(WH + ad), bl = *(const LAS bf16x8*)(WL + ad);
                    lacc[nb] = __builtin_amdgcn_mfma_f32_16x16x32_bf16(Ah, bh, lacc[nb], 0, 0, 0);
                    lacc[nb] = __builtin_amdgcn_mfma_f32_16x16x32_bf16(Ah, bl, lacc[nb], 0, 0, 0);
                    lacc[nb] = __builtin_amdgcn_mfma_f32_16x16x32_bf16(Al, bh, lacc[nb], 0, 0, 0); } }
        }
#else
#pragma unroll 4
        for (int ks = 0; ks < 32; ++ks) { const int c = ks * 32 + q * 8;
            const f32x4 xa = *(const f32x4*)(xr + ks * 32), xb = *(const f32x4*)(xr + ks * 32 + 4);
            const f32x4 ga = *(const LAS f32x4*)(GL + c), gb = *(const LAS f32x4*)(GL + c + 4), sha = *(const LAS f32x4*)(SL + c), shb = *(const LAS f32x4*)(SL + c + 4);
            const f32x4 ha = (xa * rstd) * ga + sha, hb = (xb * rstd) * gb + shb;
            const u32x4 hw = pack8(ha, hb); f32x4 ra, rbb; unpack8(hw, ra, rbb);
            const u32x4 lw = pack8(ha - ra, hb - rbb);
            *(u32x4*)(H + (size_t)trow * 1024 + c) = hw;
            const bf16x8 Ah = __builtin_bit_cast(bf16x8, hw), Al = __builtin_bit_cast(bf16x8, lw);
#pragma unroll
            for (int nb = 0; nb < 2; ++nb) { const int e = nb * 16 + tt; const int ad = e * 2048 + (((ks * 4 + q) ^ tt) * 16);
                const bf16x8 bh = *(const LAS bf16x8*)(WH + ad), bl = *(const LAS bf16x8*)(WL + ad);
                lacc[nb] = __builtin_amdgcn_mfma_f32_16x16x32_bf16(Ah, bh, lacc[nb], 0, 0, 0);
                lacc[nb] = __builtin_amdgcn_mfma_f32_16x16x32_bf16(Ah, bl, lacc[nb], 0, 0, 0);
                lacc[nb] = __builtin_amdgcn_mfma_f32_16x16x32_bf16(Al, bh, lacc[nb], 0, 0, 0); }
        }
#endif
#pragma unroll
        for (int nb = 0; nb < 2; ++nb) { const float bias = rb[nb * 16 + tt];
#pragma unroll
            for (int r = 0; r < 4; ++r) LG[(4 * q + r) * 32 + nb * 16 + tt] = lacc[nb][r] + bias; }
        asm volatile("s_waitcnt lgkmcnt(0)" ::: "memory");
        int be[4] = {0, 0, 0, 0}; float gt[4] = {0.f, 0.f, 0.f, 0.f}; unsigned rk[4] = {0u, 0u, 0u, 0u};
        if (lane < 16) {
            float lg[32];
#pragma unroll
            for (int j = 0; j < 8; ++j) { const f32x4 v = *(const LAS f32x4*)(LG + lane * 32 + 4 * j); lg[4 * j] = v[0]; lg[4 * j + 1] = v[1]; lg[4 * j + 2] = v[2]; lg[4 * j + 3] = v[3]; }
            float bv[4];
#pragma unroll
            for (int k = 0; k < 4; ++k) { float best = lg[0]; int bi = 0;
#pragma unroll
                for (int e = 1; e < 32; ++e) { const bool gtb = lg[e] > best; best = gtb ? lg[e] : best; bi = gtb ? e : bi; }
                bv[k] = best; be[k] = bi;
#pragma unroll
                for (int e = 0; e < 32; ++e) lg[e] = (e == bi) ? -3.0e38f : lg[e]; }
            float sum = 0.f;
#pragma unroll
            for (int k = 0; k < 4; ++k) { gt[k] = __expf(bv[k] - bv[0]); sum += gt[k]; }
            const float isum = 1.0f / sum;
#pragma unroll
            for (int k = 0; k < 4; ++k) { gt[k] *= isum; rk[k] = __hip_atomic_fetch_add(hist + be[k], 1u, __ATOMIC_RELAXED, __HIP_MEMORY_SCOPE_WORKGROUP); }
        }
        __syncthreads();
        if (tid < 32) { const unsigned nn = hist[tid]; unsigned bs = 0u; if (nn) bs = __hip_atomic_fetch_add(cntw + (l * 32 + tid) * 64, nn, __ATOMIC_RELAXED, __HIP_MEMORY_SCOPE_AGENT); basel[tid] = bs; }
        __syncthreads();
        if (lane < 16) { const int trw = it * 128 + F.wave * 16 + lane;
#pragma unroll
            for (int k = 0; k < 4; ++k) { const unsigned slot = basel[be[k]] + rk[k]; TI[(size_t)trw * 4 + k] = ((unsigned)be[k] << 20) | slot; TG[(size_t)trw * 4 + k] = gt[k]; LIST[(size_t)be[k] * TA + slot] = (unsigned)trw; } }
        __syncthreads();
        if (tid < 32) hist[tid] = 0u;
        __syncthreads();
    }
}

__device__ __forceinline__ void p_comb(Frame& F, const Args& a, int l) {
    const float* mod = (const float*)(F.ws + WS_MOD); bf16_t* H = (bf16_t*)(F.ws + WS_H); const bf16_t* Y = (const bf16_t*)(F.ws + WS_R2);
#if XBF16
    bf16_t* X = (bf16_t*)(F.ws + WS_X);
#else
    float* X = (float*)(F.ws + WS_X);
#endif
    const unsigned* TI = (const unsigned*)(F.ws + WS_TI); const float* TG = (const float*)(F.ws + WS_TG);
    const LAS unsigned* tab = (const LAS unsigned*)(F.lds + LDS_TAB);
    const int gw = F.vcu * 8 + F.wave, NGW = F.G * 8; const int nrow = l == 0 ? TA : TX; const bool lastl = l == 1;
    const int c0 = 8 * F.lane;
    for (int r0 = gw * 2; r0 < nrow; r0 += NGW * 2) {
        const int ms = r0 < TX ? (r0 >> 13) : 8;
        u32x4 ti[2]; f32x4 tg[2];
#pragma unroll
        for (int q = 0; q < 2; ++q) { ti[q] = *(const u32x4*)(TI + (size_t)(r0 + q) * 4); tg[q] = *(const f32x4*)(TG + (size_t)(r0 + q) * 4); }
        f32x4 xv[2][4];
#pragma unroll
        for (int q = 0; q < 2; ++q)
#pragma unroll
#if XBF16
            for (int j = 0; j < 2; ++j) { const u32x4 xw = *(const u32x4*)(X + (size_t)(r0 + q) * 1024 + 512 * j + c0); unpack8(xw, xv[q][2 * j], xv[q][2 * j + 1]); }
#else
            for (int j = 0; j < 4; ++j) xv[q][j] = *(const f32x4*)(X + (size_t)(r0 + q) * 1024 + 512 * (j >> 1) + c0 + 4 * (j & 1));
#endif
        u32x4 yv[2][4][2];
#pragma unroll
        for (int q = 0; q < 2; ++q)
#pragma unroll
            for (int k = 0; k < 4; ++k) { const unsigned info = ti[q][k]; const size_t pos = (size_t)tab[32 + (info >> 20)] * 256 + (info & 0xfffffu);
                yv[q][k][0] = __builtin_nontemporal_load((const u32x4*)(Y + pos * 1024 + c0)); yv[q][k][1] = __builtin_nontemporal_load((const u32x4*)(Y + pos * 1024 + 512 + c0)); }
        const float* g2 = mod + (size_t)(l * 9 + ms) * 6144 + 5 * 1024;
        f32x4 gv[4];
#pragma unroll
        for (int j = 0; j < 4; ++j) gv[j] = *(const f32x4*)(g2 + 512 * (j >> 1) + c0 + 4 * (j & 1));
        float ss[2];
#pragma unroll
        for (int q = 0; q < 2; ++q) {
            f32x4 f[4];
#pragma unroll
            for (int j = 0; j < 4; ++j) f[j] = (f32x4){0.f, 0.f, 0.f, 0.f};
#pragma unroll
            for (int k = 0; k < 4; ++k) { const float gk = tg[q][k]; f32x4 a0, a1, b0, b1; unpack8(yv[q][k][0], a0, a1); unpack8(yv[q][k][1], b0, b1);
                f[0] += a0 * gk; f[1] += a1 * gk; f[2] += b0 * gk; f[3] += b1 * gk; }
            float s_ = 0.f;
#pragma unroll
            for (int j = 0; j < 4; ++j) { xv[q][j] += gv[j] * f[j]; s_ += (xv[q][j][0] * xv[q][j][0] + xv[q][j][1] * xv[q][j][1]) + (xv[q][j][2] * xv[q][j][2] + xv[q][j][3] * xv[q][j][3]); }
            ss[q] = s_;
        }
#pragma unroll
        for (int o = 1; o < 64; o <<= 1) { ss[0] += __shfl_xor(ss[0], o); ss[1] += __shfl_xor(ss[1], o); }
        if (!lastl) {
            const float* mp = mod + (size_t)(9 + ms) * 6144; const float* n1g = a.in[6] + 1024;
            f32x4 pg[4], psh[4], psc[4];
#pragma unroll
            for (int j = 0; j < 4; ++j) { const int c = 512 * (j >> 1) + c0 + 4 * (j & 1); pg[j] = *(const f32x4*)(n1g + c); psh[j] = *(const f32x4*)(mp + c); psc[j] = *(const f32x4*)(mp + 1024 + c); }
#pragma unroll
            for (int q = 0; q < 2; ++q) { const float rstd = 1.0f / sqrtf(ss[q] * (1.0f / 1024.0f) + EPS);
                f32x4 h[4];
#if XBF16
                *(u32x4*)(X + (size_t)(r0 + q) * 1024 + c0) = pack8(xv[q][0], xv[q][1]); *(u32x4*)(X + (size_t)(r0 + q) * 1024 + 512 + c0) = pack8(xv[q][2], xv[q][3]);
#pragma unroll
                for (int j = 0; j < 4; ++j) h[j] = (xv[q][j] * rstd * pg[j]) * (psc[j] + 1.0f) + psh[j];
#else
#pragma unroll
                for (int j = 0; j < 4; ++j) { *(f32x4*)(X + (size_t)(r0 + q) * 1024 + 512 * (j >> 1) + c0 + 4 * (j & 1)) = xv[q][j]; h[j] = (xv[q][j] * rstd * pg[j]) * (psc[j] + 1.0f) + psh[j]; }
#endif
                *(u32x4*)(H + (size_t)(r0 + q) * 1024 + c0) = pack8(h[0], h[1]); *(u32x4*)(H + (size_t)(r0 + q) * 1024 + 512 + c0) = pack8(h[2], h[3]); }
        } else {
            f32x4 fg[4];
#pragma unroll
            for (int j = 0; j < 4; ++j) fg[j] = *(const f32x4*)(a.in[27] + 512 * (j >> 1) + c0 + 4 * (j & 1));
#pragma unroll
            for (int q = 0; q < 2; ++q) { const float rstd = 1.0f / sqrtf(ss[q] * (1.0f / 1024.0f) + EPS);
#pragma unroll
                for (int j = 0; j < 4; ++j) *(f32x4*)(a.out + (size_t)(r0 + q) * 1024 + 512 * (j >> 1) + c0 + 4 * (j & 1)) = xv[q][j] * rstd * fg[j]; }
        }
    }
}

__device__ __forceinline__ void znarrow_k512(Frame& F, int tid, f32x4 (&acc)[4], const bf16_t* Arow, const bf16_t* B0, int ldb) {
    const int lane = tid & 63, l15 = lane & 15, kg = lane >> 4;
    u32x4 areg[16];
#pragma unroll
    for (int ks = 0; ks < 16; ++ks) areg[ks] = *(const u32x4*)(Arow + ks * 32);
    u32x4 breg[8];
#pragma unroll
    for (int i = 0; i < 8; ++i) { const int idx = i * 512 + tid, row = idx >> 6, c = idx & 63; breg[i] = *(const u32x4*)(B0 + (size_t)((row >> 5) * 128 + (row & 31)) * ldb + c * 8); }
    __syncthreads();
#pragma unroll
    for (int i = 0; i < 8; ++i) { const int idx = i * 512 + tid, row = idx >> 6, c = idx & 63; *(LAS u32x4*)(F.lds + row * 1024 + ((c ^ (row & 15)) * 16)) = breg[i]; }
    __syncthreads();
#pragma unroll
    for (int ks = 0; ks < 16; ++ks)
#pragma unroll
        for (int t = 0; t < 4; ++t) { const bf16x8 b = *(const LAS bf16x8*)(F.lds + (16 * t + l15) * 1024 + (((ks * 4 + kg) ^ l15) * 16));
            acc[t] = __builtin_amdgcn_mfma_f32_16x16x32_bf16(__builtin_bit_cast(bf16x8, areg[ks]), b, acc[t], 0, 0, 0); }
}
__device__ __forceinline__ void z_branch_unit(Frame& F, const unsigned char* r1, unsigned char* r2, const unsigned char* wl) {
    int tid = F.tid; asm volatile("" : "+v"(tid));
    const int v = F.vcu, rb = v >> 4, cg = v & 15, pn = cg >> 2, wc = cg & 3, lane = tid & 63, l15 = lane & 15, kg = lane >> 4;
    const int r0 = TX + rb * 128 + F.wave * 16;
    f32x4 acc[3][4];
#pragma unroll
    for (int br = 0; br < 3; ++br)
#pragma unroll
        for (int t = 0; t < 4; ++t) acc[br][t] = (f32x4){0.f, 0.f, 0.f, 0.f};
#pragma unroll
    for (int br = 0; br < 3; ++br)
        znarrow_k512(F, tid, acc[br], (const bf16_t*)(r2 + R2_AC + (size_t)br * R2_AT) + (size_t)(r0 + l15) * 512 + kg * 8,
                     (const bf16_t*)(wl + W_CO + (size_t)br * W_P_B) + (size_t)(pn * 256 + wc * 32) * 512, 512);
    const bf16_t* G = (const bf16_t*)(r1 + R1_G); bf16_t* MG = (bf16_t*)(r2 + R2_MG);
    bf16_t gq[4][4][3];
#pragma unroll
    for (int t = 0; t < 4; ++t)
#pragma unroll
        for (int r = 0; r < 4; ++r) { const bf16_t* gp = G + (size_t)(r0 + 4 * kg + r) * 3072 + pn * 256 + 64 * wc + 16 * t + l15; gq[t][r][0] = gp[0]; gq[t][r][1] = gp[1024]; gq[t][r][2] = gp[2048]; }
#pragma unroll
    for (int t = 0; t < 4; ++t)
#pragma unroll
        for (int r = 0; r < 4; ++r) { const int row = r0 + 4 * kg + r, sc = pn * 256 + 64 * wc + 16 * t + l15;
            const float g0 = bflo(gq[t][r][0]), g1 = bflo(gq[t][r][1]), g2 = bflo(gq[t][r][2]);
            MG[(size_t)row * 1024 + sc] = (bf16_t)f2bf(g0 * acc[0][t][r] + g1 * acc[1][t][r] + g2 * acc[2][t][r]); }
}
__device__ __forceinline__ void z_wout_unit(Frame& F, const Args& args, unsigned char* r2, const unsigned char* wl, const float* modl) {
    int tid = F.tid; asm volatile("" : "+v"(tid));
    const int v = F.vcu, rb = v >> 4, cg = v & 15, pn = cg >> 2, wc = cg & 3, lane = tid & 63, l15 = lane & 15, kg = lane >> 4;
    const int r0 = TX + rb * 128 + F.wave * 16;
    f32x4 acc[4];
#pragma unroll
    for (int t = 0; t < 4; ++t) acc[t] = (f32x4){0.f, 0.f, 0.f, 0.f};
#pragma unroll
    for (int kh = 0; kh < 2; ++kh)
        znarrow_k512(F, tid, acc, (const bf16_t*)(r2 + R2_MG) + (size_t)(r0 + l15) * 1024 + kh * 512 + kg * 8,
                     (const bf16_t*)(wl + W_OUT) + (size_t)(pn * 256 + wc * 32) * 1024 + kh * 512, 1024);
    bf16_t* X = (bf16_t*)(F.ws + WS_X); float* SS = (float*)(F.ws + WS_SS); const float* gvp = modl + (size_t)8 * 6144 + 2 * 1024;
    float sq[4] = {0.f, 0.f, 0.f, 0.f};
#pragma unroll
    for (int t = 0; t < 4; ++t) { const int sc = pn * 256 + 64 * wc + 16 * t + l15; const float gv = gvp[sc];
#pragma unroll
        for (int r = 0; r < 4; ++r) { const int row = r0 + 4 * kg + r;
            const unsigned w = f2bf(args.in[2][(size_t)(row - TX) * 1024 + sc] + gv * acc[t][r]); const float vr = bflo(w);
            X[(size_t)row * 1024 + sc] = (bf16_t)w; sq[r] += vr * vr; } }
#pragma unroll
    for (int r = 0; r < 4; ++r) { float s_ = sq[r]; s_ += __shfl_xor(s_, 1); s_ += __shfl_xor(s_, 2); s_ += __shfl_xor(s_, 4); s_ += __shfl_xor(s_, 8);
        if (l15 == 0) SS[(size_t)(r0 + 4 * kg + r) * 16 + pn * 4 + wc] = s_; }
}

__device__ __forceinline__ void z_kv_unit(Frame& F, int u, unsigned char* r1, const unsigned char* wl) {
    int tid = F.tid; asm volatile("" : "+v"(tid));
    const int rb = u >> 2, wc = u & 3, lane = tid & 63, l15 = lane & 15, kg = lane >> 4;
    const int r0 = TX + rb * 128 + F.wave * 16;
    f32x4 acc[4];
#pragma unroll
    for (int t = 0; t < 4; ++t) acc[t] = (f32x4){0.f, 0.f, 0.f, 0.f};
#pragma unroll
    for (int kh = 0; kh < 2; ++kh)
        znarrow_k512(F, tid, acc, (const bf16_t*)(F.ws + WS_H) + (size_t)(r0 + l15) * 1024 + kh * 512 + kg * 8,
                     (const bf16_t*)(wl + W_IN) + (size_t)(6 * 256 + wc * 32) * 1024 + kh * 512, 1024);
    bf16_t* Kd = (bf16_t*)(r1 + R1_K); bf16_t* vt = (bf16_t*)(r1 + R1_VT);
#pragma unroll
    for (int t = 0; t < 4; ++t) { const int bj = t >> 1, i = (t & 1) * 16 + l15;
#pragma unroll
        for (int r = 0; r < 4; ++r) { const int row = r0 + 4 * kg + r; const bf16_t val = (bf16_t)f2bf(acc[t][r]);
            if (wc < 2) Kd[(size_t)row * 128 + wc * 64 + bj * 32 + i] = val;
            else { const int zz = row - TX, b = zz >> 8, cp = zz & 255; vt[(size_t)TX * 128 + ((size_t)((b * 2 + bj) * 64 + (wc - 2) * 32 + i)) * CTXL + perm16(cp)] = val; } } }
}

__global__ void __launch_bounds__(512, 2) mk_fwd(Args args) {
    extern __shared__ __attribute__((aligned(16))) unsigned char lds_raw[];
    Frame F;
    F.lds = (LAS unsigned char*)lds_raw; F.ws = args.ws; F.ctl = (unsigned*)(args.ws + WS_CTL);
    F.tid = threadIdx.x; F.lane = F.tid & 63; F.wave = __builtin_amdgcn_readfirstlane(F.tid >> 6);
    F.G = gridDim.x; { const int bx = blockIdx.x; F.vcu = (F.G % 8 == 0) ? (bx % 8) * (F.G / 8) + bx / 8 : bx; }
    volatile LAS unsigned* MISC = (volatile LAS unsigned*)(F.lds + LDS_MISC);
    if (F.tid < 64) MISC[F.tid] = 0u;
    __syncthreads();
    XcdBarrier bar; bar.bar = (unsigned*)(F.ctl + CW_BAR); bar.x = 0; bar.st = nullptr;
#if !MK_PER_PHASE
    bar = xcd_barrier_post((unsigned*)(F.ctl + CW_BAR), MISC + 8);
#endif
    const int lo = args.ph_lo, hi = args.ph_hi; int bxo = blockIdx.x;
#ifndef PH_MASK
#define PH_MASK 0x3ff
#endif
#ifndef REP_MASK
#define REP_MASK 0
#endif
#define NREP(ty) (((REP_MASK >> (ty)) & 1) ? 2 : 1)
#define INT(k, ty) (((PH_MASK >> (ty)) & 1) && lo <= (k) && (k) < hi)
#define IN(k) (lo <= (k) && (k) < hi)
#define REFRESH() do { int t_; asm volatile("v_mbcnt_lo_u32_b32 %0, -1, 0\n\tv_mbcnt_hi_u32_b32 %0, -1, %0" : "=v"(t_)); t_ |= F.wave << 6; F.tid = t_; F.lane = t_ & 63; int b_ = blockIdx.x; asm volatile("" : "+s"(b_)); bxo = b_; F.vcu = (F.G % 8 == 0) ? (b_ % 8) * (F.G / 8) + b_ / 8 : b_; } while (0)
#ifndef NXBAR
#define NXBAR 1
#endif
#define SEAM(k) do { if (IN((k) + 1)) { for (int q_ = 0; q_ < NXBAR; ++q_) xcd_barrier(bar); } } while (0)

    if (INT(0, 0)) { REFRESH(); for (int rep = 0; rep < NREP(0); ++rep) { p_prologue(F, args); __syncthreads(); } SEAM(0); }
    if (INT(1, 1)) { REFRESH(); for (int rep = 0; rep < NREP(1); ++rep) p_norm0(F, args); SEAM(1); }

    for (int l = 0; l < 2; ++l) {
        const int pb = 2 + l * 8;
        unsigned char* wl = F.ws + WS_W + (size_t)l * W_LAYER;
        unsigned char* r1 = F.ws + WS_R1; unsigned char* r2 = F.ws + WS_R2;
        const float* modl = (const float*)(F.ws + WS_MOD) + (size_t)l * 9 * 6144;
        const int nrt = l == 0 ? NTA : NTX;

        if (INT(pb + 0, 2)) { REFRESH();
            const bool zkv = l == 1 && F.G == 256;
            g8::SchedDense<1024> S{(const char*)(F.ws + WS_H), (const char*)(wl + W_IN), nrt, 21, F.G, bxo, (l == 0 || zkv) ? 0 : NTZ, 6};
            g8::EpiInProj E{(bf16_t*)(r1 + R1_AGLU), (bf16_t*)(r1 + R1_Q), (bf16_t*)(r1 + R1_K), (bf16_t*)(r1 + R1_VT), (bf16_t*)(r1 + R1_U), (bf16_t*)(r1 + R1_G),
                            args.in[8] + l * 3072, (const float*)(F.ws + WS_ROPE)};
#ifdef PROBE_SAME
            g8::gemm_phase<1024>(F.lds, S, E, F.tid); { g8::EpiNull EN; g8::SchedSame SS{(const char*)(F.ws + WS_H), (const char*)(wl + W_IN), 22, bxo}; g8::gemm_phase<1024>(F.lds, SS, EN, F.tid); }
#elif defined(PROBE_NULL_EPI)
            g8::gemm_phase<1024>(F.lds, S, E, F.tid); { g8::EpiNull EN; g8::gemm_phase<1024>(F.lds, S, EN, F.tid); }
#else
            for (int rep = 0; rep < NREP(2); ++rep) g8::gemm_phase<1024>(F.lds, S, E, F.tid);
#endif
            if (zkv && bxo < 64) z_kv_unit(F, bxo, r1, wl);
            SEAM(pb + 0);
        }
        if (INT(pb + 1, 3)) { REFRESH();
            const bf16_t* Q = (const bf16_t*)(r1 + R1_Q); const bf16_t* Kb = (const bf16_t*)(r1 + R1_K); const bf16_t* VT = (const bf16_t*)(r1 + R1_VT);
            bf16_t* AT = (bf16_t*)(r2 + R2_AT); const float* sink = args.in[14] + l * 8;
            __syncthreads();
#if !defined(MIX_SUB) || (MIX_SUB & 1)
            for (int rep = 0; rep < NREP(10); ++rep) {
                const int nu = l == 0 ? 1056 : 1024;
                for (int i = 0; ; ++i) {
                    int id;
                    if (F.G == 256) { if (i < 4) id = F.vcu * 4 + i; else if (i == 4 && F.vcu < 32) id = 1024 + F.vcu; else break; }
                    else id = F.vcu + i * F.G;
                    if (id >= nu) break;
                    if (id < 1024) attn_unit(F, Q, Kb, VT, AT, sink, false, id >> 7, (id & 127) >> 1, id & 1);
                    else { const int zz = id - 1024; attn_unit(F, Q, Kb, VT, AT, sink, true, zz >> 2, (zz >> 1) & 1, zz & 1); }
                }
            }
#endif
            REFRESH();
            __syncthreads();
            LAS float* wlds = (LAS float*)F.lds;
            { float tv[31];
#pragma unroll
              for (int j = 0; j < 31; ++j) tv[j] = args.in[9][(size_t)l * 31 * 512 + j * 512 + F.tid];
#pragma unroll
              for (int k = 0; k < 48; ++k) wlds[k * 512 + F.tid] = (k >= 8 && k <= 38) ? tv[(k >= 8 && k <= 38) ? k - 8 : 0] : 0.f; }
            __syncthreads();
            const int ntask = (l == 0 ? TA : TX) / 8; const int gw = F.vcu * 8 + F.wave, NGW = F.G * 8;
#if !defined(MIX_SUB) || (MIX_SUB & 2)
            const bool zconv1 = l == 0 && F.G == 256;
            const int ntaskc = zconv1 ? TX / 8 : ntask;
            for (int rep = 0; rep < NREP(11); ++rep) { for (int i_ = 0, tk = gw; tk < ntaskc; ++i_, tk = (i_ + 1) * NGW <= ntaskc ? gw + i_ * NGW : i_ * NGW + (NGW - 1 - gw))
                conv_task(F, tk, (const bf16_t*)(r1 + R1_AGLU), (bf16_t*)(r2 + R2_AC), wlds, args.in[10] + l * 512, args.in[11] + l * 512, args.in[12] + l * 512);
              if (zconv1 && F.vcu >= 32) for (int zt = gw - 256; zt < TZ; zt += NGW - 256)
                conv_task1(F, TX + zt, (const bf16_t*)(r1 + R1_AGLU), (bf16_t*)(r2 + R2_AC), wlds, args.in[10] + l * 512, args.in[11] + l * 512, args.in[12] + l * 512); }
#endif
#if !defined(MIX_SUB) || (MIX_SUB & 4)
            for (int rep = 0; rep < NREP(12); ++rep) for (int i_ = 0, tk = gw; tk < ntask; ++i_, tk = (i_ + 1) * NGW <= ntask ? gw + i_ * NGW : i_ * NGW + (NGW - 1 - gw)) pool_task(F, tk, (const bf16_t*)(r1 + R1_U), (bf16_t*)(r2 + R2_PL));
#endif
            SEAM(pb + 1);
        }
        if (INT(pb + 2, 4)) { REFRESH();
            const bool znarrow = XBF16 && l == 0 && F.G == 256;
            g8::SchedBranch S{(const char*)(r2 + R2_AC), (const char*)(wl + W_CO), R2_AT, W_P_B, znarrow ? NTX : nrt, F.G, bxo};
            g8::EpiBranch E{(const bf16_t*)(r1 + R1_G), (bf16_t*)(r2 + R2_MG)};
            for (int rep = 0; rep < NREP(4); ++rep) g8::gemm_phase<512>(F.lds, S, E, F.tid);
            if (znarrow) z_branch_unit(F, r1, r2, wl);
            SEAM(pb + 2);
        }
        if (INT(pb + 3, 5)) { REFRESH();
            const bool znarrow = XBF16 && l == 0 && F.G == 256;
            g8::SchedDense<1024> S{(const char*)(r2 + R2_MG), (const char*)(wl + W_OUT), znarrow ? NTX : nrt, 4, F.G, bxo, 0, 0};
            #if XBF16
            g8::EpiWout E{args.in[0], args.in[2], (bf16_t*)(F.ws + WS_X), modl, (float*)(F.ws + WS_SS), l == 0 ? 1 : 0};
#else
            g8::EpiWout E{args.in[0], args.in[2], (float*)(F.ws + WS_X), modl, (float*)(F.ws + WS_SS), l == 0 ? 1 : 0};
#endif
            for (int rep = 0; rep < (l == 0 ? NREP(5) : 1); ++rep) g8::gemm_phase<1024>(F.lds, S, E, F.tid);
#if XBF16
            if (znarrow) z_wout_unit(F, args, r2, wl, modl);
#endif
            SEAM(pb + 3);
        }
        if (INT(pb + 4, 6)) { REFRESH(); __syncthreads(); p_route(F, args, l, 0); if (NREP(6) == 2) { __syncthreads(); p_route(F, args, l, 1); } SEAM(pb + 4); }
        if (INT(pb + 5, 7)) { REFRESH();
            moe_tables(F, l);
            g8::SchedMoE<true> S{(const char*)(F.ws + WS_H), (const char*)(wl + W_GU), W_GU_E, (const unsigned*)(F.ws + WS_LIST), (const LAS unsigned*)(F.lds + LDS_TAB), 8, F.G, bxo};
            g8::EpiGU E{(bf16_t*)r1, args.in[24] + (size_t)l * 32 * 2048};
#ifdef PROBE_NULL_GU
            g8::gemm_phase<1024>(F.lds, S, E, F.tid); { g8::EpiNull EN; g8::gemm_phase<1024>(F.lds, S, EN, F.tid); }
#else
            for (int rep = 0; rep < NREP(7); ++rep) g8::gemm_phase<1024>(F.lds, S, E, F.tid);
#endif
            SEAM(pb + 5);
        }
        if (INT(pb + 6, 8)) { REFRESH();
            if (!INT(pb + 5, 7)) moe_tables(F, l);
            g8::SchedMoE<false> S{(const char*)r1, (const char*)(wl + W_DN), W_DN_E, nullptr, (const LAS unsigned*)(F.lds + LDS_TAB), 4, F.G, bxo};
            g8::EpiDown E{(bf16_t*)r2, args.in[26] + (size_t)l * 32 * 1024};
#ifdef PROBE_NULL_DOWN
            g8::gemm_phase<1024>(F.lds, S, E, F.tid); { g8::EpiNull EN; g8::gemm_phase<1024>(F.lds, S, EN, F.tid); }
#else
            for (int rep = 0; rep < NREP(8); ++rep) g8::gemm_phase<1024>(F.lds, S, E, F.tid);
#endif
            SEAM(pb + 6);
        }
        if (INT(pb + 7, 9)) { REFRESH(); if (!INT(pb + 5, 7)) moe_tables(F, l); p_comb(F, args, l); if (NREP(9) == 2 && l == 1) p_comb(F, args, l); SEAM(pb + 7); }
    }
#undef IN
#undef INT
#undef SEAM
}

extern "C" void kernel_launch(void* const* d_in, const int* in_sizes, int n_in, void* d_out, int out_size, void* d_ws, size_t ws_size, hipStream_t stream) {
    static int grid = 0;
    if (grid == 0) {
        if (n_in != 28 || out_size != TX * D || ws_size < WS_END) { fprintf(stderr, "kernel_launch: unexpected shapes (n_in %d out %d ws %zu need %zu)\n", n_in, out_size, ws_size, (size_t)WS_END); grid = -1; return; }
        int dev = 0, cus = 0, per_cu = 0;
        if (hipGetDevice(&dev) != hipSuccess || hipDeviceGetAttribute(&cus, hipDeviceAttributeMultiprocessorCount, dev) != hipSuccess) { grid = -1; return; }
        if (hipFuncSetAttribute((const void*)mk_fwd, hipFuncAttributeMaxDynamicSharedMemorySize, LDS_BYTES) != hipSuccess) { fprintf(stderr, "kernel_launch: hipFuncSetAttribute failed\n"); grid = -1; return; }
        if (hipOccupancyMaxActiveBlocksPerMultiprocessor(&per_cu, (const void*)mk_fwd, 512, LDS_BYTES) != hipSuccess || per_cu < 1) { fprintf(stderr, "kernel_launch: occupancy query says %d\n", per_cu); }
        (void)hipGetLastError();
        grid = cus;
    }
    if (grid < 0) return;
    (void)in_sizes;
    (void)hipMemsetAsync((char*)d_ws + WS_CTL, 0, CTL_ZERO, stream);
    Args a{};
    for (int i = 0; i < 28; ++i) a.in[i] = (const float*)d_in[i];
    a.out = (float*)d_out; a.ws = (unsigned char*)d_ws;
#if MK_PER_PHASE
    for (int p = 0; p < NPH; ++p) { a.ph_lo = p; a.ph_hi = p + 1; hipLaunchKernelGGL(mk_fwd, dim3(grid), dim3(512), LDS_BYTES, stream, a); }
#else
    a.ph_lo = 0; a.ph_hi = NPH; hipLaunchKernelGGL(mk_fwd, dim3(grid), dim3(512), LDS_BYTES, stream, a);
#endif
}
```

```cpp
#include <hip/hip_runtime.h>
#include <cstdio>
#include <cstdint>

#ifndef GEMM_STAGGER
#define GEMM_STAGGER 0
#endif
#ifndef XBF16
#define XBF16 1
#endif
#ifndef PG8_ALIGN_EPI
#define PG8_ALIGN_EPI 1
#endif
#ifndef MK_PER_PHASE
#define MK_PER_PHASE 0
#endif

#define GAS __attribute__((address_space(1)))
#define LAS __attribute__((address_space(3)))
typedef unsigned short bf16_t;
typedef short bf16x8 __attribute__((ext_vector_type(8)));
typedef float f32x2 __attribute__((ext_vector_type(2)));
typedef float f32x4 __attribute__((ext_vector_type(4)));
typedef float f32x16 __attribute__((ext_vector_type(16)));
typedef unsigned u32x2 __attribute__((ext_vector_type(2)));
typedef unsigned u32x4 __attribute__((ext_vector_type(4)));
typedef __bf16 bf16x2_t __attribute__((ext_vector_type(2)));

constexpr int D = 1024, NB = 8, SEQ = 8192, CTXL = 256;
constexpr int TX = NB * SEQ, TZ = NB * CTXL, TA = TX + TZ;
constexpr int NTX = TX / 256, NTZ = TZ / 256, NTA = TA / 256;
constexpr int DIN = 5376, NE = 32;
constexpr int NPH = 18;
constexpr float EPS = 1e-6f;
constexpr float LOG2E = 1.4426950408889634f;

constexpr size_t al256(size_t x) { return (x + 255) & ~(size_t)255; }
constexpr size_t WS_CTL = 0, CTL_BYTES = 1u << 20, CTL_ZERO = 128u << 10;
constexpr size_t WS_MOD = WS_CTL + CTL_BYTES, MOD_BYTES = al256((size_t)2 * 9 * 6144 * 4);
constexpr size_t WS_ROPE = WS_MOD + MOD_BYTES, ROPE_BYTES = (size_t)2 * 8192 * 32 * 4;
constexpr size_t WS_W = WS_ROPE + ROPE_BYTES;
constexpr size_t W_IN = 0, W_IN_B = (size_t)DIN * 1024 * 2;
constexpr size_t W_CO = W_IN + W_IN_B, W_P_B = (size_t)1024 * 512 * 2;
constexpr size_t W_AO = W_CO + W_P_B;
constexpr size_t W_PE = W_AO + W_P_B;
constexpr size_t W_OUT = W_PE + W_P_B, W_OUT_B = (size_t)1024 * 1024 * 2;
constexpr size_t W_GU = W_OUT + W_OUT_B, W_GU_E = (size_t)2048 * 1024 * 2, W_GU_B = 32 * W_GU_E;
constexpr size_t W_DN = W_GU + W_GU_B, W_DN_E = (size_t)1024 * 1024 * 2, W_DN_B = 32 * W_DN_E;
constexpr size_t W_LAYER = W_DN + W_DN_B;
constexpr size_t WS_H = WS_W + 2 * W_LAYER;
constexpr size_t H_BYTES = (size_t)TA * 1024 * 2;
constexpr size_t WS_R1 = WS_H + H_BYTES;
constexpr size_t R1_AGLU = 0, R1_Q = R1_AGLU + (size_t)TA * 512 * 2, R1_K = R1_Q + (size_t)TA * 512 * 2, R1_VT = R1_K + (size_t)TA * 128 * 2,
                 R1_U = R1_VT + (size_t)TA * 128 * 2, R1_G = R1_U + (size_t)TA * 512 * 2, R1_BYTES = R1_G + (size_t)TA * 3072 * 2;
constexpr int PMAX = TA * 4 + 32 * 256;
constexpr size_t ACT_BYTES = (size_t)PMAX * 1024 * 2;
static_assert(ACT_BYTES <= R1_BYTES, "ACT must fit R1");
constexpr size_t WS_R2 = WS_R1 + R1_BYTES;
constexpr size_t R2_AC = 0, R2_AT = (size_t)TA * 512 * 2, R2_PL = 2 * R2_AT, R2_MG = 3 * R2_AT, R2_BYTES = ACT_BYTES;
static_assert(R2_MG + (size_t)TA * 1024 * 2 <= R2_BYTES, "R2");
constexpr size_t WS_X = WS_R2 + R2_BYTES;
constexpr size_t X_BYTES = (size_t)TA * 1024 * 4;
constexpr size_t WS_TI = WS_X + X_BYTES;
constexpr size_t WS_TG = WS_TI + (size_t)TA * 16;
constexpr size_t WS_LIST = WS_TG + (size_t)TA * 16;
constexpr size_t WS_SS = WS_LIST + (size_t)32 * TA * 4;
constexpr size_t WS_END = WS_SS + (size_t)TA * 16 * 4;
constexpr int CW_TMO = 0, CW_BAR = 4096, CW_CNT = 16384;

constexpr int LDS_BYTES = 163840;
constexpr int LDS_MISC = 163840 - 256;
constexpr int LDS_TAB = 131072;

__device__ __forceinline__ unsigned f2bf(float f) { unsigned u = __builtin_bit_cast(unsigned, f); return (u + 0x7fffu + ((u >> 16) & 1u)) >> 16; }
__device__ __forceinline__ unsigned pk2(float lo, float hi) { f32x2 v = {lo, hi}; bf16x2_t b = __builtin_convertvector(v, bf16x2_t); return __builtin_bit_cast(unsigned, b); }
__device__ __forceinline__ float bflo(unsigned u) { return __builtin_bit_cast(float, u << 16); }
__device__ __forceinline__ float bfhi(unsigned u) { return __builtin_bit_cast(float, u & 0xffff0000u); }
__device__ __forceinline__ float wave_sum(float v) {
#pragma unroll
    for (int o = 1; o < 64; o <<= 1) v += __shfl_xor(v, o);
    return v;
}
__device__ __forceinline__ float sigmoidf_(float x) { return __builtin_amdgcn_rcpf(1.0f + __builtin_amdgcn_exp2f(-x * LOG2E)); }
__device__ __forceinline__ u32x4 pack8(const f32x4& a, const f32x4& b) { u32x4 w; w.x = pk2(a[0], a[1]); w.y = pk2(a[2], a[3]); w.z = pk2(b[0], b[1]); w.w = pk2(b[2], b[3]); return w; }
__device__ __forceinline__ void unpack8(const u32x4& w, f32x4& a, f32x4& b) { a = (f32x4){bflo(w.x), bfhi(w.x), bflo(w.y), bfhi(w.y)}; b = (f32x4){bflo(w.z), bfhi(w.z), bflo(w.w), bfhi(w.w)}; }
__device__ __forceinline__ int perm16(int s) { return (s & ~12) | ((s & 4) << 1) | ((s & 8) >> 1); }

#define XB_TMO      128
#define XB_XCNT(j)  (256  + 64 * (j))
#define XB_XSUB(j)  (1280 + 64 * (j))
#define XB_XGEN(j)  (2304 + 64 * (j))
#define XB_TOP      3328
#define XB_TOPGEN   3392
#define XCD_BAR_WORDS 3456
#define XB_SPIN_CAP (1u << 18)
__device__ __forceinline__ unsigned xb_ld(unsigned* p)              { return __hip_atomic_load(p, __ATOMIC_RELAXED, __HIP_MEMORY_SCOPE_AGENT); }
__device__ __forceinline__ unsigned xb_add(unsigned* p, unsigned v) { return __hip_atomic_fetch_add(p, v, __ATOMIC_RELAXED, __HIP_MEMORY_SCOPE_AGENT); }
__device__ __forceinline__ unsigned xb_xcc_id() { return (unsigned)__builtin_amdgcn_s_getreg((3 << 11) | 20) & 0xFu; }
#define XB_SPIN(cond, bar) do { unsigned _sp = 0; while (cond) { __builtin_amdgcn_s_sleep(1); \
    if ((++_sp & 255u) == 0u) { if (xb_ld(&(bar)[XB_TMO])) break; if (_sp > XB_SPIN_CAP) { atomicAdd(&(bar)[XB_TMO], 1u); break; } } } } while (0)
struct XcdBarrier { unsigned* bar; unsigned x; volatile LAS unsigned* st; };
__device__ __forceinline__ XcdBarrier xcd_barrier_post(unsigned* bar, volatile LAS unsigned* st) {
    XcdBarrier b; b.bar = bar; b.x = xb_xcc_id(); b.st = st;
    if (threadIdx.x == 0) (void)xb_add(&bar[XB_XCNT(b.x)], 1u);
    return b;
}
__device__ __forceinline__ void xcd_barrier_complete(unsigned* bar, unsigned x, unsigned& nloc, unsigned& nx) {
    const unsigned G = gridDim.x * gridDim.y * gridDim.z;
    unsigned sum, cnt, mine, sp = 0u;
    for (;;) {
        sum = 0u; cnt = 0u; mine = 0u;
#pragma unroll
        for (unsigned j = 0; j < 16; ++j) { const unsigned c = xb_ld(&bar[XB_XCNT(j)]); sum += c; cnt += (c > 0u) ? 1u : 0u; mine = (j == x) ? c : mine; }
        if (sum == G) break;
        __builtin_amdgcn_s_sleep(1);
        if ((++sp & 255u) == 0u) { if (xb_ld(&bar[XB_TMO])) break; if (sp > XB_SPIN_CAP) { atomicAdd(&bar[XB_TMO], 1u); break; } }
    }
    nloc = mine > 0u ? mine : 1u; nx = cnt > 0u ? cnt : 1u;
}
__device__ __forceinline__ void xcd_barrier(const XcdBarrier& b) {
    asm volatile("s_waitcnt vmcnt(0)" ::: "memory");
    __syncthreads();
    if (threadIdx.x == 0) {
        unsigned* bar = b.bar;
        __builtin_amdgcn_s_waitcnt(0);
        unsigned nloc = b.st[0], nx = b.st[1];
        if (nloc == 0u) { xcd_barrier_complete(bar, b.x, nloc, nx); b.st[0] = nloc; b.st[1] = nx; }
        const unsigned old = xb_add(&bar[XB_XSUB(b.x)], 1u);
        const unsigned gen = old / nloc;
        if (old + 1u == (gen + 1u) * nloc) {
            __builtin_amdgcn_fence(__ATOMIC_RELEASE, "agent");
            asm volatile("s_waitcnt vmcnt(0)" ::: "memory");
            const unsigned og = xb_add(&bar[XB_TOP], 1u);
            const unsigned tg = og / nx;
            if (og + 1u == (tg + 1u) * nx) xb_add(&bar[XB_TOPGEN], 1u);
            else XB_SPIN(xb_ld(&bar[XB_TOPGEN]) == tg, bar);
            __builtin_amdgcn_fence(__ATOMIC_ACQUIRE, "agent");
            xb_add(&bar[XB_XGEN(b.x)], 1u);
            asm volatile("s_waitcnt vmcnt(0)" ::: "memory");
        } else {
            XB_SPIN(xb_ld(&bar[XB_XGEN(b.x)]) == gen, bar);
            __builtin_amdgcn_fence(__ATOMIC_ACQUIRE, "agent");
            asm volatile("s_waitcnt vmcnt(0)" ::: "memory");
        }
    }
    __syncthreads();
}

namespace g8 {
constexpr int BM = 256, BK = 64, HALF = 128, HTB = HALF * BK * 2, STAGE_BYTES = 8 * HTB, NXCD = 8, WGM = 8;
__device__ __forceinline__ int lds_byte(int r, int c) { const int st = (r >> 4) * 2 + (c >> 5), rr = r & 15, cc = c & 31, ob = rr * 64 + cc * 2; return st * 1024 + (ob ^ (((ob >> 9) & 1) << 5)); }
__device__ __forceinline__ void stage_rc(int b, int& R, int& C) { const int st = b / 1024, sb = b % 1024, swz = sb ^ (((sb >> 9) & 1) << 5); R = (st >> 1) * 16 + swz / 64; C = (st & 1) * 32 + (swz % 64) / 2; }
__device__ __forceinline__ int perm32(int rho) { const int n = rho >> 4, i = rho & 15; return 8 * (i >> 2) + 4 * n + (i & 3); }

struct GUnit { const char* A; const char* B; int pm, pn, aux; };

__device__ __forceinline__ bool tile_map(int L, int nM, int nN, int& pm, int& pn) {
    const int nwg = nM * nN; if (L >= nwg) return false;
    int wgid = L; { const int q = nwg / NXCD, r = nwg % NXCD, xcd = wgid % NXCD, off = wgid / NXCD; wgid = (xcd < r ? xcd * (q + 1) : r * (q + 1) + (xcd - r) * q) + off; }
    const int nig = WGM * nN, gid = wgid / nig, fm = gid * WGM, gsz = (nM - fm) < WGM ? (nM - fm) : WGM;
    pm = fm + ((wgid % nig) % gsz); pn = (wgid % nig) / gsz; return true;
}

template <int K, class Epi, class Sched>
__device__ __forceinline__ void gemm_phase(LAS unsigned char* lds, const Sched& S, const Epi& E, const int tid) {
    const int wid = __builtin_amdgcn_readfirstlane(tid >> 6), lane = tid & 63, wr = wid >> 2, wc = wid & 3, fr = lane & 15, fq = lane >> 4;
    constexpr int nt = K / BK;
    unsigned voffB[2]; int sR[2], sC[2];
#pragma unroll
    for (int i = 0; i < 2; ++i) { int R, C; stage_rc(tid * 16 + i * 8192, R, C); const int Rb = Epi::PERM ? ((R & ~31) + perm32(R & 31)) : R;
        voffB[i] = (unsigned)(Rb * K + C) * 2u; sR[i] = R; sC[i] = C; }
    constexpr size_t kstep = (size_t)(BK * 2);
    constexpr size_t hstep = (size_t)HALF * K * 2;
    const unsigned ldsw = (unsigned)wid * 1024u;
    const int aoff = lds_byte(wr * 64 + fr, fq * 8), boff = lds_byte(wc * 32 + fr, fq * 8);
#define PG8_SA(b, h) (((b) * 2 + (h)) * HTB)
#define PG8_SB(b, h) ((4 + (b) * 2 + (h)) * HTB)
#define PG8_STAGE(bufoff, gbase, voff) do { _Pragma("unroll") for (int _i = 0; _i < 2; ++_i) \
        __builtin_amdgcn_global_load_lds((const unsigned*)((const char*)(gbase) + (voff)[_i]), (LAS unsigned*)(lds + (bufoff) + ldsw + _i * 8192), 16, 0, 0); } while (0)
#define PG8_LDA(dst, b, h) do { _Pragma("unroll") for (int m = 0; m < 4; ++m) _Pragma("unroll") for (int k = 0; k < 2; ++k) dst[m][k] = *(const LAS bf16x8*)(lds + PG8_SA(b, h) + aoff + m * 2048 + k * 1024); } while (0)
#define PG8_LDB(dst, b, h) do { _Pragma("unroll") for (int n = 0; n < 2; ++n) _Pragma("unroll") for (int k = 0; k < 2; ++k) dst[n][k] = *(const LAS bf16x8*)(lds + PG8_SB(b, h) + boff + n * 2048 + k * 1024); } while (0)
#define PG8_MMA(ai, bj, At, Bt) do { __builtin_amdgcn_s_setprio(1); _Pragma("unroll") for (int m = 0; m < 4; ++m) _Pragma("unroll") for (int n = 0; n < 2; ++n) _Pragma("unroll") for (int k = 0; k < 2; ++k) \
        acc[ai][bj][m][n] = __builtin_amdgcn_mfma_f32_16x16x32_bf16(Bt[n][k], At[m][k], acc[ai][bj][m][n], 0, 0, 0); __builtin_amdgcn_s_setprio(0); } while (0)
#define PG8_WAIT_V(n) asm volatile("s_waitcnt vmcnt(" #n ")" ::: "memory")
#define PG8_WAIT_L(n) asm volatile("s_waitcnt lgkmcnt(" #n ")" ::: "memory")
#define PG8_BAR __builtin_amdgcn_s_barrier()
#define PG8_SCHED __builtin_amdgcn_sched_barrier(0)
    GUnit cur, nxt; int ui = 0;
    if (!S.next(0, cur)) return;
#if defined(GEMM_STAGGER) && GEMM_STAGGER > 0
    {
        const unsigned grp = ((unsigned)blockIdx.x >> 3) & 3u; const unsigned long long t0 = __builtin_amdgcn_s_memrealtime();
        while (__builtin_amdgcn_s_memrealtime() - t0 < (unsigned long long)(grp * GEMM_STAGGER)) __builtin_amdgcn_s_sleep(8);
    }
#endif
    f32x4 acc[2][2][4][2];
    E.init(acc, cur, wr, wc, fr, fq);
    bf16x8 At[4][2], B0[2][2], B1[2][2];
    unsigned ca0[2], ca1[2], na0[2], na1[2];
    S.aoff(cur, sR, sC, ca0, ca1);
    const char* cA = cur.A; const char* cB = cur.B;
    PG8_STAGE(PG8_SB(0, 0), cB, voffB); PG8_STAGE(PG8_SB(0, 1), cB + hstep, voffB); PG8_STAGE(PG8_SA(0, 0), cA, ca0); PG8_STAGE(PG8_SA(0, 1), cA, ca1);
    if (wr == 1) PG8_BAR;
    PG8_WAIT_V(2); PG8_BAR;
    PG8_STAGE(PG8_SB(1, 0), cB + kstep, voffB); PG8_STAGE(PG8_SA(1, 0), cA + kstep, ca0); PG8_STAGE(PG8_SB(1, 1), cB + hstep + kstep, voffB);
    PG8_WAIT_V(6); PG8_BAR;
    for (;;) {
        const bool has_next = S.next(ui + 1, nxt);
        if (has_next) S.aoff(nxt, sR, sC, na0, na1); else { na0[0] = ca0[0]; na0[1] = ca0[1]; na1[0] = ca1[0]; na1[1] = ca1[1]; }
        const char* nA = has_next ? nxt.A : cA; const char* nB = has_next ? nxt.B : cB;
        for (int t = 0; t < nt; t += 2) {
            const bool last = (t == nt - 2);
            const char* a1 = cA + (size_t)(t + 1) * kstep;
            const char* a2 = last ? nA : cA + (size_t)(t + 2) * kstep; const char* b2 = last ? nB : cB + (size_t)(t + 2) * kstep;
            const char* a3 = a2 + kstep; const char* b3 = b2 + kstep;
            unsigned xa0[2], xa1[2];
            xa0[0] = last ? na0[0] : ca0[0]; xa0[1] = last ? na0[1] : ca0[1]; xa1[0] = last ? na1[0] : ca1[0]; xa1[1] = last ? na1[1] : ca1[1];
            PG8_LDB(B0, 0, 0); PG8_LDB(B1, 0, 1); PG8_SCHED; PG8_LDA(At, 0, 0); PG8_STAGE(PG8_SA(1, 1), a1, ca1);
            PG8_WAIT_V(8); PG8_WAIT_L(0); PG8_BAR; PG8_MMA(0, 0, At, B0); PG8_MMA(0, 1, At, B1); PG8_BAR; PG8_SCHED;
            PG8_LDA(At, 0, 1); PG8_STAGE(PG8_SB(0, 0), b2, voffB); PG8_STAGE(PG8_SB(0, 1), b2 + hstep, voffB); PG8_STAGE(PG8_SA(0, 0), a2, xa0);
            PG8_WAIT_V(8); PG8_WAIT_L(0); PG8_BAR; PG8_MMA(1, 0, At, B0); PG8_MMA(1, 1, At, B1); PG8_BAR; PG8_SCHED;
            PG8_LDB(B0, 1, 0); PG8_LDB(B1, 1, 1); PG8_SCHED; PG8_LDA(At, 1, 0); PG8_STAGE(PG8_SA(0, 1), a2, xa1);
            PG8_WAIT_V(8); PG8_WAIT_L(0); PG8_BAR; PG8_MMA(0, 0, At, B0); PG8_MMA(0, 1, At, B1); PG8_BAR; PG8_SCHED;
            PG8_LDA(At, 1, 1); PG8_STAGE(PG8_SB(1, 0), b3, voffB); PG8_STAGE(PG8_SB(1, 1), b3 + hstep, voffB); PG8_STAGE(PG8_SA(1, 0), a3, xa0);
            PG8_WAIT_V(8); PG8_WAIT_L(0); PG8_BAR; PG8_MMA(1, 0, At, B0); PG8_MMA(1, 1, At, B1); PG8_BAR; PG8_SCHED;
        }
#if PG8_ALIGN_EPI
        if (wr == 0) PG8_BAR;
#endif
        const bool keepacc = E(acc, cur, wr, wc, fr, fq);
        if (!has_next) break;
        if (!keepacc) E.init(acc, nxt, wr, wc, fr, fq);
        cur = nxt; cA = nA; cB = nB; ca0[0] = na0[0]; ca0[1] = na0[1]; ca1[0] = na1[0]; ca1[1] = na1[1]; ++ui;
#if PG8_ALIGN_EPI
        if (wr == 1) PG8_BAR;
#endif
    }
    PG8_WAIT_V(0);
#if !PG8_ALIGN_EPI
    if (wr == 0) PG8_BAR;
#endif
    PG8_BAR;
#undef PG8_SA
#undef PG8_SB
#undef PG8_STAGE
#undef PG8_LDA
#undef PG8_LDB
#undef PG8_MMA
#undef PG8_WAIT_V
#undef PG8_WAIT_L
#undef PG8_BAR
#undef PG8_SCHED
}

template <int K> struct SchedDense {
    const char* A; const char* B; int nM, nN, G, c, extra, xpn;
    __device__ __forceinline__ bool next(int i, GUnit& u) const {
        const int L = i * G + c; int pm, pn;
        if (!tile_map(L, nM, nN, pm, pn)) { const int j = L - nM * nN; if (j >= extra) return false; pm = nM + j; pn = xpn; }
        u.pm = pm; u.pn = pn; u.aux = 0; u.A = A + (size_t)pm * 256 * K * 2; u.B = B + (size_t)pn * 256 * K * 2; return true;
    }
    __device__ __forceinline__ void aoff(const GUnit&, const int (&sR)[2], const int (&sC)[2], unsigned (&o0)[2], unsigned (&o1)[2]) const {
#pragma unroll
        for (int i = 0; i < 2; ++i) { o0[i] = (unsigned)(sR[i] * K + sC[i]) * 2u; o1[i] = (unsigned)((128 + sR[i]) * K + sC[i]) * 2u; }
    }
};
struct SchedSame {
    const char* A; const char* B; int n, c;
    __device__ __forceinline__ bool next(int i, GUnit& u) const {
        if (i >= n) return false; const int pm = (c >> 3) & 7, pn = (c >> 6) & 3;
        u.pm = pm; u.pn = pn; u.aux = 0; u.A = A + (size_t)pm * 256 * 2048; u.B = B + (size_t)pn * 256 * 2048; return true;
    }
    __device__ __forceinline__ void aoff(const GUnit&, const int (&sR)[2], const int (&sC)[2], unsigned (&o0)[2], unsigned (&o1)[2]) const {
#pragma unroll
        for (int i = 0; i < 2; ++i) { o0[i] = (unsigned)(sR[i] * 1024 + sC[i]) * 2u; o1[i] = (unsigned)((128 + sR[i]) * 1024 + sC[i]) * 2u; }
    }
};
struct SchedBranch {
    const char* A0; const char* B0; size_t sa, sb; int nM, G, c;
    __device__ __forceinline__ bool next(int i, GUnit& u) const {
        const int ti = i / 3, br = i - 3 * ti; const int L = ti * G + c; int pm, pn;
        if (!tile_map(L, nM, 4, pm, pn)) return false;
        u.pm = pm; u.pn = pn; u.aux = br;
        u.A = A0 + (size_t)br * sa + (size_t)pm * 256 * 1024; u.B = B0 + (size_t)br * sb + (size_t)pn * 256 * 1024; return true;
    }
    __device__ __forceinline__ void aoff(const GUnit&, const int (&sR)[2], const int (&sC)[2], unsigned (&o0)[2], unsigned (&o1)[2]) const {
#pragma unroll
        for (int i = 0; i < 2; ++i) { o0[i] = (unsigned)(sR[i] * 512 + sC[i]) * 2u; o1[i] = (unsigned)((128 + sR[i]) * 512 + sC[i]) * 2u; }
    }
};
template <bool GATHER> struct SchedMoE {
    const char* A; const char* W; size_t wexp; const unsigned* list; const LAS unsigned* tab; int nN, G, c;
    __device__ __forceinline__ bool next(int i, GUnit& u) const {
        const int L = i * G + c; int pm, pn; const int nM = (int)tab[64];
        if (!tile_map(L, nM, nN, pm, pn)) return false;
        const int e = __builtin_amdgcn_readfirstlane((int)tab[96 + pm]);
        u.pm = pm; u.pn = pn; u.aux = e; u.B = W + (size_t)e * wexp + (size_t)pn * 256 * 2048;
        u.A = GATHER ? A : A + (size_t)pm * 256 * 2048; return true;
    }
    __device__ __forceinline__ void aoff(const GUnit& u, const int (&sR)[2], const int (&sC)[2], unsigned (&o0)[2], unsigned (&o1)[2]) const {
        if (GATHER) {
            const int e = u.aux; const int n_e = (int)tab[e]; const int idx0 = (u.pm - (int)tab[32 + e]) * 256;
            const unsigned* le = list + (size_t)e * TA;
#pragma unroll
            for (int i = 0; i < 2; ++i) {
                const int i0 = idx0 + sR[i], i1 = i0 + 128;
                const unsigned t0 = i0 < n_e ? le[i0] : 0u, t1 = i1 < n_e ? le[i1] : 0u;
                o0[i] = (t0 * 1024u + (unsigned)sC[i]) * 2u; o1[i] = (t1 * 1024u + (unsigned)sC[i]) * 2u; }
        } else {
#pragma unroll
            for (int i = 0; i < 2; ++i) { o0[i] = (unsigned)(sR[i] * 1024 + sC[i]) * 2u; o1[i] = (unsigned)((128 + sR[i]) * 1024 + sC[i]) * 2u; }
        }
    }
};

struct EpiInProj {
    static constexpr bool PERM = true; static constexpr int MINOPS = 8;
    bf16_t* aglu; bf16_t* q; bf16_t* k; bf16_t* vt; bf16_t* u; bf16_t* g; const float* bgate; const float* rope;
    __device__ __forceinline__ void init(f32x4 (&acc)[2][2][4][2], const GUnit& un, int wr, int wc, int fr, int fq) const {
        f32x4 bv[2][2];
        if (un.pn >= 9) { const int gc0 = (un.pn - 9) * 256 + wc * 64 + fq * 8;
#pragma unroll
            for (int bj = 0; bj < 2; ++bj)
#pragma unroll
                for (int n = 0; n < 2; ++n) bv[bj][n] = *(const f32x4*)(bgate + gc0 + bj * 32 + 4 * n);
        } else { bv[0][0] = (f32x4){0.f, 0.f, 0.f, 0.f}; bv[0][1] = bv[0][0]; bv[1][0] = bv[0][0]; bv[1][1] = bv[0][0]; }
#pragma unroll
        for (int a = 0; a < 2; ++a)
#pragma unroll
            for (int b = 0; b < 2; ++b)
#pragma unroll
                for (int m = 0; m < 4; ++m)
#pragma unroll
                    for (int n = 0; n < 2; ++n) acc[a][b][m][n] = bv[b][n];
    }
    __device__ __forceinline__ bool operator()(f32x4 (&acc)[2][2][4][2], const GUnit& un, int wr, int wc, int fr, int fq) const {
        const int pn = un.pn; const int row0 = un.pm * 256 + wr * 64 + fr; const bool isx = un.pm < NTX;
        if (pn < 4) {
#pragma unroll
            for (int ai = 0; ai < 2; ++ai)
#pragma unroll
                for (int m = 0; m < 4; ++m) { const int row = row0 + ai * 128 + m * 16; f32x4 o0, o1;
#pragma unroll
                    for (int j = 0; j < 4; ++j) { o0[j] = acc[ai][0][m][0][j] * sigmoidf_(acc[ai][1][m][0][j]); o1[j] = acc[ai][0][m][1][j] * sigmoidf_(acc[ai][1][m][1][j]); }
                    *(u32x4*)(aglu + (size_t)row * 512 + pn * 128 + wc * 32 + fq * 8) = pack8(o0, o1); }
        } else if (pn < 6 || (pn == 6 && wc < 2)) {
            bf16_t* dst; int ld, c0;
            if (pn < 6) { dst = q; ld = 512; c0 = ((pn - 4) * 4 + wc) * 64 + fq * 8; } else { dst = k; ld = 128; c0 = wc * 64 + fq * 8; }
#pragma unroll
            for (int ai = 0; ai < 2; ++ai)
#pragma unroll
                for (int m = 0; m < 4; ++m) { const int row = row0 + ai * 128 + m * 16;
                    f32x4 x1a = acc[ai][0][m][0], x1b = acc[ai][0][m][1], x2a = acc[ai][1][m][0], x2b = acc[ai][1][m][1];
                    if (isx) { const int s = row & (SEQ - 1); const float* cp = rope + (size_t)s * 32 + fq * 8; const float* sp = cp + 8192 * 32;
                        const f32x4 ca = *(const f32x4*)cp, cb = *(const f32x4*)(cp + 4), sa = *(const f32x4*)sp, sb = *(const f32x4*)(sp + 4);
                        const f32x4 o1a = x1a * ca - x2a * sa, o1b = x1b * cb - x2b * sb, o2a = x2a * ca + x1a * sa, o2b = x2b * cb + x1b * sb;
                        x1a = o1a; x1b = o1b; x2a = o2a; x2b = o2b; }
                    *(u32x4*)(dst + (size_t)row * ld + c0) = pack8(x1a, x1b);
                    *(u32x4*)(dst + (size_t)row * ld + c0 + 32) = pack8(x2a, x2b); }
        } else if (pn == 6) {
            const int d0 = (wc - 2) * 32 + fq * 8;
#pragma unroll
            for (int ai = 0; ai < 2; ++ai)
#pragma unroll
                for (int m = 0; m < 4; ++m) { const int row = row0 + ai * 128 + m * 16;
#pragma unroll
                    for (int bj = 0; bj < 2; ++bj) {
                        bf16_t* base; size_t st;
                        if (isx) { const int b = row >> 13, s = row & (SEQ - 1); base = vt + ((size_t)((b * 2 + bj) * 64 + d0)) * SEQ + perm16(s); st = SEQ; }
                        else { const int zz = row - TX, b = zz >> 8, cp = zz & 255; base = vt + (size_t)TX * 128 + ((size_t)((b * 2 + bj) * 64 + d0)) * CTXL + perm16(cp); st = CTXL; }
#pragma unroll
                        for (int j = 0; j < 4; ++j) { base[(size_t)j * st] = (bf16_t)f2bf(acc[ai][bj][m][0][j]); base[(size_t)(4 + j) * st] = (bf16_t)f2bf(acc[ai][bj][m][1][j]); } } }
        } else if (pn < 9) {
#pragma unroll
            for (int ai = 0; ai < 2; ++ai)
#pragma unroll
                for (int m = 0; m < 4; ++m) { const int row = row0 + ai * 128 + m * 16;
#pragma unroll
                    for (int bj = 0; bj < 2; ++bj) *(u32x4*)(u + (size_t)row * 512 + (pn - 7) * 256 + wc * 64 + bj * 32 + fq * 8) = pack8(acc[ai][bj][m][0], acc[ai][bj][m][1]); }
        } else {
            const int gc0 = (pn - 9) * 256 + wc * 64 + fq * 8;
#pragma unroll
            for (int ai = 0; ai < 2; ++ai)
#pragma unroll
                for (int m = 0; m < 4; ++m) { const int row = row0 + ai * 128 + m * 16;
#pragma unroll
                    for (int bj = 0; bj < 2; ++bj) { f32x4 o0, o1;
#pragma unroll
                        for (int j = 0; j < 4; ++j) { o0[j] = sigmoidf_(acc[ai][bj][m][0][j]); o1[j] = sigmoidf_(acc[ai][bj][m][1][j]); }
                        *(u32x4*)(g + (size_t)row * 3072 + gc0 + bj * 32) = pack8(o0, o1); } }
        }
        return false;
    }
};
struct EpiBranch {
    static constexpr bool PERM = true; static constexpr int MINOPS = 8;
    const bf16_t* g; bf16_t* mg;
    __device__ __forceinline__ void init(f32x4 (&acc)[2][2][4][2], const GUnit&, int, int, int, int) const {
#pragma unroll
        for (int a = 0; a < 2; ++a)
#pragma unroll
            for (int b = 0; b < 2; ++b)
#pragma unroll
                for (int m = 0; m < 4; ++m)
#pragma unroll
                    for (int n = 0; n < 2; ++n) acc[a][b][m][n] = (f32x4){0.f, 0.f, 0.f, 0.f};
    }
    __device__ __forceinline__ bool operator()(f32x4 (&acc)[2][2][4][2], const GUnit& un, int wr, int wc, int fr, int fq) const {
        const int br = un.aux; const int row0 = un.pm * 256 + wr * 64 + fr; const int c0 = un.pn * 256 + wc * 64 + fq * 8;
        if (br < 2) {
#pragma unroll
            for (int ai = 0; ai < 2; ++ai) {
                u32x4 ga[4][2], gb[4][2];
#pragma unroll
                for (int m = 0; m < 4; ++m)
#pragma unroll
                    for (int bj = 0; bj < 2; ++bj) { const bf16_t* gp = g + (size_t)(row0 + ai * 128 + m * 16) * 3072 + br * 1024 + c0 + bj * 32;
                        ga[m][bj] = *(const u32x4*)gp; gb[m][bj] = *(const u32x4*)(gp + 1024); }
#pragma unroll
                for (int m = 0; m < 4; ++m)
#pragma unroll
                    for (int bj = 0; bj < 2; ++bj) { f32x4 a0, a1, b0, b1; unpack8(ga[m][bj], a0, a1); unpack8(gb[m][bj], b0, b1);
#pragma unroll
                        for (int j = 0; j < 4; ++j) { acc[ai][bj][m][0][j] *= a0[j] * __builtin_amdgcn_rcpf(b0[j]); acc[ai][bj][m][1][j] *= a1[j] * __builtin_amdgcn_rcpf(b1[j]); } }
                asm volatile("" ::: "memory");
            }
            return true;
        }
#pragma unroll
        for (int ai = 0; ai < 2; ++ai) {
            u32x4 gw[4][2];
#pragma unroll
            for (int m = 0; m < 4; ++m)
#pragma unroll
                for (int bj = 0; bj < 2; ++bj) gw[m][bj] = *(const u32x4*)(g + (size_t)(row0 + ai * 128 + m * 16) * 3072 + 2048 + c0 + bj * 32);
#pragma unroll
            for (int m = 0; m < 4; ++m)
#pragma unroll
                for (int bj = 0; bj < 2; ++bj) { f32x4 a0, a1; unpack8(gw[m][bj], a0, a1);
                    *(u32x4*)(mg + (size_t)(row0 + ai * 128 + m * 16) * 1024 + c0 + bj * 32) = pack8(a0 * acc[ai][bj][m][0], a1 * acc[ai][bj][m][1]); }
            asm volatile("" ::: "memory");
        }
        return false;
    }
};
#if XBF16
struct EpiWout {
    static constexpr bool PERM = true; static constexpr int MINOPS = 8;
    const float* resx; const float* resz; bf16_t* X; const float* modl; float* SS; int first;
    __device__ __forceinline__ void init(f32x4 (&acc)[2][2][4][2], const GUnit&, int, int, int, int) const {
#pragma unroll
        for (int a = 0; a < 2; ++a)
#pragma unroll
            for (int b = 0; b < 2; ++b)
#pragma unroll
                for (int m = 0; m < 4; ++m)
#pragma unroll
                    for (int n = 0; n < 2; ++n) acc[a][b][m][n] = (f32x4){0.f, 0.f, 0.f, 0.f};
    }
    __device__ __forceinline__ bool operator()(f32x4 (&acc)[2][2][4][2], const GUnit& un, int wr, int wc, int fr, int fq) const {
        const int row0 = un.pm * 256 + wr * 64 + fr; const int c0 = un.pn * 256 + wc * 64 + fq * 8; const bool isx = un.pm < NTX;
        const int ms = isx ? (un.pm >> 5) : 8;
        const float* gp = modl + (size_t)ms * 6144 + 2 * 1024 + c0;
        f32x4 gv[2][2];
#pragma unroll
        for (int bj = 0; bj < 2; ++bj)
#pragma unroll
            for (int n = 0; n < 2; ++n) gv[bj][n] = *(const f32x4*)(gp + bj * 32 + n * 4);
#pragma unroll
        for (int ai = 0; ai < 2; ++ai)
#pragma unroll
        for (int mh = 0; mh < 2; ++mh) {
            f32x4 rv[2][2][2];
            if (first) {
#pragma unroll
                for (int m2 = 0; m2 < 2; ++m2) { const int row = row0 + ai * 128 + (mh * 2 + m2) * 16; const float* rp = isx ? resx + (size_t)row * 1024 : resz + (size_t)(row - TX) * 1024;
#pragma unroll
                    for (int bj = 0; bj < 2; ++bj)
#pragma unroll
                        for (int n = 0; n < 2; ++n) rv[m2][bj][n] = *(const f32x4*)(rp + c0 + bj * 32 + n * 4); }
            } else {
#pragma unroll
                for (int m2 = 0; m2 < 2; ++m2) { const int row = row0 + ai * 128 + (mh * 2 + m2) * 16;
#pragma unroll
                    for (int bj = 0; bj < 2; ++bj) { const u32x4 w = *(const u32x4*)(X + (size_t)row * 1024 + c0 + bj * 32); unpack8(w, rv[m2][bj][0], rv[m2][bj][1]); } }
            }
#pragma unroll
            for (int m2 = 0; m2 < 2; ++m2) { const int m = mh * 2 + m2; const int row = row0 + ai * 128 + m * 16; float sq = 0.f;
#pragma unroll
                for (int bj = 0; bj < 2; ++bj) { const u32x4 w = pack8(rv[m2][bj][0] + gv[bj][0] * acc[ai][bj][m][0], rv[m2][bj][1] + gv[bj][1] * acc[ai][bj][m][1]);
                    f32x4 va, vb; unpack8(w, va, vb);
                    sq += (va[0] * va[0] + va[1] * va[1]) + (va[2] * va[2] + va[3] * va[3]) + (vb[0] * vb[0] + vb[1] * vb[1]) + (vb[2] * vb[2] + vb[3] * vb[3]);
                    *(u32x4*)(X + (size_t)row * 1024 + c0 + bj * 32) = w; }
                sq += __shfl_xor(sq, 16); sq += __shfl_xor(sq, 32);
                if (fq == 0) SS[(size_t)row * 16 + un.pn * 4 + wc] = sq; }
            asm volatile("" ::: "memory");
        }
        return false;
    }
};
#else
struct EpiWout {
    static constexpr bool PERM = false; static constexpr int MINOPS = 8;
    const float* resx; const float* resz; float* X; const float* modl; float* SS; int first;
    __device__ __forceinline__ void init(f32x4 (&acc)[2][2][4][2], const GUnit&, int, int, int, int) const {
#pragma unroll
        for (int a = 0; a < 2; ++a)
#pragma unroll
            for (int b = 0; b < 2; ++b)
#pragma unroll
                for (int m = 0; m < 4; ++m)
#pragma unroll
                    for (int n = 0; n < 2; ++n) acc[a][b][m][n] = (f32x4){0.f, 0.f, 0.f, 0.f};
    }
    __device__ __forceinline__ bool operator()(f32x4 (&acc)[2][2][4][2], const GUnit& un, int wr, int wc, int fr, int fq) const {
        const int row0 = un.pm * 256 + wr * 64 + fr; const int c0 = un.pn * 256 + wc * 32 + fq * 4; const bool isx = un.pm < NTX;
        const int ms = isx ? (un.pm >> 5) : 8;
        const float* gp = modl + (size_t)ms * 6144 + 2 * 1024 + c0;
        f32x4 gv[2][2];
#pragma unroll
        for (int bj = 0; bj < 2; ++bj)
#pragma unroll
            for (int n = 0; n < 2; ++n) gv[bj][n] = *(const f32x4*)(gp + bj * 128 + n * 16);
#pragma unroll
        for (int ai = 0; ai < 2; ++ai) {
            f32x4 rv[4][2][2];
#pragma unroll
            for (int m = 0; m < 4; ++m) { const int row = row0 + ai * 128 + m * 16;
                const float* rp = first ? (isx ? resx + (size_t)row * 1024 : resz + (size_t)(row - TX) * 1024) : X + (size_t)row * 1024;
#pragma unroll
                for (int bj = 0; bj < 2; ++bj)
#pragma unroll
                    for (int n = 0; n < 2; ++n) rv[m][bj][n] = *(const f32x4*)(rp + c0 + bj * 128 + n * 16); }
#pragma unroll
            for (int m = 0; m < 4; ++m) { const int row = row0 + ai * 128 + m * 16; float sq = 0.f;
#pragma unroll
                for (int bj = 0; bj < 2; ++bj)
#pragma unroll
                    for (int n = 0; n < 2; ++n) { const f32x4 v = rv[m][bj][n] + gv[bj][n] * acc[ai][bj][m][n]; sq += (v[0] * v[0] + v[1] * v[1]) + (v[2] * v[2] + v[3] * v[3]);
                        *(f32x4*)(X + (size_t)row * 1024 + c0 + bj * 128 + n * 16) = v; }
                sq += __shfl_xor(sq, 16); sq += __shfl_xor(sq, 32);
                if (fq == 0) SS[(size_t)row * 16 + un.pn * 4 + wc] = sq; }
            asm volatile("" ::: "memory");
        }
        return false;
    }
};
#endif
struct EpiGU {
    static constexpr bool PERM = true; static constexpr int MINOPS = 8;
    bf16_t* act; const float* bgu;
    __device__ __forceinline__ void init(f32x4 (&acc)[2][2][4][2], const GUnit& un, int wr, int wc, int fr, int fq) const {
        f32x4 bv[2][2];
        { const float* bp = bgu + (size_t)un.aux * 2048 + un.pn * 128 + wc * 32 + fq * 8;
          bv[0][0] = *(const f32x4*)bp; bv[0][1] = *(const f32x4*)(bp + 4); bv[1][0] = *(const f32x4*)(bp + 1024); bv[1][1] = *(const f32x4*)(bp + 1028); }
#pragma unroll
        for (int a = 0; a < 2; ++a)
#pragma unroll
            for (int b = 0; b < 2; ++b)
#pragma unroll
                for (int m = 0; m < 4; ++m)
#pragma unroll
                    for (int n = 0; n < 2; ++n) acc[a][b][m][n] = bv[b][n];
    }
    __device__ __forceinline__ bool operator()(f32x4 (&acc)[2][2][4][2], const GUnit& un, int wr, int wc, int fr, int fq) const {
        const int row0 = un.pm * 256 + wr * 64 + fr; const int c0 = un.pn * 128 + wc * 32 + fq * 8;
#pragma unroll
        for (int ai = 0; ai < 2; ++ai)
#pragma unroll
            for (int m = 0; m < 4; ++m) { const int row = row0 + ai * 128 + m * 16; f32x4 o0, o1;
#pragma unroll
                for (int j = 0; j < 4; ++j) {
                    const float g0 = fminf(acc[ai][0][m][0][j], 7.0f), u0 = __builtin_amdgcn_fmed3f(acc[ai][1][m][0][j], -7.0f, 7.0f);
                    const float g1 = fminf(acc[ai][0][m][1][j], 7.0f), u1 = __builtin_amdgcn_fmed3f(acc[ai][1][m][1][j], -7.0f, 7.0f);
                    const float t0 = g0 * __builtin_amdgcn_rcpf(1.0f + __builtin_amdgcn_exp2f(g0 * (-1.702f * LOG2E)));
                    const float t1 = g1 * __builtin_amdgcn_rcpf(1.0f + __builtin_amdgcn_exp2f(g1 * (-1.702f * LOG2E)));
                    o0[j] = u0 * t0 + t0; o1[j] = u1 * t1 + t1; }
                *(u32x4*)(act + (size_t)row * 1024 + c0) = pack8(o0, o1); }
        return false;
    }
};
struct EpiDown {
    static constexpr bool PERM = true; static constexpr int MINOPS = 8;
    bf16_t* y; const float* bdn;
    __device__ __forceinline__ void init(f32x4 (&acc)[2][2][4][2], const GUnit& un, int wr, int wc, int fr, int fq) const {
        f32x4 bv[2][2];
        { const float* bp = bdn + (size_t)un.aux * 1024 + un.pn * 256 + wc * 64 + fq * 8;
#pragma unroll
          for (int bj = 0; bj < 2; ++bj)
#pragma unroll
              for (int n = 0; n < 2; ++n) bv[bj][n] = *(const f32x4*)(bp + bj * 32 + 4 * n); }
#pragma unroll
        for (int a = 0; a < 2; ++a)
#pragma unroll
            for (int b = 0; b < 2; ++b)
#pragma unroll
                for (int m = 0; m < 4; ++m)
#pragma unroll
                    for (int n = 0; n < 2; ++n) acc[a][b][m][n] = bv[b][n];
    }
    __device__ __forceinline__ bool operator()(f32x4 (&acc)[2][2][4][2], const GUnit& un, int wr, int wc, int fr, int fq) const {
        const int row0 = un.pm * 256 + wr * 64 + fr; const int c0 = un.pn * 256 + wc * 64 + fq * 8;
#pragma unroll
        for (int ai = 0; ai < 2; ++ai)
#pragma unroll
            for (int m = 0; m < 4; ++m) { const int row = row0 + ai * 128 + m * 16;
#pragma unroll
                for (int bj = 0; bj < 2; ++bj) *(u32x4*)(y + (size_t)row * 1024 + c0 + bj * 32) = pack8(acc[ai][bj][m][0], acc[ai][bj][m][1]); }
        return false;
    }
};
struct EpiNull {
    static constexpr bool PERM = true; static constexpr int MINOPS = 0;
    __device__ __forceinline__ void init(f32x4 (&acc)[2][2][4][2], const GUnit&, int, int, int, int) const {
#pragma unroll
        for (int a = 0; a < 2; ++a)
#pragma unroll
            for (int b = 0; b < 2; ++b)
#pragma unroll
                for (int m = 0; m < 4; ++m)
#pragma unroll
                    for (int n = 0; n < 2; ++n) acc[a][b][m][n] = (f32x4){0.f, 0.f, 0.f, 0.f};
    }
    __device__ __forceinline__ bool operator()(f32x4 (&acc)[2][2][4][2], const GUnit&, int, int, int, int) const {
#pragma unroll
        for (int ai = 0; ai < 2; ++ai)
#pragma unroll
            for (int bj = 0; bj < 2; ++bj)
#pragma unroll
                for (int m = 0; m < 4; ++m)
#pragma unroll
                    for (int n = 0; n < 2; ++n) asm volatile("" :: "v"(acc[ai][bj][m][n]));
        return false;
    }
};
}

struct Args { const float* in[28]; float* out; unsigned char* ws; int ph_lo, ph_hi; };
struct Frame {
    LAS unsigned char* lds; unsigned char* ws; unsigned* ctl;
    int tid, lane, wave, vcu, G;
};

__device__ __forceinline__ int semcol(int lc) { return ((lc >> 5) & 3) * 64 + (lc >> 7) * 32 + (lc & 31); }
__device__ __forceinline__ int logcol(int sc) { return ((sc >> 5) & 1) * 128 + ((sc >> 6) & 3) * 32 + (sc & 31); }
__device__ __forceinline__ int colmap_in(int n) {
    const int pn = n >> 8, lc = n & 255, bj = lc >> 7, c = lc & 127;
    if (pn < 4) return bj * 512 + pn * 128 + c;
    if (pn < 6) return 1024 + ((pn - 4) * 4 + (c >> 5)) * 64 + bj * 32 + (c & 31);
    if (pn == 6) return c < 64 ? 1536 + (c >> 5) * 64 + bj * 32 + (c & 31) : 1664 + bj * 64 + (c - 64);
    if (pn < 9) return 1792 + (pn - 7) * 256 + semcol(lc);
    return 2304 + (pn - 9) * 256 + semcol(lc);
}
__device__ __forceinline__ void transpose_item(const float* src, int ld, int k0, int c0, bf16_t* dst, int r0, int Kd, LAS float* scr, int lane) {
    const int kr = lane >> 3, nq = (lane & 7) * 4;
    f32x4 v[8];
#pragma unroll
    for (int i = 0; i < 8; ++i) v[i] = __builtin_nontemporal_load((const f32x4*)(src + (size_t)(k0 + 8 * i + kr) * ld + c0 + nq));
#pragma unroll
    for (int i = 0; i < 8; ++i) { LAS float* p = scr + (8 * i + kr) * 33 + nq; p[0] = v[i][0]; p[1] = v[i][1]; p[2] = v[i][2]; p[3] = v[i][3]; }
    asm volatile("s_waitcnt lgkmcnt(0)" ::: "memory");
    const int c = lane & 7;
#pragma unroll
    for (int j = 0; j < 4; ++j) { const int n = (lane >> 3) + 8 * j; const LAS float* s = scr + (8 * c) * 33 + n;
        u32x4 o; o.x = pk2(s[0 * 33], s[1 * 33]); o.y = pk2(s[2 * 33], s[3 * 33]); o.z = pk2(s[4 * 33], s[5 * 33]); o.w = pk2(s[6 * 33], s[7 * 33]);
        *(u32x4*)(dst + (size_t)(r0 + n) * Kd + k0 + 8 * c) = o; }
    asm volatile("s_waitcnt lgkmcnt(0)" ::: "memory");
}
__device__ __forceinline__ void p_prologue(Frame& F, const Args& a) {
    float* mod = (float*)(F.ws + WS_MOD);
    if (blockIdx.x < 192) {
        const int l = blockIdx.x / 96, n0 = (blockIdx.x % 96) * 64;
        LAS float* sc = (LAS float*)F.lds; LAS float* part = (LAS float*)(F.lds + 36864);
        { float cv[18];
#pragma unroll
          for (int q = 0; q < 18; ++q) { const int i = q * 512 + F.tid; cv[q] = i < 8192 ? a.in[1][i] : a.in[3][i - 8192]; }
#pragma unroll
          for (int q = 0; q < 18; ++q) sc[q * 512 + F.tid] = cv[q] * sigmoidf_(cv[q]); }
        __syncthreads();
        const int ks = F.tid >> 6, col = F.tid & 63;
        float accv[9];
#pragma unroll
        for (int s = 0; s < 9; ++s) accv[s] = 0.f;
        const float* wp = a.in[4] + (size_t)l * 1024 * 6144 + n0 + col;
#pragma unroll 1
        for (int k0 = ks * 128; k0 < ks * 128 + 128; k0 += 16) { float w[16];
#pragma unroll
            for (int j = 0; j < 16; ++j) w[j] = wp[(size_t)(k0 + j) * 6144];
#pragma unroll
            for (int j = 0; j < 16; ++j)
#pragma unroll
                for (int s = 0; s < 9; ++s) accv[s] += sc[s * 1024 + k0 + j] * w[j]; }
#pragma unroll
        for (int s = 0; s < 9; ++s) part[(ks * 9 + s) * 64 + col] = accv[s];
        __syncthreads();
        for (int i = F.tid; i < 576; i += 512) { const int s = i >> 6, cc = i & 63; float v = a.in[5][l * 6144 + n0 + cc];
#pragma unroll
            for (int k2 = 0; k2 < 8; ++k2) v += part[(k2 * 9 + s) * 64 + cc];
            mod[(size_t)(l * 9 + s) * 6144 + n0 + cc] = v; }
        __syncthreads();
    }
    {
        const double inv[16] = {1.0, 0.5623413251903491, 0.31622776601683794, 0.1778279410038923, 0.1, 0.05623413251903491, 0.03162277660168379, 0.01778279410038923,
                                0.01, 0.005623413251903491, 0.0031622776601683794, 0.0017782794100389228, 0.001, 0.0005623413251903491, 0.00031622776601683794, 0.00017782794100389227};
        float* rope = (float*)(F.ws + WS_ROPE);
        for (int idx = F.vcu * 512 + F.tid; idx < 8192 * 32; idx += F.G * 512) {
            const int s = idx >> 5, dd = idx & 31; const int pos = dd < 16 ? (s >> 6) : (s & 63); const int i = dd & 15;
            double iv = inv[0];
#pragma unroll
            for (int q = 1; q < 16; ++q) iv = (i == q) ? inv[q] : iv;
            const double ang = (double)((float)pos * (float)iv);
            double rev = ang * 0.15915494309189535; rev -= __builtin_rint(rev); const double r = rev * 6.283185307179586, r2 = r * r;
            double sn = -1.0 / 51090942171709440000.0;
            sn = sn * r2 + 1.0 / 121645100408832000.0; sn = sn * r2 - 1.0 / 355687428096000.0; sn = sn * r2 + 1.0 / 1307674368000.0; sn = sn * r2 - 1.0 / 6227020800.0;
            sn = sn * r2 + 1.0 / 39916800.0; sn = sn * r2 - 1.0 / 362880.0; sn = sn * r2 + 1.0 / 5040.0; sn = sn * r2 - 1.0 / 120.0; sn = sn * r2 + 1.0 / 6.0; sn = sn * r2 - 1.0; sn = -sn * r;
            double cs = 1.0 / 1124000727777607680000.0;
            cs = cs * r2 - 1.0 / 2432902008176640000.0; cs = cs * r2 + 1.0 / 6402373705728000.0; cs = cs * r2 - 1.0 / 20922789888000.0; cs = cs * r2 + 1.0 / 87178291200.0;
            cs = cs * r2 - 1.0 / 479001600.0; cs = cs * r2 + 1.0 / 3628800.0; cs = cs * r2 - 1.0 / 40320.0; cs = cs * r2 + 1.0 / 720.0; cs = cs * r2 - 1.0 / 24.0; cs = cs * r2 + 0.5; cs = 1.0 - cs * r2;
            rope[idx] = (float)cs; rope[8192 * 32 + idx] = (float)sn;
        }
    }
    const int gw = F.vcu * 8 + F.wave, NGW = F.G * 8;
    for (int it = gw; it < 2048; it += NGW) {
        const int l = it >> 10, r = it & 1023, g = r >> 8, c0 = ((r & 255) >> 4) * 8, n = (r & 15) * 64 + F.lane;
        const float* wp = a.in[16] + ((size_t)(l * 4 + g) * 128 + c0) * 128; const float* ps = a.in[17] + l * 512 + g * 128; const float* wo = a.in[18] + ((size_t)l * 512 + g * 128) * 1024 + n;
        float accv[8];
#pragma unroll
        for (int i = 0; i < 8; ++i) accv[i] = 0.f;
        for (int d = 0; d < 128; ++d) { const float wv = wo[(size_t)d * 1024] * ps[d];
#pragma unroll
            for (int i = 0; i < 8; ++i) accv[i] += wp[i * 128 + d] * wv; }
        bf16_t* dst = (bf16_t*)(F.ws + WS_W + (size_t)l * W_LAYER + W_PE) + (size_t)((n & ~255) + logcol(n & 255)) * 512 + g * 128 + c0;
        u32x4 o; o.x = pk2(accv[0], accv[1]); o.y = pk2(accv[2], accv[3]); o.z = pk2(accv[4], accv[5]); o.w = pk2(accv[6], accv[7]);
        *(u32x4*)dst = o;
    }
    LAS float* scr = (LAS float*)(F.lds + F.wave * 16384);
    constexpr int I_IN = 16 * 168, I_P = 8 * 32, I_O = 16 * 32, I_GU = 32 * 1024, I_DN = 32 * 512, I_L = I_IN + 2 * I_P + I_O + I_GU + I_DN;
    for (int it = gw; it < 2 * I_L; it += NGW) {
        const int l = it / I_L; int r = it - l * I_L; unsigned char* wl = F.ws + WS_W + (size_t)l * W_LAYER;
        if (r < I_IN) { const int kb = r / 168, nb = r % 168; transpose_item(a.in[7] + (size_t)l * 1024 * DIN, DIN, kb * 64, colmap_in(nb * 32), (bf16_t*)(wl + W_IN), nb * 32, 1024, scr, F.lane); continue; } r -= I_IN;
        if (r < I_P) { const int kb = r / 32, nb = r % 32; transpose_item(a.in[13] + (size_t)l * 512 * 1024, 1024, kb * 64, ((nb * 32) & ~255) + semcol((nb * 32) & 255), (bf16_t*)(wl + W_CO), nb * 32, 512, scr, F.lane); continue; } r -= I_P;
        if (r < I_P) { const int kb = r / 32, nb = r % 32; transpose_item(a.in[15] + (size_t)l * 512 * 1024, 1024, kb * 64, ((nb * 32) & ~255) + semcol((nb * 32) & 255), (bf16_t*)(wl + W_AO), nb * 32, 512, scr, F.lane); continue; } r -= I_P;
        if (r < I_O) { const int kb = r / 32, nb = r % 32; transpose_item(a.in[19] + (size_t)l * 1024 * 1024, 1024, kb * 64, XBF16 ? ((nb * 32) & ~255) + semcol((nb * 32) & 255) : nb * 32, (bf16_t*)(wl + W_OUT), nb * 32, 1024, scr, F.lane); continue; } r -= I_O;
        if (r < I_GU) { const int e = r >> 10, rr = r & 1023, kb = rr >> 6, nb = rr & 63, n0 = nb * 32; const int pn = n0 >> 8, lc = n0 & 255, c0 = (lc >> 7) * 1024 + pn * 128 + (lc & 127);
            transpose_item(a.in[23] + (size_t)(l * 32 + e) * 1024 * 2048, 2048, kb * 64, c0, (bf16_t*)(wl + W_GU + (size_t)e * W_GU_E), n0, 1024, scr, F.lane); continue; } r -= I_GU;
        { const int e = r >> 9, rr = r & 511, kb = rr >> 5, nb = rr & 31;
            const int n0 = nb * 32, lc = n0 & 255; const int c0 = (n0 & ~255) + ((lc & 127) >> 5) * 64 + (lc >> 7) * 32;
            transpose_item(a.in[25] + (size_t)(l * 32 + e) * 1024 * 1024, 1024, kb * 64, c0, (bf16_t*)(wl + W_DN + (size_t)e * W_DN_E), n0, 1024, scr, F.lane); }
    }
}

__device__ __forceinline__ void p_norm0(Frame& F, const Args& a) {
    const float* mod = (const float*)(F.ws + WS_MOD); bf16_t* H = (bf16_t*)(F.ws + WS_H);
    const int gw = F.vcu * 8 + F.wave, NGW = F.G * 8; const int c0 = 8 * F.lane;
    for (int r0 = gw * 2; r0 < TA; r0 += NGW * 2) {
        const bool isx = r0 < TX; const int ms = isx ? (r0 >> 13) : 8;
        f32x4 v[2][4]; float ss[2];
#pragma unroll
        for (int q = 0; q < 2; ++q) { const float* src = isx ? a.in[0] + (size_t)(r0 + q) * 1024 : a.in[2] + (size_t)(r0 + q - TX) * 1024;
#pragma unroll
            for (int j = 0; j < 4; ++j) v[q][j] = __builtin_nontemporal_load((const f32x4*)(src + 512 * (j >> 1) + c0 + 4 * (j & 1))); }
        const float* mp = mod + (size_t)ms * 6144;
        f32x4 pg[4], psh[4], psc[4];
#pragma unroll
        for (int j = 0; j < 4; ++j) { const int c = 512 * (j >> 1) + c0 + 4 * (j & 1); pg[j] = *(const f32x4*)(a.in[6] + c); psh[j] = *(const f32x4*)(mp + c); psc[j] = *(const f32x4*)(mp + 1024 + c); }
#pragma unroll
        for (int q = 0; q < 2; ++q) { float s_ = 0.f;
#pragma unroll
            for (int j = 0; j < 4; ++j) s_ += (v[q][j][0] * v[q][j][0] + v[q][j][1] * v[q][j][1]) + (v[q][j][2] * v[q][j][2] + v[q][j][3] * v[q][j][3]);
            ss[q] = s_; }
#pragma unroll
        for (int o = 1; o < 64; o <<= 1) { ss[0] += __shfl_xor(ss[0], o); ss[1] += __shfl_xor(ss[1], o); }
#pragma unroll
        for (int q = 0; q < 2; ++q) { const float rstd = 1.0f / sqrtf(ss[q] * (1.0f / 1024.0f) + EPS); f32x4 h[4];
#pragma unroll
            for (int j = 0; j < 4; ++j) h[j] = (v[q][j] * rstd * pg[j]) * (psc[j] + 1.0f) + psh[j];
            *(u32x4*)(H + (size_t)(r0 + q) * 1024 + c0) = pack8(h[0], h[1]); *(u32x4*)(H + (size_t)(r0 + q) * 1024 + 512 + c0) = pack8(h[2], h[3]); }
    }
}

constexpr int AT_BUFB = 16384;
__device__ __forceinline__ int crow(int r, int hi) { return (r & 3) + 8 * (r >> 2) + 4 * hi; }
__device__ __forceinline__ void attn_unit(Frame& F, const bf16_t* Q, const bf16_t* Kb, const bf16_t* VT, bf16_t* AT, const float* sink, bool isz, int b, int n, int kvh) {
    const int tid = F.tid, lane = F.lane, wave = F.wave, r32 = lane & 31, hi = lane >> 5;
    const int qq = (wave & 3) ^ ((wave >> 2) * 2), headA = kvh * 4 + (wave >> 2) * 2;
    const int qrow = (isz ? TX + b * CTXL : b * SEQ) + n * 128 + qq * 32;
    LAS unsigned char* KV = F.lds;
    LAS unsigned char* QS = F.lds + 3 * AT_BUFB + wave * 8192;
    const int n0 = (isz || n == 0) ? 0 : 2, n2 = n0 + ((isz || n == SEQ / 128 - 1) ? 0 : 2), ntile = isz ? 4 : n2 + 6;
    const int srow = tid >> 3, chunk = (tid & 7) ^ ((srow >> 1) & 7);
#define AT_CODE(ti, cc) do { const int t_ = (ti); cc = isz ? t_ + 6 : (t_ < n0 ? t_ : (t_ < n2 ? 4 + (t_ - n0) : (t_ - n2 < 2 ? 2 + (t_ - n2) : 4 + (t_ - n2)))); } while (0)
#define AT_ISSUE(ti, bo_) do { int c_; AT_CODE(ti, c_); const bf16_t* ksrc; const bf16_t* vsrc; \
        if (c_ < 6) { const int blk = n - 1 + (c_ >> 1), j0_ = (c_ & 1) * 64; ksrc = Kb + (size_t)(b * SEQ + blk * 128 + j0_ + srow) * 128 + kvh * 64 + chunk * 8; \
                      vsrc = VT + ((size_t)((b * 2 + kvh) * 64 + srow)) * SEQ + blk * 128 + j0_ + chunk * 8; } \
        else { const int j0_ = (c_ - 6) * 64; ksrc = Kb + (size_t)(TX + b * CTXL + j0_ + srow) * 128 + kvh * 64 + chunk * 8; \
               vsrc = VT + (size_t)TX * 128 + ((size_t)((b * 2 + kvh) * 64 + srow)) * CTXL + j0_ + chunk * 8; } \
        __builtin_amdgcn_global_load_lds((const unsigned*)ksrc, (LAS unsigned*)(KV + (bo_) + wave * 1024), 16, 0, 0); \
        __builtin_amdgcn_global_load_lds((const unsigned*)vsrc, (LAS unsigned*)(KV + (bo_) + 8192 + wave * 1024), 16, 0, 0); } while (0)
    { const int qr = lane >> 4, qc = lane & 15;
#pragma unroll
        for (int i = 0; i < 8; ++i) { const int row = 4 * i + qr;
            __builtin_amdgcn_global_load_lds((const unsigned*)(Q + (size_t)(qrow + row) * 512 + headA * 64 + ((qc ^ (row & 15)) * 8)), (LAS unsigned*)(QS + i * 1024), 16, 0, 0); } }
    asm volatile("" ::: "memory");
    __builtin_amdgcn_s_barrier();
    asm volatile("" ::: "memory");
    AT_ISSUE(0, 0);
    AT_ISSUE(1, AT_BUFB);
    const int qo_ = r32 * 256 + (((r32 & 15) ^ hi) << 4);
    const int a0 = r32 * 128 + (((r32 >> 2) & 3) << 5) + ((hi ^ ((r32 >> 1) & 1)) << 4);
    const float c2 = 0.125f * LOG2E;
    float mrA = sink[headA] * LOG2E, mrB = sink[headA + 1] * LOG2E, lrA = (hi == 0) ? 1.0f : 0.0f, lrB = lrA;
    f32x16 oA0, oA1, oB0, oB1;
#pragma unroll
    for (int r = 0; r < 16; ++r) { oA0[r] = 0.f; oA1[r] = 0.f; oB0[r] = 0.f; oB1[r] = 0.f; }
#define AT_SOFTMAX(s0, s1, mrun, lrun, o0, o1, pw) do { \
        const f32x2 c2v = {c2, c2};                                           \
        _Pragma("unroll") for (int r = 0; r < 16; r += 2) { const f32x2 a = (f32x2){s0[r], s0[r + 1]} * c2v, b = (f32x2){s1[r], s1[r + 1]} * c2v; s0[r] = a.x; s0[r + 1] = a.y; s1[r] = b.x; s1[r + 1] = b.y; } \
        float tma = fmaxf(s0[0], s1[0]), tmb = fmaxf(s0[1], s1[1]), tmc = fmaxf(s0[2], s1[2]), tmd = fmaxf(s0[3], s1[3]); \
        _Pragma("unroll") for (int r = 4; r < 16; r += 4) { tma = fmaxf(tma, fmaxf(s0[r], s1[r])); tmb = fmaxf(tmb, fmaxf(s0[r + 1], s1[r + 1])); tmc = fmaxf(tmc, fmaxf(s0[r + 2], s1[r + 2])); tmd = fmaxf(tmd, fmaxf(s0[r + 3], s1[r + 3])); } \
        float tm = fmaxf(fmaxf(tma, tmb), fmaxf(tmc, tmd)); tm = fmaxf(tm, __shfl_xor(tm, 32)); \
        const float mn = fmaxf(mrun, tm); const bool grew = __any(mn > mrun); const float alpha = __builtin_amdgcn_exp2f(mrun - mn); mrun = mn; \
        const f32x2 mnv = {mn, mn}, alv = {alpha, alpha}; f32x2 ls0 = {0.f, 0.f}, ls1 = {0.f, 0.f}; \
        _Pragma("unroll") for (int r = 0; r < 16; r += 2) { \
            f32x2 a = (f32x2){s0[r], s0[r + 1]} - mnv, b = (f32x2){s1[r], s1[r + 1]} - mnv; \
            a.x = __builtin_amdgcn_exp2f(a.x); a.y = __builtin_amdgcn_exp2f(a.y); b.x = __builtin_amdgcn_exp2f(b.x); b.y = __builtin_amdgcn_exp2f(b.y); \
            s0[r] = a.x; s0[r + 1] = a.y; s1[r] = b.x; s1[r + 1] = b.y; ls0 += a; ls1 += b; } \
        ls0 += ls1; lrun = lrun * alpha + (ls0.x + ls0.y); \
        if (grew) { _Pragma("unroll") for (int r = 0; r < 16; r += 2) { const f32x2 x0 = (f32x2){o0[r], o0[r + 1]} * alv, x1 = (f32x2){o1[r], o1[r + 1]} * alv; o0[r] = x0.x; o0[r + 1] = x0.y; o1[r] = x1.x; o1[r + 1] = x1.y; } } \
        pw[0] = (u32x4){pk2(s0[0], s0[1]), pk2(s0[2], s0[3]), pk2(s0[4], s0[5]), pk2(s0[6], s0[7])}; \
        pw[1] = (u32x4){pk2(s0[8], s0[9]), pk2(s0[10], s0[11]), pk2(s0[12], s0[13]), pk2(s0[14], s0[15])}; \
        pw[2] = (u32x4){pk2(s1[0], s1[1]), pk2(s1[2], s1[3]), pk2(s1[4], s1[5]), pk2(s1[6], s1[7])}; \
        pw[3] = (u32x4){pk2(s1[8], s1[9]), pk2(s1[10], s1[11]), pk2(s1[12], s1[13]), pk2(s1[14], s1[15])}; } while (0)
#define AT_MASK(MODE, s0, s1) do { if (MODE == 0) { _Pragma("unroll") for (int r = 0; r < 16; ++r) { const int cr = (r & 3) + 8 * (r >> 2); if (cr < tq) s0[r] = -1e30f; if (cr + 32 < tq) s1[r] = -1e30f; } } \
        else if (MODE == 2) { _Pragma("unroll") for (int r = 0; r < 16; ++r) { const int cr = (r & 3) + 8 * (r >> 2); if (cr > tq) s0[r] = -1e30f; if (cr + 32 > tq) s1[r] = -1e30f; } } } while (0)
#define AT_TILE(MODE) do { \
        if (ti + 1 < ntile) asm volatile("s_waitcnt vmcnt(2)" ::: "memory"); else asm volatile("s_waitcnt vmcnt(0)" ::: "memory"); \
        __builtin_amdgcn_s_barrier();                                          \
        asm volatile("" ::: "memory"); \
        if (ti + 2 < ntile) { const int bn = bo >= AT_BUFB ? bo - AT_BUFB : bo + 2 * AT_BUFB; AT_ISSUE(ti + 2, bn); } \
        int ccur; AT_CODE(ti, ccur); const int j0 = (ccur & 1) * 64; \
        const bool skip = (MODE == 0 && j0 == 0 && qq >= 2) || (MODE == 2 && j0 == 64 && qq < 2); \
        if (!skip) { \
            const LAS unsigned char* tb = KV + bo; const int tq = qt - j0; (void)tq; \
            f32x16 sA0, sA1, sB0, sB1; u32x4 pwA[4], pwB[4]; \
            _Pragma("unroll") for (int r = 0; r < 16; ++r) { sA0[r] = 0.f; sA1[r] = 0.f; sB0[r] = 0.f; sB1[r] = 0.f; } \
            _Pragma("unroll") for (int ks = 0; ks < 4; ++ks) { \
                const bf16x8 k0 = *(const LAS bf16x8*)(tb + (a0 ^ (ks * 32))), k1 = *(const LAS bf16x8*)(tb + 4096 + (a0 ^ (ks * 32))); \
                const bf16x8 qa = *(const LAS bf16x8*)(QS + (qo_ ^ (ks * 32))), qb = *(const LAS bf16x8*)(QS + (qo_ ^ (128 + ks * 32))); \
                sA0 = __builtin_amdgcn_mfma_f32_32x32x16_bf16(k0, qa, sA0, 0, 0, 0); sA1 = __builtin_amdgcn_mfma_f32_32x32x16_bf16(k1, qa, sA1, 0, 0, 0); \
                sB0 = __builtin_amdgcn_mfma_f32_32x32x16_bf16(k0, qb, sB0, 0, 0, 0); sB1 = __builtin_amdgcn_mfma_f32_32x32x16_bf16(k1, qb, sB1, 0, 0, 0); } \
            AT_MASK(MODE, sA0, sA1); AT_MASK(MODE, sB0, sB1); \
            AT_SOFTMAX(sA0, sA1, mrA, lrA, oA0, oA1, pwA); \
            AT_SOFTMAX(sB0, sB1, mrB, lrB, oB0, oB1, pwB); \
            _Pragma("unroll") for (int kk = 0; kk < 4; ++kk) { \
                const bf16x8 v0 = *(const LAS bf16x8*)(tb + 8192 + (a0 ^ (kk * 32))), v1 = *(const LAS bf16x8*)(tb + 12288 + (a0 ^ (kk * 32))); \
                oA0 = __builtin_amdgcn_mfma_f32_32x32x16_bf16(v0, __builtin_bit_cast(bf16x8, pwA[kk]), oA0, 0, 0, 0); oA1 = __builtin_amdgcn_mfma_f32_32x32x16_bf16(v1, __builtin_bit_cast(bf16x8, pwA[kk]), oA1, 0, 0, 0); \
                oB0 = __builtin_amdgcn_mfma_f32_32x32x16_bf16(v0, __builtin_bit_cast(bf16x8, pwB[kk]), oB0, 0, 0, 0); oB1 = __builtin_amdgcn_mfma_f32_32x32x16_bf16(v1, __builtin_bit_cast(bf16x8, pwB[kk]), oB1, 0, 0, 0); } \
        } \
        bo = bo == 2 * AT_BUFB ? 0 : bo + AT_BUFB; } while (0)
    int qt = qq * 32 + r32 - 4 * hi; asm volatile("" : "+v"(qt));
    int bo = 0, ti = 0;
#pragma unroll 1
    for (; ti < n0; ++ti) AT_TILE(0);
#pragma unroll 1
    for (; ti < n2; ++ti) AT_TILE(2);
#pragma unroll 1
    for (; ti < ntile; ++ti) AT_TILE(1);
#undef AT_CODE
#undef AT_ISSUE
#undef AT_SOFTMAX
#undef AT_MASK
#undef AT_TILE
    {
        const float ltA = lrA + __shfl_xor(lrA, 32), ltB = lrB + __shfl_xor(lrB, 32); const float invA = 1.0f / ltA, invB = 1.0f / ltB;
        bf16_t* op = AT + (size_t)(qrow + r32) * 512 + headA * 64 + 4 * hi;
#pragma unroll
        for (int gi = 0; gi < 4; ++gi) {
            u32x2 w; w.x = pk2(oA0[4 * gi] * invA, oA0[4 * gi + 1] * invA); w.y = pk2(oA0[4 * gi + 2] * invA, oA0[4 * gi + 3] * invA); *(u32x2*)(op + 8 * gi) = w;
            w.x = pk2(oA1[4 * gi] * invA, oA1[4 * gi + 1] * invA); w.y = pk2(oA1[4 * gi + 2] * invA, oA1[4 * gi + 3] * invA); *(u32x2*)(op + 32 + 8 * gi) = w;
            w.x = pk2(oB0[4 * gi] * invB, oB0[4 * gi + 1] * invB); w.y = pk2(oB0[4 * gi + 2] * invB, oB0[4 * gi + 3] * invB); *(u32x2*)(op + 64 + 8 * gi) = w;
            w.x = pk2(oB1[4 * gi] * invB, oB1[4 * gi + 1] * invB); w.y = pk2(oB1[4 * gi + 2] * invB, oB1[4 * gi + 3] * invB); *(u32x2*)(op + 96 + 8 * gi) = w; }
    }
}

__device__ __forceinline__ void conv_task(Frame& F, int tk, const bf16_t* AG, bf16_t* AC, const LAS float* wl, const float* bdw, const float* lng, const float* lnb) {
    const int t0 = tk * 8; int s0, s1;
    if (t0 < TX) { s0 = t0 & ~(SEQ - 1); s1 = s0 + SEQ; } else { s0 = TX + ((t0 - TX) & ~(CTXL - 1)); s1 = s0 + CTXL; }
    int cA = 4 * F.lane; asm volatile("" : "+v"(cA));
    float acc[8][8];
#pragma unroll
    for (int o = 0; o < 8; ++o)
#pragma unroll
        for (int i = 0; i < 8; ++i) acc[o][i] = 0.f;
    u32x2 cwa[8], cwb[8], nwa[8], nwb[8];
    const bf16_t* zrow = (const bf16_t*)(F.ws + WS_CTL + 126 * 1024);
#pragma unroll
    for (int i = 0; i < 8; ++i) { const int row = t0 - 15 + i; const bool inr = row >= s0 && row < s1; const bf16_t* rp = inr ? AG + (size_t)row * 512 : zrow;
        cwa[i] = *(const u32x2*)(rp + cA); cwb[i] = *(const u32x2*)(rp + 256 + cA); }
#pragma unroll 1
    for (int grp = 0; grp < 5; ++grp) {
        if (grp < 4) {
#pragma unroll
            for (int i = 0; i < 8; ++i) { const int row = t0 - 15 + 8 * (grp + 1) + i; const bool inr = row >= s0 && row < s1; const bf16_t* rp = inr ? AG + (size_t)row * 512 : zrow;
                nwa[i] = *(const u32x2*)(rp + cA); nwb[i] = *(const u32x2*)(rp + 256 + cA); }
        }
        float x[8][8];
#pragma unroll
        for (int i = 0; i < 8; ++i) { x[i][0] = bflo(cwa[i].x); x[i][1] = bfhi(cwa[i].x); x[i][2] = bflo(cwa[i].y); x[i][3] = bfhi(cwa[i].y);
            x[i][4] = bflo(cwb[i].x); x[i][5] = bfhi(cwb[i].x); x[i][6] = bflo(cwb[i].y); x[i][7] = bfhi(cwb[i].y); }
        const LAS float* wg = wl + (8 * grp + 8) * 512 + cA;
#pragma unroll
        for (int d = -7; d <= 7; ++d) {
            const f32x4 w0 = *(const LAS f32x4*)(wg + d * 512), w1 = *(const LAS f32x4*)(wg + d * 512 + 256);
#pragma unroll
            for (int o = 0; o < 8; ++o) { const int i = o + d;
                if (i >= 0 && i < 8) {
#pragma unroll
                    for (int q = 0; q < 4; ++q) { acc[o][q] += w0[q] * x[i][q]; acc[o][4 + q] += w1[q] * x[i][4 + q]; } } }
        }
#pragma unroll
        for (int i = 0; i < 8; ++i) { cwa[i] = nwa[i]; cwb[i] = nwb[i]; }
    }
    const f32x4 b0 = *(const f32x4*)(bdw + cA), b1 = *(const f32x4*)(bdw + 256 + cA), g0 = *(const f32x4*)(lng + cA), g1 = *(const f32x4*)(lng + 256 + cA),
                e0 = *(const f32x4*)(lnb + cA), e1 = *(const f32x4*)(lnb + 256 + cA);
#pragma unroll
    for (int o = 0; o < 8; ++o) {
        float v[8]; float s = 0.f;
#pragma unroll
        for (int i = 0; i < 4; ++i) { v[i] = acc[o][i] + b0[i]; v[4 + i] = acc[o][4 + i] + b1[i]; s += v[i] + v[4 + i]; }
        const float mu = wave_sum(s) * (1.0f / 512.0f); float q = 0.f;
#pragma unroll
        for (int i = 0; i < 8; ++i) { v[i] -= mu; q += v[i] * v[i]; }
        const float rstd = 1.0f / sqrtf(wave_sum(q) * (1.0f / 512.0f) + EPS);
        float y[8];
#pragma unroll
        for (int i = 0; i < 4; ++i) { const float ya = v[i] * rstd * g0[i] + e0[i], yb = v[4 + i] * rstd * g1[i] + e1[i]; y[i] = ya * sigmoidf_(ya); y[4 + i] = yb * sigmoidf_(yb); }
        u32x2 oa, ob; oa.x = pk2(y[0], y[1]); oa.y = pk2(y[2], y[3]); ob.x = pk2(y[4], y[5]); ob.y = pk2(y[6], y[7]);
        *(u32x2*)(AC + (size_t)(t0 + o) * 512 + cA) = oa; *(u32x2*)(AC + (size_t)(t0 + o) * 512 + 256 + cA) = ob;
    }
}
__device__ __forceinline__ void conv_task1(Frame& F, int t, const bf16_t* AG, bf16_t* AC, const LAS float* wl, const float* bdw, const float* lng, const float* lnb) {
    const int s0 = t < TX ? (t & ~(SEQ - 1)) : TX + ((t - TX) & ~(CTXL - 1)), s1 = s0 + (t < TX ? SEQ : CTXL);
    int c0 = 8 * F.lane; asm volatile("" : "+v"(c0));
    const bf16_t* zrow1 = (const bf16_t*)(F.ws + WS_CTL + 126 * 1024);
    float acc[8];
#pragma unroll
    for (int i = 0; i < 8; ++i) acc[i] = 0.f;
#pragma unroll 1
    for (int hb = 0; hb < 2; ++hb) {
        u32x4 xr[16];
#pragma unroll
        for (int i = 0; i < 16; ++i) { const int j = hb * 16 + i, row = t + j - 15; const bool inr = j < 31 && row >= s0 && row < s1;
            xr[i] = *(const u32x4*)((inr ? AG + (size_t)row * 512 : zrow1) + c0); }
#pragma unroll
        for (int i = 0; i < 16; ++i) { const int j = hb * 16 + i; f32x4 xa, xb; unpack8(xr[i], xa, xb);
            const f32x4 w0 = *(const LAS f32x4*)(wl + (j + 8) * 512 + c0), w1 = *(const LAS f32x4*)(wl + (j + 8) * 512 + c0 + 4);
#pragma unroll
            for (int q = 0; q < 4; ++q) { acc[q] += w0[q] * xa[q]; acc[4 + q] += w1[q] * xb[q]; } }
    }
    const f32x4 b0 = *(const f32x4*)(bdw + c0), b1 = *(const f32x4*)(bdw + c0 + 4), g0 = *(const f32x4*)(lng + c0), g1 = *(const f32x4*)(lng + c0 + 4), e0 = *(const f32x4*)(lnb + c0), e1 = *(const f32x4*)(lnb + c0 + 4);
    float v[8]; float s = 0.f;
#pragma unroll
    for (int i = 0; i < 4; ++i) { v[i] = acc[i] + b0[i]; v[4 + i] = acc[4 + i] + b1[i]; s += v[i] + v[4 + i]; }
    const float mu = wave_sum(s) * (1.0f / 512.0f); float q = 0.f;
#pragma unroll
    for (int i = 0; i < 8; ++i) { v[i] -= mu; q += v[i] * v[i]; }
    const float rstd = 1.0f / sqrtf(wave_sum(q) * (1.0f / 512.0f) + EPS);
    f32x4 ya, yb;
#pragma unroll
    for (int i = 0; i < 4; ++i) { const float a = v[i] * rstd * g0[i] + e0[i], b = v[4 + i] * rstd * g1[i] + e1[i]; ya[i] = a * sigmoidf_(a); yb[i] = b * sigmoidf_(b); }
    *(u32x4*)(AC + (size_t)t * 512 + c0) = pack8(ya, yb);
}
__device__ __forceinline__ void pool_task(Frame& F, int tk, const bf16_t* U, bf16_t* PL) {
    const int t0 = tk * 8; int s0, s1;
    if (t0 < TX) { s0 = t0 & ~(SEQ - 1); s1 = s0 + SEQ; } else { s0 = TX + ((t0 - TX) & ~(CTXL - 1)); s1 = s0 + CTXL; }
    int c0 = 8 * F.lane; asm volatile("" : "+v"(c0)); const int hw = 1 << (F.lane >> 4);
    float acc[8][8], cnt[8];
#pragma unroll
    for (int o = 0; o < 8; ++o) { cnt[o] = 0.f;
#pragma unroll
        for (int i = 0; i < 8; ++i) acc[o][i] = 0.f; }
    u32x4 cu[4], nu[4];
#pragma unroll
    for (int i = 0; i < 4; ++i) { const int row = t0 - 8 + i; const int rr = (row >= s0 && row < s1) ? row : t0; cu[i] = *(const u32x4*)(U + (size_t)rr * 512 + c0); }
#pragma unroll 1
    for (int grp = 0; grp < 6; ++grp) {
        if (grp < 5) {
#pragma unroll
            for (int i = 0; i < 4; ++i) { const int row = t0 - 8 + 4 * (grp + 1) + i; const int rr = (row >= s0 && row < s1) ? row : t0; nu[i] = *(const u32x4*)(U + (size_t)rr * 512 + c0); }
        }
#pragma unroll
        for (int i = 0; i < 4; ++i) {
            const int r = -8 + 4 * grp + i; const int row = t0 + r; const bool inr = row >= s0 && row < s1;
            f32x4 xa, xb; unpack8(cu[i], xa, xb);
#pragma unroll
            for (int o = 0; o < 8; ++o) { const int rel = r - o;
                const float mm = (inr && rel >= -hw && rel < hw) ? 1.0f : 0.0f; cnt[o] += mm;
#pragma unroll
                for (int q = 0; q < 4; ++q) { acc[o][q] += mm * xa[q]; acc[o][4 + q] += mm * xb[q]; } }
            __builtin_amdgcn_sched_barrier(0);
        }
#pragma unroll
        for (int i = 0; i < 4; ++i) cu[i] = nu[i];
    }
    u32x4 wown[8];
#pragma unroll
    for (int o = 0; o < 8; ++o) wown[o] = *(const u32x4*)(U + (size_t)(t0 + o) * 512 + c0);
#pragma unroll
    for (int o = 0; o < 8; ++o) {
        const u32x4 w = wown[o]; f32x4 xa, xb; unpack8(w, xa, xb);
        const float ic = 1.0f / cnt[o]; f32x4 pa, pb;
#pragma unroll
        for (int i = 0; i < 4; ++i) { pa[i] = acc[o][i] * ic - xa[i]; pb[i] = acc[o][4 + i] * ic - xb[i]; }
        *(u32x4*)(PL + (size_t)(t0 + o) * 512 + c0) = pack8(pa, pb);
    }
}

__device__ __forceinline__ void moe_tables(Frame& F, int l) {
    LAS unsigned* tab = (LAS unsigned*)(F.lds + LDS_TAB);
    __syncthreads();
    if (F.tid < 32) { const unsigned n = __hip_atomic_load(F.ctl + CW_CNT + (l * 32 + F.tid) * 64, __ATOMIC_RELAXED, __HIP_MEMORY_SCOPE_AGENT); tab[F.tid] = n; tab[1400 + F.tid] = (n + 255u) >> 8; }
    __syncthreads();
    if (F.tid < 32) { unsigned tb = 0; for (int e = 0; e < F.tid; ++e) tb += tab[1400 + e]; const unsigned nte = tab[1400 + F.tid]; tab[32 + F.tid] = tb; if (F.tid == 31) tab[64] = tb + nte;
        for (unsigned i = 0; i < nte; ++i) tab[96 + tb + i] = (unsigned)F.tid; }
    __syncthreads();
}

__device__ __forceinline__ void p_route(Frame& F, const Args& a, int l, int dummy) {
    const float* mod = (const float*)(F.ws + WS_MOD) + (size_t)l * 9 * 6144; bf16_t* H = (bf16_t*)(F.ws + WS_H);
#if XBF16
    const bf16_t* X = (const bf16_t*)(F.ws + WS_X);
#else
    const float* X = (const float*)(F.ws + WS_X);
#endif
    unsigned* TI = (unsigned*)(F.ws + WS_TI + (dummy ? WS_END - WS_TI : 0)); float* TG = (float*)(F.ws + WS_TG + (dummy ? WS_END - WS_TI : 0)); unsigned* LIST = (unsigned*)(F.ws + WS_LIST + (dummy ? WS_END - WS_TI : 0));
    unsigned* cntw = F.ctl + CW_CNT + (dummy ? 8192 : 0);
    const float* rw = a.in[21] + (size_t)l * 1024 * 32; const float* rb = a.in[22] + l * 32; const float* n2g = a.in[20] + l * 1024;
    LAS unsigned char* WH = F.lds; LAS unsigned char* WL = F.lds + 65536; LAS float* LG = (LAS float*)(F.lds + 131072) + F.wave * 512;
    LAS unsigned* hist = (LAS unsigned*)(F.lds + 131072 + 16384); LAS unsigned* basel = hist + 32;
    const int tid = F.tid, lane = F.lane;
    {
        f32x4 wv[16];
#pragma unroll
        for (int k = 0; k < 16; ++k) wv[k] = *(const f32x4*)(rw + 4 * (k * 512 + tid));
#pragma unroll
        for (int k = 0; k < 16; ++k) { const int v = k * 512 + tid, c = v >> 3, e0 = (v & 7) * 4;
#pragma unroll
            for (int j = 0; j < 4; ++j) { const int e = e0 + j; const float w = wv[k][j]; const unsigned h = f2bf(w); const float wh = __builtin_bit_cast(float, h << 16); const unsigned lo = f2bf(w - wh);
                const int ad = e * 2048 + (((c >> 3) ^ (e & 15)) * 16) + (c & 7) * 2; *(LAS bf16_t*)(WH + ad) = (bf16_t)h; *(LAS bf16_t*)(WL + ad) = (bf16_t)lo; } }
    }
    if (tid < 32) hist[tid] = 0u;
    __syncthreads();
    const int niter = (l == 0 ? TA : TX) / 128;
    const int tt = lane & 15, q = lane >> 4;
    const float* SSp = (const float*)(F.ws + WS_SS);
    LAS float* GL = (LAS float*)(F.lds + 131072 + 16384 + 512); LAS float* SL = GL + 1024;
    for (int it = blockIdx.x; it < niter; it += F.G) {
        const int trow = it * 128 + F.wave * 16 + tt; const int ms = (it * 128) < TX ? ((it * 128) >> 13) : 8;
        const auto* xr = X + (size_t)trow * 1024 + q * 8; const float* mp = mod + (size_t)ms * 6144;
        { const float ga0 = n2g[tid], ga1 = n2g[tid + 512], sc0 = mp[4 * 1024 + tid], sc1 = mp[4 * 1024 + tid + 512], sh0 = mp[3 * 1024 + tid], sh1 = mp[3 * 1024 + tid + 512];
          GL[tid] = ga0 * (sc0 + 1.0f); GL[tid + 512] = ga1 * (sc1 + 1.0f); SL[tid] = sh0; SL[tid + 512] = sh1; }
        const f32x4 sp = *(const f32x4*)(SSp + (size_t)trow * 16 + q * 4);
        float ss = (sp[0] + sp[1]) + (sp[2] + sp[3]);
        ss += __shfl_xor(ss, 16); ss += __shfl_xor(ss, 32);
        const float rstd = 1.0f / sqrtf(ss * (1.0f / 1024.0f) + EPS);
        __syncthreads();
        f32x4 lacc[2]; lacc[0] = (f32x4){0.f, 0.f, 0.f, 0.f}; lacc[1] = lacc[0];
#if XBF16
        const bf16_t* xr2 = X + (size_t)trow * 1024 + q * 16;
#pragma unroll 2
        for (int st = 0; st < 16; ++st) { const int c = st * 64 + q * 16;
            const u32x4 xw0 = *(const u32x4*)(xr2 + st * 64), xw1 = *(const u32x4*)(xr2 + st * 64 + 8);
            u32x4 hw[2], lw[2];
#pragma unroll
            for (int j = 0; j < 2; ++j) { f32x4 xa, xb; unpack8(j ? xw1 : xw0, xa, xb); const int cj = c + 8 * j;
                const f32x4 ga = *(const LAS f32x4*)(GL + cj), gb = *(const LAS f32x4*)(GL + cj + 4), sha = *(const LAS f32x4*)(SL + cj), shb = *(const LAS f32x4*)(SL + cj + 4);
                const f32x4 ha = (xa * rstd) * ga + sha, hb = (xb * rstd) * gb + shb;
                hw[j] = pack8(ha, hb); f32x4 ra, rbb; unpack8(hw[j], ra, rbb); lw[j] = pack8(ha - ra, hb - rbb); }
            *(u32x4*)(H + (size_t)trow * 1024 + c) = hw[0]; *(u32x4*)(H + (size_t)trow * 1024 + c + 8) = hw[1];
#pragma unroll
            for (int j = 0; j < 2; ++j) { const bf16x8 Ah = __builtin_bit_cast(bf16x8, hw[j]), Al = __builtin_bit_cast(bf16x8, lw[j]);
#pragma unroll
                for (int nb = 0; nb < 2; ++nb) { const int e = nb * 16 + tt; const int ad = e * 2048 + (((st * 8 + q * 2 + j) ^ tt) * 16);
                    const bf16x8 bh = *(const LAS bf16x8*)(WH + ad), bl = *(const LAS bf16x8*)(WL + ad);
                    lacc[nb] = __builtin_amdgcn_mfma_f32_16x16x32_bf16(Ah, bh, lacc[nb], 0, 0, 0);
                    lacc[nb] = __builtin_amdgcn_mfma_f32_16x16x32_bf16(Ah, bl, lacc[nb], 0, 0, 0);
                    lacc[nb] = __builtin_amdgcn_mfma_f32_16x16x32_bf16(Al, bh, lacc[nb], 0, 0, 0); } }
        }
#else
#pragma unroll 4
        for (int ks = 0; ks < 32; ++ks) { const int c = ks * 32 + q * 8;
            const f32x4 xa = *(const f32x4*)(xr + ks * 32), xb = *(const f32x4*)(xr + ks * 32 + 4);
            const f32x4 ga = *(const LAS f32x4*)(GL + c), gb = *(const LAS f32x4*)(GL + c + 4), sha = *(const LAS f32x4*)(SL + c), shb = *(const LAS f32x4*)(SL + c + 4);
            const f32x4 ha = (xa * rstd) * ga + sha, hb = (xb * rstd) * gb + shb;
            const u32x4 hw = pack8(ha, hb); f32x4 ra, rbb; unpack8(hw, ra, rbb);
            const u32x4 lw = pack8(ha - ra, hb - rbb);
            *(u32x4*)(H + (size_t)trow * 1024 + c) = hw;
            const bf16x8 Ah = __builtin_bit_cast(bf16x8, hw), Al = __builtin_bit_cast(bf16x8, lw);
#pragma unroll
            for (int nb = 0; nb < 2; ++nb) { const int e = nb * 16 + tt; const int ad = e * 2048 + (((ks * 4 + q) ^ tt) * 16);
                const bf16x8 bh = *(const LAS bf16x8*)(WH + ad), bl = *(const LAS bf16x8*)(WL + ad);
                lacc[nb] = __builtin_amdgcn_mfma_f32_16x16x32_bf16(Ah, bh, lacc[nb], 0, 0, 0);
                lacc[nb] = __builtin_amdgcn_mfma_f32_16x16x32_bf16(Ah, bl, lacc[nb], 0, 0, 0);
                lacc[nb] = __builtin_amdgcn_mfma_f32_16x16x32_bf16(Al, bh, lacc[nb], 0, 0, 0); }
        }
#endif
#pragma unroll
        for (int nb = 0; nb < 2; ++nb) { const float bias = rb[nb * 16 + tt];
#pragma unroll
            for (int r = 0; r < 4; ++r) LG[(4 * q + r) * 32 + nb * 16 + tt] = lacc[nb][r] + bias; }
        asm volatile("s_waitcnt lgkmcnt(0)" ::: "memory");
        int be[4] = {0, 0, 0, 0}; float gt[4] = {0.f, 0.f, 0.f, 0.f}; unsigned rk[4] = {0u, 0u, 0u, 0u};
        if (lane < 16) {
            float lg[32];
#pragma unroll
            for (int j = 0; j < 8; ++j) { const f32x4 v = *(const LAS f32x4*)(LG + lane * 32 + 4 * j); lg[4 * j] = v[0]; lg[4 * j + 1] = v[1]; lg[4 * j + 2] = v[2]; lg[4 * j + 3] = v[3]; }
            float bv[4];
#pragma unroll
            for (int k = 0; k < 4; ++k) { float best = lg[0]; int bi = 0;
#pragma unroll
                for (int e = 1; e < 32; ++e) { const bool gtb = lg[e] > best; best = gtb ? lg[e] : best; bi = gtb ? e : bi; }
                bv[k] = best; be[k] = bi;
#pragma unroll
                for (int e = 0; e < 32; ++e) lg[e] = (e == bi) ? -3.0e38f : lg[e]; }
            float sum = 0.f;
#pragma unroll
            for (int k = 0; k < 4; ++k) { gt[k] = __expf(bv[k] - bv[0]); sum += gt[k]; }
            const float isum = 1.0f / sum;
#pragma unroll
            for (int k = 0; k < 4; ++k) { gt[k] *= isum; rk[k] = __hip_atomic_fetch_add(hist + be[k], 1u, __ATOMIC_RELAXED, __HIP_MEMORY_SCOPE_WORKGROUP); }
        }
        __syncthreads();
        if (tid < 32) { const unsigned nn = hist[tid]; unsigned bs = 0u; if (nn) bs = __hip_atomic_fetch_add(cntw + (l * 32 + tid) * 64, nn, __ATOMIC_RELAXED, __HIP_MEMORY_SCOPE_AGENT); basel[tid] = bs; }
        __syncthreads();
        if (lane < 16) { const int trw = it * 128 + F.wave * 16 + lane;
#pragma unroll
            for (int k = 0; k < 4; ++k) { const unsigned slot = basel[be[k]] + rk[k]; TI[(size_t)trw * 4 + k] = ((unsigned)be[k] << 20) | slot; TG[(size_t)trw * 4 + k] = gt[k]; LIST[(size_t)be[k] * TA + slot] = (unsigned)trw; } }
        __syncthreads();
        if (tid < 32) hist[tid] = 0u;
        __syncthreads();
    }
}

__device__ __forceinline__ void p_comb(Frame& F, const Args& a, int l) {
    const float* mod = (const float*)(F.ws + WS_MOD); bf16_t* H = (bf16_t*)(F.ws + WS_H); const bf16_t* Y = (const bf16_t*)(F.ws + WS_R2);
#if XBF16
    bf16_t* X = (bf16_t*)(F.ws + WS_X);
#else
    float* X = (float*)(F.ws + WS_X);
#endif
    const unsigned* TI = (const unsigned*)(F.ws + WS_TI); const float* TG = (const float*)(F.ws + WS_TG);
    const LAS unsigned* tab = (const LAS unsigned*)(F.lds + LDS_TAB);
    const int gw = F.vcu * 8 + F.wave, NGW = F.G * 8; const int nrow = l == 0 ? TA : TX; const bool lastl = l == 1;
    const int c0 = 8 * F.lane;
    for (int r0 = gw * 2; r0 < nrow; r0 += NGW * 2) {
        const int ms = r0 < TX ? (r0 >> 13) : 8;
        u32x4 ti[2]; f32x4 tg[2];
#pragma unroll
        for (int q = 0; q < 2; ++q) { ti[q] = *(const u32x4*)(TI + (size_t)(r0 + q) * 4); tg[q] = *(const f32x4*)(TG + (size_t)(r0 + q) * 4); }
        f32x4 xv[2][4];
#pragma unroll
        for (int q = 0; q < 2; ++q)
#pragma unroll
#if XBF16
            for (int j = 0; j < 2; ++j) { const u32x4 xw = *(const u32x4*)(X + (size_t)(r0 + q) * 1024 + 512 * j + c0); unpack8(xw, xv[q][2 * j], xv[q][2 * j + 1]); }
#else
            for (int j = 0; j < 4; ++j) xv[q][j] = *(const f32x4*)(X + (size_t)(r0 + q) * 1024 + 512 * (j >> 1) + c0 + 4 * (j & 1));
#endif
        u32x4 yv[2][4][2];
#pragma unroll
        for (int q = 0; q < 2; ++q)
#pragma unroll
            for (int k = 0; k < 4; ++k) { const unsigned info = ti[q][k]; const size_t pos = (size_t)tab[32 + (info >> 20)] * 256 + (info & 0xfffffu);
                yv[q][k][0] = __builtin_nontemporal_load((const u32x4*)(Y + pos * 1024 + c0)); yv[q][k][1] = __builtin_nontemporal_load((const u32x4*)(Y + pos * 1024 + 512 + c0)); }
        const float* g2 = mod + (size_t)(l * 9 + ms) * 6144 + 5 * 1024;
        f32x4 gv[4];
#pragma unroll
        for (int j = 0; j < 4; ++j) gv[j] = *(const f32x4*)(g2 + 512 * (j >> 1) + c0 + 4 * (j & 1));
        float ss[2];
#pragma unroll
        for (int q = 0; q < 2; ++q) {
            f32x4 f[4];
#pragma unroll
            for (int j = 0; j < 4; ++j) f[j] = (f32x4){0.f, 0.f, 0.f, 0.f};
#pragma unroll
            for (int k = 0; k < 4; ++k) { const float gk = tg[q][k]; f32x4 a0, a1, b0, b1; unpack8(yv[q][k][0], a0, a1); unpack8(yv[q][k][1], b0, b1);
                f[0] += a0 * gk; f[1] += a1 * gk; f[2] += b0 * gk; f[3] += b1 * gk; }
            float s_ = 0.f;
#pragma unroll
            for (int j = 0; j < 4; ++j) { xv[q][j] += gv[j] * f[j]; s_ += (xv[q][j][0] * xv[q][j][0] + xv[q][j][1] * xv[q][j][1]) + (xv[q][j][2] * xv[q][j][2] + xv[q][j][3] * xv[q][j][3]); }
            ss[q] = s_;
        }
#pragma unroll
        for (int o = 1; o < 64; o <<= 1) { ss[0] += __shfl_xor(ss[0], o); ss[1] += __shfl_xor(ss[1], o); }
        if (!lastl) {
            const float* mp = mod + (size_t)(9 + ms) * 6144; const float* n1g = a.in[6] + 1024;
            f32x4 pg[4], psh[4], psc[4];
#pragma unroll
            for (int j = 0; j < 4; ++j) { const int c = 512 * (j >> 1) + c0 + 4 * (j & 1); pg[j] = *(const f32x4*)(n1g + c); psh[j] = *(const f32x4*)(mp + c); psc[j] = *(const f32x4*)(mp + 1024 + c); }
#pragma unroll
            for (int q = 0; q < 2; ++q) { const float rstd = 1.0f / sqrtf(ss[q] * (1.0f / 1024.0f) + EPS);
                f32x4 h[4];
#if XBF16
                *(u32x4*)(X + (size_t)(r0 + q) * 1024 + c0) = pack8(xv[q][0], xv[q][1]); *(u32x4*)(X + (size_t)(r0 + q) * 1024 + 512 + c0) = pack8(xv[q][2], xv[q][3]);
#pragma unroll
                for (int j = 0; j < 4; ++j) h[j] = (xv[q][j] * rstd * pg[j]) * (psc[j] + 1.0f) + psh[j];
#else
#pragma unroll
                for (int j = 0; j < 4; ++j) { *(f32x4*)(X + (size_t)(r0 + q) * 1024 + 512 * (j >> 1) + c0 + 4 * (j & 1)) = xv[q][j]; h[j] = (xv[q][j] * rstd * pg[j]) * (psc[j] + 1.0f) + psh[j]; }
#endif
                *(u32x4*)(H + (size_t)(r0 + q) * 1024 + c0) = pack8(h[0], h[1]); *(u32x4*)(H + (size_t)(r0 + q) * 1024 + 512 + c0) = pack8(h[2], h[3]); }
        } else {
            f32x4 fg[4];
#pragma unroll
            for (int j = 0; j < 4; ++j) fg[j] = *(const f32x4*)(a.in[27] + 512 * (j >> 1) + c0 + 4 * (j & 1));
#pragma unroll
            for (int q = 0; q < 2; ++q) { const float rstd = 1.0f / sqrtf(ss[q] * (1.0f / 1024.0f) + EPS);
#pragma unroll
                for (int j = 0; j < 4; ++j) *(f32x4*)(a.out + (size_t)(r0 + q) * 1024 + 512 * (j >> 1) + c0 + 4 * (j & 1)) = xv[q][j] * rstd * fg[j]; }
        }
    }
}

__device__ __forceinline__ void znarrow_k512(Frame& F, int tid, f32x4 (&acc)[4], const bf16_t* Arow, const bf16_t* B0, int ldb) {
    const int lane = tid & 63, l15 = lane & 15, kg = lane >> 4;
    u32x4 areg[16];
#pragma unroll
    for (int ks = 0; ks < 16; ++ks) areg[ks] = *(const u32x4*)(Arow + ks * 32);
    u32x4 breg[8];
#pragma unroll
    for (int i = 0; i < 8; ++i) { const int idx = i * 512 + tid, row = idx >> 6, c = idx & 63; breg[i] = *(const u32x4*)(B0 + (size_t)((row >> 5) * 128 + (row & 31)) * ldb + c * 8); }
    __syncthreads();
#pragma unroll
    for (int i = 0; i < 8; ++i) { const int idx = i * 512 + tid, row = idx >> 6, c = idx & 63; *(LAS u32x4*)(F.lds + row * 1024 + ((c ^ (row & 15)) * 16)) = breg[i]; }
    __syncthreads();
#pragma unroll
    for (int ks = 0; ks < 16; ++ks)
#pragma unroll
        for (int t = 0; t < 4; ++t) { const bf16x8 b = *(const LAS bf16x8*)(F.lds + (16 * t + l15) * 1024 + (((ks * 4 + kg) ^ l15) * 16));
            acc[t] = __builtin_amdgcn_mfma_f32_16x16x32_bf16(__builtin_bit_cast(bf16x8, areg[ks]), b, acc[t], 0, 0, 0); }
}
__device__ __forceinline__ void z_branch_unit(Frame& F, const unsigned char* r1, unsigned char* r2, const unsigned char* wl) {
    int tid = F.tid; asm volatile("" : "+v"(tid));
    const int v = F.vcu, rb = v >> 4, cg = v & 15, pn = cg >> 2, wc = cg & 3, lane = tid & 63, l15 = lane & 15, kg = lane >> 4;
    const int r0 = TX + rb * 128 + F.wave * 16;
    f32x4 acc[3][4];
#pragma unroll
    for (int br = 0; br < 3; ++br)
#pragma unroll
        for (int t = 0; t < 4; ++t) acc[br][t] = (f32x4){0.f, 0.f, 0.f, 0.f};
#pragma unroll
    for (int br = 0; br < 3; ++br)
        znarrow_k512(F, tid, acc[br], (const bf16_t*)(r2 + R2_AC + (size_t)br * R2_AT) + (size_t)(r0 + l15) * 512 + kg * 8,
                     (const bf16_t*)(wl + W_CO + (size_t)br * W_P_B) + (size_t)(pn * 256 + wc * 32) * 512, 512);
    const bf16_t* G = (const bf16_t*)(r1 + R1_G); bf16_t* MG = (bf16_t*)(r2 + R2_MG);
    bf16_t gq[4][4][3];
#pragma unroll
    for (int t = 0; t < 4; ++t)
#pragma unroll
        for (int r = 0; r < 4; ++r) { const bf16_t* gp = G + (size_t)(r0 + 4 * kg + r) * 3072 + pn * 256 + 64 * wc + 16 * t + l15; gq[t][r][0] = gp[0]; gq[t][r][1] = gp[1024]; gq[t][r][2] = gp[2048]; }
#pragma unroll
    for (int t = 0; t < 4; ++t)
#pragma unroll
        for (int r = 0; r < 4; ++r) { const int row = r0 + 4 * kg + r, sc = pn * 256 + 64 * wc + 16 * t + l15;
            const float g0 = bflo(gq[t][r][0]), g1 = bflo(gq[t][r][1]), g2 = bflo(gq[t][r][2]);
            MG[(size_t)row * 1024 + sc] = (bf16_t)f2bf(g0 * acc[0][t][r] + g1 * acc[1][t][r] + g2 * acc[2][t][r]); }
}
__device__ __forceinline__ void z_wout_unit(Frame& F, const Args& args, unsigned char* r2, const unsigned char* wl, const float* modl) {
    int tid = F.tid; asm volatile("" : "+v"(tid));
    const int v = F.vcu, rb = v >> 4, cg = v & 15, pn = cg >> 2, wc = cg & 3, lane = tid & 63, l15 = lane & 15, kg = lane >> 4;
    const int r0 = TX + rb * 128 + F.wave * 16;
    f32x4 acc[4];
#pragma unroll
    for (int t = 0; t < 4; ++t) acc[t] = (f32x4){0.f, 0.f, 0.f, 0.f};
#pragma unroll
    for (int kh = 0; kh < 2; ++kh)
        znarrow_k512(F, tid, acc, (const bf16_t*)(r2 + R2_MG) + (size_t)(r0 + l15) * 1024 + kh * 512 + kg * 8,
                     (const bf16_t*)(wl + W_OUT) + (size_t)(pn * 256 + wc * 32) * 1024 + kh * 512, 1024);
    bf16_t* X = (bf16_t*)(F.ws + WS_X); float* SS = (float*)(F.ws + WS_SS); const float* gvp = modl + (size_t)8 * 6144 + 2 * 1024;
    float sq[4] = {0.f, 0.f, 0.f, 0.f};
    float resv[4][4], gvv[4];
#pragma unroll
    for (int t = 0; t < 4; ++t) { const int sc = pn * 256 + 64 * wc + 16 * t + l15; gvv[t] = gvp[sc];
#pragma unroll
        for (int r = 0; r < 4; ++r) resv[t][r] = args.in[2][(size_t)(r0 + 4 * kg + r - TX) * 1024 + sc]; }
#pragma unroll
    for (int t = 0; t < 4; ++t) { const int sc = pn * 256 + 64 * wc + 16 * t + l15; const float gv = gvv[t];
#pragma unroll
        for (int r = 0; r < 4; ++r) { const int row = r0 + 4 * kg + r;
            const unsigned w = f2bf(resv[t][r] + gv * acc[t][r]); const float vr = bflo(w);
            X[(size_t)row * 1024 + sc] = (bf16_t)w; sq[r] += vr * vr; } }
#pragma unroll
    for (int r = 0; r < 4; ++r) { float s_ = sq[r]; s_ += __shfl_xor(s_, 1); s_ += __shfl_xor(s_, 2); s_ += __shfl_xor(s_, 4); s_ += __shfl_xor(s_, 8);
        if (l15 == 0) SS[(size_t)(r0 + 4 * kg + r) * 16 + pn * 4 + wc] = s_; }
}

__device__ __forceinline__ void z_kv_unit(Frame& F, int u, unsigned char* r1, const unsigned char* wl) {
    int tid = F.tid; asm volatile("" : "+v"(tid));
    const int rb = u >> 2, wc = u & 3, lane = tid & 63, l15 = lane & 15, kg = lane >> 4;
    const int r0 = TX + rb * 128 + F.wave * 16;
    f32x4 acc[4];
#pragma unroll
    for (int t = 0; t < 4; ++t) acc[t] = (f32x4){0.f, 0.f, 0.f, 0.f};
#pragma unroll
    for (int kh = 0; kh < 2; ++kh)
        znarrow_k512(F, tid, acc, (const bf16_t*)(F.ws + WS_H) + (size_t)(r0 + l15) * 1024 + kh * 512 + kg * 8,
                     (const bf16_t*)(wl + W_IN) + (size_t)(6 * 256 + wc * 32) * 1024 + kh * 512, 1024);
    bf16_t* Kd = (bf16_t*)(r1 + R1_K); bf16_t* vt = (bf16_t*)(r1 + R1_VT);
#pragma unroll
    for (int t = 0; t < 4; ++t) { const int bj = t >> 1, i = (t & 1) * 16 + l15;
#pragma unroll
        for (int r = 0; r < 4; ++r) { const int row = r0 + 4 * kg + r; const bf16_t val = (bf16_t)f2bf(acc[t][r]);
            if (wc < 2) Kd[(size_t)row * 128 + wc * 64 + bj * 32 + i] = val;
            else { const int zz = row - TX, b = zz >> 8, cp = zz & 255; vt[(size_t)TX * 128 + ((size_t)((b * 2 + bj) * 64 + (wc - 2) * 32 + i)) * CTXL + perm16(cp)] = val; } } }
}

__global__ void __launch_bounds__(512, 2) mk_fwd(Args args) {
    extern __shared__ __attribute__((aligned(16))) unsigned char lds_raw[];
    Frame F;
    F.lds = (LAS unsigned char*)lds_raw; F.ws = args.ws; F.ctl = (unsigned*)(args.ws + WS_CTL);
    F.tid = threadIdx.x; F.lane = F.tid & 63; F.wave = __builtin_amdgcn_readfirstlane(F.tid >> 6);
    F.G = gridDim.x; { const int bx = blockIdx.x; F.vcu = (F.G % 8 == 0) ? (bx % 8) * (F.G / 8) + bx / 8 : bx; }
    volatile LAS unsigned* MISC = (volatile LAS unsigned*)(F.lds + LDS_MISC);
    if (F.tid < 64) MISC[F.tid] = 0u;
    __syncthreads();
    XcdBarrier bar; bar.bar = (unsigned*)(F.ctl + CW_BAR); bar.x = 0; bar.st = nullptr;
#if !MK_PER_PHASE
    bar = xcd_barrier_post((unsigned*)(F.ctl + CW_BAR), MISC + 8);
#endif
    const int lo = args.ph_lo, hi = args.ph_hi; int bxo = blockIdx.x;
#ifndef PH_MASK
#define PH_MASK 0x3ff
#endif
#ifndef REP_MASK
#define REP_MASK 0
#endif
#define NREP(ty) (((REP_MASK >> (ty)) & 1) ? 2 : 1)
#define INT(k, ty) (((PH_MASK >> (ty)) & 1) && lo <= (k) && (k) < hi)
#define IN(k) (lo <= (k) && (k) < hi)
#define REFRESH() do { int t_; asm volatile("v_mbcnt_lo_u32_b32 %0, -1, 0\n\tv_mbcnt_hi_u32_b32 %0, -1, %0" : "=v"(t_)); t_ |= F.wave << 6; F.tid = t_; F.lane = t_ & 63; int b_ = blockIdx.x; asm volatile("" : "+s"(b_)); bxo = b_; F.vcu = (F.G % 8 == 0) ? (b_ % 8) * (F.G / 8) + b_ / 8 : b_; } while (0)
#ifndef NXBAR
#define NXBAR 1
#endif
#define SEAM(k) do { if (IN((k) + 1)) { for (int q_ = 0; q_ < NXBAR; ++q_) xcd_barrier(bar); } } while (0)

    if (INT(0, 0)) { REFRESH(); for (int rep = 0; rep < NREP(0); ++rep) { p_prologue(F, args); __syncthreads(); } SEAM(0); }
    if (INT(1, 1)) { REFRESH(); for (int rep = 0; rep < NREP(1); ++rep) p_norm0(F, args); SEAM(1); }

    for (int l = 0; l < 2; ++l) {
        const int pb = 2 + l * 8;
        unsigned char* wl = F.ws + WS_W + (size_t)l * W_LAYER;
        unsigned char* r1 = F.ws + WS_R1; unsigned char* r2 = F.ws + WS_R2;
        const float* modl = (const float*)(F.ws + WS_MOD) + (size_t)l * 9 * 6144;
        const int nrt = l == 0 ? NTA : NTX;

        if (INT(pb + 0, 2)) { REFRESH();
            const bool zkv = l == 1 && F.G == 256;
            g8::SchedDense<1024> S{(const char*)(F.ws + WS_H), (const char*)(wl + W_IN), nrt, 21, F.G, bxo, (l == 0 || zkv) ? 0 : NTZ, 6};
            g8::EpiInProj E{(bf16_t*)(r1 + R1_AGLU), (bf16_t*)(r1 + R1_Q), (bf16_t*)(r1 + R1_K), (bf16_t*)(r1 + R1_VT), (bf16_t*)(r1 + R1_U), (bf16_t*)(r1 + R1_G),
                            args.in[8] + l * 3072, (const float*)(F.ws + WS_ROPE)};
#ifdef PROBE_SAME
            g8::gemm_phase<1024>(F.lds, S, E, F.tid); { g8::EpiNull EN; g8::SchedSame SS{(const char*)(F.ws + WS_H), (const char*)(wl + W_IN), 22, bxo}; g8::gemm_phase<1024>(F.lds, SS, EN, F.tid); }
#elif defined(PROBE_NULL_EPI)
            g8::gemm_phase<1024>(F.lds, S, E, F.tid); { g8::EpiNull EN; g8::gemm_phase<1024>(F.lds, S, EN, F.tid); }
#else
            for (int rep = 0; rep < NREP(2); ++rep) g8::gemm_phase<1024>(F.lds, S, E, F.tid);
#endif
            if (zkv && bxo < 64) z_kv_unit(F, bxo, r1, wl);
            SEAM(pb + 0);
        }
        if (INT(pb + 1, 3)) { REFRESH();
            const bf16_t* Q = (const bf16_t*)(r1 + R1_Q); const bf16_t* Kb = (const bf16_t*)(r1 + R1_K); const bf16_t* VT = (const bf16_t*)(r1 + R1_VT);
            bf16_t* AT = (bf16_t*)(r2 + R2_AT); const float* sink = args.in[14] + l * 8;
            __syncthreads();
#if !defined(MIX_SUB) || (MIX_SUB & 1)
            for (int rep = 0; rep < NREP(10); ++rep) {
                const int nu = l == 0 ? 1056 : 1024;
                for (int i = 0; ; ++i) {
                    int id;
                    if (F.G == 256) { if (i < 4) id = F.vcu * 4 + i; else if (i == 4 && F.vcu < 32) id = 1024 + F.vcu; else break; }
                    else id = F.vcu + i * F.G;
                    if (id >= nu) break;
                    if (id < 1024) attn_unit(F, Q, Kb, VT, AT, sink, false, id >> 7, (id & 127) >> 1, id & 1);
                    else { const int zz = id - 1024; attn_unit(F, Q, Kb, VT, AT, sink, true, zz >> 2, (zz >> 1) & 1, zz & 1); }
                }
            }
#endif
            REFRESH();
            __syncthreads();
            LAS float* wlds = (LAS float*)F.lds;
            { float tv[31];
#pragma unroll
              for (int j = 0; j < 31; ++j) tv[j] = args.in[9][(size_t)l * 31 * 512 + j * 512 + F.tid];
#pragma unroll
              for (int k = 0; k < 48; ++k) wlds[k * 512 + F.tid] = (k >= 8 && k <= 38) ? tv[(k >= 8 && k <= 38) ? k - 8 : 0] : 0.f; }
            __syncthreads();
            const int ntask = (l == 0 ? TA : TX) / 8; const int gw = F.vcu * 8 + F.wave, NGW = F.G * 8;
#if !defined(MIX_SUB) || (MIX_SUB & 2)
            const bool zconv1 = l == 0 && F.G == 256;
            const int ntaskc = zconv1 ? TX / 8 : ntask;
            for (int rep = 0; rep < NREP(11); ++rep) { for (int i_ = 0, tk = gw; tk < ntaskc; ++i_, tk = (i_ + 1) * NGW <= ntaskc ? gw + i_ * NGW : i_ * NGW + (NGW - 1 - gw))
                conv_task(F, tk, (const bf16_t*)(r1 + R1_AGLU), (bf16_t*)(r2 + R2_AC), wlds, args.in[10] + l * 512, args.in[11] + l * 512, args.in[12] + l * 512);
              if (zconv1 && F.vcu >= 32) for (int zt = gw - 256; zt < TZ; zt += NGW - 256)
                conv_task1(F, TX + zt, (const bf16_t*)(r1 + R1_AGLU), (bf16_t*)(r2 + R2_AC), wlds, args.in[10] + l * 512, args.in[11] + l * 512, args.in[12] + l * 512); }
#endif
#if !defined(MIX_SUB) || (MIX_SUB & 4)
            for (int rep = 0; rep < NREP(12); ++rep) for (int i_ = 0, tk = gw; tk < ntask; ++i_, tk = (i_ + 1) * NGW <= ntask ? gw + i_ * NGW : i_ * NGW + (NGW - 1 - gw)) pool_task(F, tk, (const bf16_t*)(r1 + R1_U), (bf16_t*)(r2 + R2_PL));
#endif
            SEAM(pb + 1);
        }
        if (INT(pb + 2, 4)) { REFRESH();
            const bool znarrow = XBF16 && l == 0 && F.G == 256;
            g8::SchedBranch S{(const char*)(r2 + R2_AC), (const char*)(wl + W_CO), R2_AT, W_P_B, znarrow ? NTX : nrt, F.G, bxo};
            g8::EpiBranch E{(const bf16_t*)(r1 + R1_G), (bf16_t*)(r2 + R2_MG)};
            for (int rep = 0; rep < NREP(4); ++rep) g8::gemm_phase<512>(F.lds, S, E, F.tid);
            if (znarrow) z_branch_unit(F, r1, r2, wl);
            SEAM(pb + 2);
        }
        if (INT(pb + 3, 5)) { REFRESH();
            const bool znarrow = XBF16 && l == 0 && F.G == 256;
            g8::SchedDense<1024> S{(const char*)(r2 + R2_MG), (const char*)(wl + W_OUT), znarrow ? NTX : nrt, 4, F.G, bxo, 0, 0};
            #if XBF16
            g8::EpiWout E{args.in[0], args.in[2], (bf16_t*)(F.ws + WS_X), modl, (float*)(F.ws + WS_SS), l == 0 ? 1 : 0};
#else
            g8::EpiWout E{args.in[0], args.in[2], (float*)(F.ws + WS_X), modl, (float*)(F.ws + WS_SS), l == 0 ? 1 : 0};
#endif
            for (int rep = 0; rep < (l == 0 ? NREP(5) : 1); ++rep) g8::gemm_phase<1024>(F.lds, S, E, F.tid);
#if XBF16
            if (znarrow) z_wout_unit(F, args, r2, wl, modl);
#endif
            SEAM(pb + 3);
        }
        if (INT(pb + 4, 6)) { REFRESH(); __syncthreads(); p_route(F, args, l, 0); if (NREP(6) == 2) { __syncthreads(); p_route(F, args, l, 1); } SEAM(pb + 4); }
        if (INT(pb + 5, 7)) { REFRESH();
            moe_tables(F, l);
            g8::SchedMoE<true> S{(const char*)(F.ws + WS_H), (const char*)(wl + W_GU), W_GU_E, (const unsigned*)(F.ws + WS_LIST), (const LAS unsigned*)(F.lds + LDS_TAB), 8, F.G, bxo};
            g8::EpiGU E{(bf16_t*)r1, args.in[24] + (size_t)l * 32 * 2048};
#ifdef PROBE_NULL_GU
            g8::gemm_phase<1024>(F.lds, S, E, F.tid); { g8::EpiNull EN; g8::gemm_phase<1024>(F.lds, S, EN, F.tid); }
#else
            for (int rep = 0; rep < NREP(7); ++rep) g8::gemm_phase<1024>(F.lds, S, E, F.tid);
#endif
            SEAM(pb + 5);
        }
        if (INT(pb + 6, 8)) { REFRESH();
            if (!INT(pb + 5, 7)) moe_tables(F, l);
            g8::SchedMoE<false> S{(const char*)r1, (const char*)(wl + W_DN), W_DN_E, nullptr, (const LAS unsigned*)(F.lds + LDS_TAB), 4, F.G, bxo};
            g8::EpiDown E{(bf16_t*)r2, args.in[26] + (size_t)l * 32 * 1024};
#ifdef PROBE_NULL_DOWN
            g8::gemm_phase<1024>(F.lds, S, E, F.tid); { g8::EpiNull EN; g8::gemm_phase<1024>(F.lds, S, EN, F.tid); }
#else
            for (int rep = 0; rep < NREP(8); ++rep) g8::gemm_phase<1024>(F.lds, S, E, F.tid);
#endif
            SEAM(pb + 6);
        }
        if (INT(pb + 7, 9)) { REFRESH(); if (!INT(pb + 5, 7)) moe_tables(F, l); p_comb(F, args, l); if (NREP(9) == 2 && l == 1) p_comb(F, args, l); SEAM(pb + 7); }
    }
#undef IN
#undef INT
#undef SEAM
}

extern "C" void kernel_launch(void* const* d_in, const int* in_sizes, int n_in, void* d_out, int out_size, void* d_ws, size_t ws_size, hipStream_t stream) {
    static int grid = 0;
    if (grid == 0) {
        if (n_in != 28 || out_size != TX * D || ws_size < WS_END) { fprintf(stderr, "kernel_launch: unexpected shapes (n_in %d out %d ws %zu need %zu)\n", n_in, out_size, ws_size, (size_t)WS_END); grid = -1; return; }
        int dev = 0, cus = 0, per_cu = 0;
        if (hipGetDevice(&dev) != hipSuccess || hipDeviceGetAttribute(&cus, hipDeviceAttributeMultiprocessorCount, dev) != hipSuccess) { grid = -1; return; }
        if (hipFuncSetAttribute((const void*)mk_fwd, hipFuncAttributeMaxDynamicSharedMemorySize, LDS_BYTES) != hipSuccess) { fprintf(stderr, "kernel_launch: hipFuncSetAttribute failed\n"); grid = -1; return; }
        if (hipOccupancyMaxActiveBlocksPerMultiprocessor(&per_cu, (const void*)mk_fwd, 512, LDS_BYTES) != hipSuccess || per_cu < 1) { fprintf(stderr, "kernel_launch: occupancy query says %d\n", per_cu); }
        (void)hipGetLastError();
        grid = cus;
    }
    if (grid < 0) return;
    (void)in_sizes;
    (void)hipMemsetAsync((char*)d_ws + WS_CTL, 0, CTL_ZERO, stream);
    Args a{};
    for (int i = 0; i < 28; ++i) a.in[i] = (const float*)d_in[i];
    a.out = (float*)d_out; a.ws = (unsigned char*)d_ws;
#if MK_PER_PHASE
    for (int p = 0; p < NPH; ++p) { a.ph_lo = p; a.ph_hi = p + 1; hipLaunchKernelGGL(mk_fwd, dim3(grid), dim3(512), LDS_BYTES, stream, a); }
#else
    a.ph_lo = 0; a.ph_hi = NPH; hipLaunchKernelGGL(mk_fwd, dim3(grid), dim3(512), LDS_BYTES, stream, a);
#endif
}
```
